# Optimizing an MI355X kernel written in HIP

```python
import math
import jax, jax.numpy as jnp
from jax import lax
import numpy as np

D_MODEL = 2048
BATCH = 4
SEQ = 4096
DEPTH = 2

DILATED_GROUPS = ((128, 1), (512, 4), (2048, 16))
N_ATTN_GROUPS = len(DILATED_GROUPS)
HEADS_PER_GROUP = 4
HEAD_DIM = 128
N_ATTN_HEADS = N_ATTN_GROUPS * HEADS_PER_GROUP
QKV_W = N_ATTN_HEADS * HEAD_DIM
ATTN_OUT = HEADS_PER_GROUP * HEAD_DIM
REL_BUCKETS = 32
REL_MAX_DIST = 2048
D_INNER = 2 * D_MODEL
SSM_HEAD_DIM = 64
SSM_HEADS = D_INNER // SSM_HEAD_DIM
SSM_GROUPS = 8
HEADS_PER_SSM_GROUP = SSM_HEADS // SSM_GROUPS
D_STATE = 128
CONV_K = 4
CHUNK = 128
CONV_DIM = D_INNER + 2 * SSM_GROUPS * D_STATE
D_FF = ((8 * D_MODEL // 3 + 255) // 256) * 256
SPLITS = (QKV_W, QKV_W, QKV_W, D_INNER, CONV_DIM, SSM_HEADS, D_MODEL, D_MODEL)
N_IN = sum(SPLITS)
EPS = 1e-6

kernel_name = "hybrid_dilated_attn_ssd_gated_block"


def rmsnorm(x, w):
    x32 = x.astype(jnp.float32)
    y = x32 * lax.rsqrt(jnp.mean(x32 * x32, axis=-1, keepdims=True) + EPS)
    return (y * w.astype(jnp.float32)).astype(x.dtype)


def t5_bucket(dist):
    exact = REL_BUCKETS // 2
    n = jnp.maximum(dist, 1).astype(jnp.float32)
    large = exact + (jnp.log(n / exact) / math.log(REL_MAX_DIST / exact)
                     * (REL_BUCKETS - exact)).astype(jnp.int32)
    large = jnp.minimum(large, REL_BUCKETS - 1)
    return jnp.where(dist < exact, dist, large)


def dilated_window_attention(q, k, v, bias_table, window, dilation):
    B, S, Hg, Dh = q.shape
    blk = window // dilation
    unit = blk * dilation
    Sp = -(-S // unit) * unit
    L = Sp // dilation
    nb = L // blk

    def to_blocks(t):
        t = jnp.pad(t, ((0, 0), (0, Sp - S), (0, 0), (0, 0)))
        t = t.reshape(B, L, dilation, Hg, Dh).transpose(0, 2, 1, 3, 4)
        return t.reshape(B, dilation, nb, blk, Hg, Dh)

    qb, kb, vb = to_blocks(q), to_blocks(k), to_blocks(v)

    def with_prev(t):
        prev = jnp.pad(t[:, :, :-1], ((0, 0), (0, 0), (1, 0), (0, 0), (0, 0), (0, 0)))
        return jnp.concatenate([prev, t], axis=3)

    kk, vv = with_prev(kb), with_prev(vb)
    logits = jnp.einsum('brnqhd,brnkhd->brnhqk', qb, kk).astype(jnp.float32) / math.sqrt(Dh)

    qi = jnp.arange(blk)[:, None]
    kj = jnp.arange(2 * blk)[None, :]
    steps = blk + qi - kj
    band = (steps >= 0) & (steps <= blk)
    first = (jnp.arange(nb) == 0)[:, None, None]
    valid = band[None] & ~(first & (kj < blk)[None])
    bucket = t5_bucket(jnp.clip(steps, 0, blk) * dilation)
    bias = bias_table[bucket].astype(jnp.float32).transpose(2, 0, 1)

    logits = jnp.where(valid[None, None, :, None], logits + bias[None, None, None], -jnp.inf)
    m = jnp.max(logits, axis=-1, keepdims=True)
    p = jnp.exp(logits - m)
    s = jnp.sum(p, axis=-1, keepdims=True)
    o = jnp.einsum('brnhqk,brnkhd->brnqhd', (p / s).astype(v.dtype), vv)
    lse = (m + jnp.log(s))[..., 0]

    o = o.reshape(B, dilation, L, Hg, Dh).transpose(0, 2, 1, 3, 4).reshape(B, Sp, Hg, Dh)[:, :S]
    lse = lse.transpose(0, 1, 2, 4, 3).reshape(B, dilation, L, Hg)
    lse = lse.transpose(0, 2, 1, 3).reshape(B, Sp, Hg)[:, :S]
    return o, lse


def ssd_chunked(xs, dt, A, Bm, Cm):
    Bsz, S, H, P = xs.shape
    G, N = Bm.shape[2], Bm.shape[3]
    R = H // G
    nc = S // CHUNK
    f32 = jnp.float32
    x = xs.astype(f32).reshape(Bsz, nc, CHUNK, G, R, P)
    dtc = dt.astype(f32).reshape(Bsz, nc, CHUNK, G, R)
    Bc = Bm.astype(f32).reshape(Bsz, nc, CHUNK, G, N)
    Cc = Cm.astype(f32).reshape(Bsz, nc, CHUNK, G, N)
    acum = jnp.cumsum(dtc * A.astype(f32).reshape(G, R), axis=2)
    xdt = x * dtc[..., None]

    at = jnp.moveaxis(acum, 2, -1)
    seg = at[..., :, None] - at[..., None, :]
    tril = jnp.tril(jnp.ones((CHUNK, CHUNK), dtype=bool))
    Ldec = jnp.exp(jnp.where(tril, seg, -jnp.inf))
    cb = jnp.einsum('bclgn,bcsgn->bcgls', Cc, Bc)
    y_diag = jnp.einsum('bcgrls,bcsgrp->bclgrp', cb[:, :, :, None] * Ldec, xdt)

    decay_states = jnp.exp(acum[:, :, -1:] - acum)
    states = jnp.einsum('bclgn,bclgrp->bcgrpn', Bc, xdt * decay_states[..., None])
    chunk_decay = jnp.exp(acum[:, :, -1])

    def step(h, inp):
        st, dec = inp
        return h * dec[..., None, None] + st, h

    h0 = jnp.zeros_like(states[:, 0])
    _, prev = lax.scan(step, h0, (jnp.moveaxis(states, 1, 0), jnp.moveaxis(chunk_decay, 1, 0)))
    prev = jnp.moveaxis(prev, 0, 1)

    y_off = jnp.einsum('bclgn,bcgrpn,bclgr->bclgrp', Cc, prev, jnp.exp(acum))
    return (y_diag + y_off).reshape(Bsz, S, H, P)


def causal_depthwise_conv(u, w, b):
    S = u.shape[1]
    up = jnp.pad(u, ((0, 0), (CONV_K - 1, 0), (0, 0)))
    out = b
    for j in range(CONV_K):
        out = out + up[:, j:j + S] * w[j]
    return out


def mixer(h, rel_bias, w_in, conv_w, conv_b, dt_bias, a_log, d_skip, ssm_norm_w,
          w_attn_proj, w_ssm_proj, w_out):
    B, S, _ = h.shape
    proj = h @ w_in
    q, k, v, z, xbc, dt_raw, g_attn, g_ssm = jnp.split(
        proj, np.cumsum(SPLITS)[:-1].tolist(), axis=-1)

    q = q.reshape(B, S, N_ATTN_GROUPS, HEADS_PER_GROUP, HEAD_DIM)
    k = k.reshape(B, S, N_ATTN_GROUPS, HEADS_PER_GROUP, HEAD_DIM)
    v = v.reshape(B, S, N_ATTN_GROUPS, HEADS_PER_GROUP, HEAD_DIM)
    outs, lses = [], []
    for g, (window, dilation) in enumerate(DILATED_GROUPS):
        o, lse = dilated_window_attention(
            q[:, :, g], k[:, :, g], v[:, :, g],
            rel_bias[:, g * HEADS_PER_GROUP:(g + 1) * HEADS_PER_GROUP], window, dilation)
        outs.append(o)
        lses.append(lse)
    wts = jax.nn.softmax(jnp.stack(lses, axis=0), axis=0)
    attn = jnp.sum(wts[..., None] * jnp.stack(outs, axis=0).astype(jnp.float32), axis=0)
    attn = attn.astype(h.dtype).reshape(B, S, ATTN_OUT)

    xbc = jax.nn.silu(causal_depthwise_conv(xbc, conv_w, conv_b))
    xs, Bm, Cm = jnp.split(xbc, [D_INNER, D_INNER + SSM_GROUPS * D_STATE], axis=-1)
    xs = xs.reshape(B, S, SSM_HEADS, SSM_HEAD_DIM)
    dt = jax.nn.softplus(dt_raw.astype(jnp.float32) + dt_bias.astype(jnp.float32))
    A = -jnp.exp(a_log.astype(jnp.float32))
    y = ssd_chunked(xs, dt, A, Bm.reshape(B, S, SSM_GROUPS, D_STATE),
                    Cm.reshape(B, S, SSM_GROUPS, D_STATE))
    y = y + d_skip.astype(jnp.float32)[:, None] * xs.astype(jnp.float32)
    y = y.reshape(B, S, D_INNER) * jax.nn.silu(z.astype(jnp.float32))
    y = y.reshape(B, S, SSM_GROUPS, D_INNER // SSM_GROUPS)
    y = y * lax.rsqrt(jnp.mean(y * y, axis=-1, keepdims=True) + EPS)
    y = (y.reshape(B, S, D_INNER) * ssm_norm_w.astype(jnp.float32)).astype(h.dtype)

    merged = jax.nn.sigmoid(g_attn) * (attn @ w_attn_proj) + jax.nn.sigmoid(g_ssm) * (y @ w_ssm_proj)
    return merged @ w_out


def swiglu(h, w_ffn_in, w_ffn_out):
    hg, hu = jnp.split(h @ w_ffn_in, 2, axis=-1)
    return (jax.nn.silu(hg) * hu) @ w_ffn_out


def setup_inputs(seed: int = 0) -> dict:
    key = jax.random.key(seed)
    ks = jax.random.split(key, 24)
    f32 = jnp.float32

    def nrm(k, shape, s):
        return jax.random.normal(k, shape, f32) * s

    dt0 = jnp.exp(jax.random.uniform(ks[10], (DEPTH, SSM_HEADS), f32)
                  * (math.log(0.1) - math.log(0.001)) + math.log(0.001))
    return {
        "x": nrm(ks[0], (BATCH, SEQ, D_MODEL), 1.0),
        "c": nrm(ks[1], (BATCH, D_MODEL), 1.0),
        "rel_bias": nrm(ks[2], (REL_BUCKETS, N_ATTN_HEADS), 0.5),
        "norm1_w": 1.0 + nrm(ks[3], (DEPTH, D_MODEL), 0.05),
        "norm2_w": 1.0 + nrm(ks[4], (DEPTH, D_MODEL), 0.05),
        "w_mod": nrm(ks[5], (DEPTH, D_MODEL, 6 * D_MODEL), D_MODEL ** -0.5),
        "b_mod": nrm(ks[6], (DEPTH, 6 * D_MODEL), 0.01),
        "w_in": nrm(ks[7], (DEPTH, D_MODEL, N_IN), D_MODEL ** -0.5),
        "conv_w": nrm(ks[8], (DEPTH, CONV_K, CONV_DIM), CONV_K ** -0.5),
        "conv_b": nrm(ks[9], (DEPTH, CONV_DIM), 0.01),
        "dt_bias": dt0 + jnp.log(-jnp.expm1(-dt0)),
        "a_log": jnp.log(jax.random.uniform(ks[11], (DEPTH, SSM_HEADS), f32, 1.0, 16.0)),
        "d_skip": 1.0 + nrm(ks[12], (DEPTH, SSM_HEADS), 0.1),
        "ssm_norm_w": 1.0 + nrm(ks[13], (DEPTH, D_INNER), 0.05),
        "w_attn_proj": nrm(ks[14], (DEPTH, ATTN_OUT, D_MODEL), ATTN_OUT ** -0.5),
        "w_ssm_proj": nrm(ks[15], (DEPTH, D_INNER, D_MODEL), D_INNER ** -0.5),
        "w_out": nrm(ks[16], (DEPTH, D_MODEL, D_MODEL), D_MODEL ** -0.5),
        "w_ffn_in": nrm(ks[17], (DEPTH, D_MODEL, 2 * D_FF), D_MODEL ** -0.5),
        "w_ffn_out": nrm(ks[18], (DEPTH, D_FF, D_MODEL), D_FF ** -0.5),
        "final_norm_w": 1.0 + nrm(ks[19], (D_MODEL,), 0.05),
    }


def reference(x, c, rel_bias, norm1_w, norm2_w, w_mod, b_mod, w_in, conv_w, conv_b,
              dt_bias, a_log, d_skip, ssm_norm_w, w_attn_proj, w_ssm_proj, w_out,
              w_ffn_in, w_ffn_out, final_norm_w):
    c_act = jax.nn.silu(c)
    for l in range(DEPTH):
        mod = (c_act @ w_mod[l] + b_mod[l])[:, None, :]
        sh1, sc1, g1, sh2, sc2, g2 = jnp.split(mod, 6, axis=-1)
        h = rmsnorm(x, norm1_w[l]) * (1.0 + sc1) + sh1
        x = x + g1 * mixer(h, rel_bias, w_in[l], conv_w[l], conv_b[l], dt_bias[l], a_log[l],
                           d_skip[l], ssm_norm_w[l], w_attn_proj[l], w_ssm_proj[l], w_out[l])
        h = rmsnorm(x, norm2_w[l]) * (1.0 + sc2) + sh2
        x = x + g2 * swiglu(h, w_ffn_in[l], w_ffn_out[l])
    return rmsnorm(x, final_norm_w)
```

```cpp
#include <hip/hip_runtime.h>
#include <hip/hip_cooperative_groups.h>
#include <cstdio>
#include <cstdint>
#include <cmath>
namespace cg = cooperative_groups;
namespace pg8 {
#define PG8_LAS __attribute__((address_space(3)))
typedef unsigned short bf16_t;
typedef short bf16x8 __attribute__((ext_vector_type(8)));
typedef float f32x4 __attribute__((ext_vector_type(4)));
typedef unsigned u32x4 __attribute__((ext_vector_type(4)));
constexpr int BM = 256, BK = 64, HALF = 128, HTB = HALF * BK * 2  , STAGE_BYTES = 8 * HTB, NXCD = 8, WGM = 8;

__host__ __device__ __forceinline__ int lds_byte(int r, int c) { const int st = (r >> 4) * 2 + (c >> 5), rr = r & 15, cc = c & 31, ob = rr * 64 + cc * 2; return st * 1024 + (ob ^ (((ob >> 9) & 1) << 5)); }
__host__ __device__ __forceinline__ void stage_rc(int b, int& R, int& C) { const int st = b / 1024, sb = b % 1024, swz = sb ^ (((sb >> 9) & 1) << 5); R = (st >> 1) * 16 + swz / 64; C = (st & 1) * 32 + (swz % 64) / 2; }
__host__ __device__ __forceinline__ int perm32(int rho) { const int n = rho >> 4, i = rho & 15; return 8 * (i >> 2) + 4 * n + (i & 3); }

struct Unit { int pm, pn; };
struct Gemm { const bf16_t* A; const bf16_t* Bt; int M, N, K, lda; };

struct StaticOrder {
    int nM, nN, nwg, G, c;
    __host__ __device__ void init(int M, int N, int G_, int c_) { nM = M / BM; nN = N / BM; nwg = nM * nN; G = G_; c = c_; }
    __host__ __device__ bool next(int i, Unit& u) const {
        const long L = (long)i * G + c; if (L >= nwg) return false;
        int wgid = (int)L; { const int q = nwg / NXCD, r = nwg % NXCD, xcd = wgid % NXCD, off = wgid / NXCD; wgid = (xcd < r ? xcd * (q + 1) : r * (q + 1) + (xcd - r) * q) + off; }
        const int nig = WGM * nN, gid = wgid / nig, fm = gid * WGM, gsz = (nM - fm) < WGM ? (nM - fm) : WGM;
        u.pm = fm + ((wgid % nig) % gsz); u.pn = (wgid % nig) / gsz; return true;
    }
    __device__ __forceinline__ void a_ready(const Unit&) const {}
    __device__ __forceinline__ void done(const Unit&) const {}
};

__device__ __forceinline__ unsigned cvt_pk_bf16(float lo, float hi) { unsigned r; asm volatile("v_cvt_pk_bf16_f32 %0, %1, %2" : "=v"(r) : "v"(lo), "v"(hi)); return r; }
__device__ __forceinline__ float bflo(unsigned u) { return __uint_as_float(u << 16); }
__device__ __forceinline__ float bfhi(unsigned u) { return __uint_as_float(u & 0xffff0000u); }
__device__ __forceinline__ float sigmoidf_(float x) { return __builtin_amdgcn_rcpf(1.f + __expf(-x)); }
__device__ __forceinline__ float siluf_(float x) { return x * __builtin_amdgcn_rcpf(1.f + __expf(-x)); }

constexpr int NPROJ = 19200;
struct EpiProj {
    static constexpr bool PERM = true, AFTER_DRAIN = false;
    bf16_t* O; float* DT;
    __device__ __forceinline__ void operator()(const f32x4 (&acc)[2][2][4][2], const Unit& u, int wr, int wc, int fr, int fq) const {
        const int row0 = u.pm * BM + wr * 64 + fr;
        if (u.pn == 74) {
            if (wc < 2) {
#pragma unroll
                for (int ai = 0; ai < 2; ++ai)
#pragma unroll
                    for (int m = 0; m < 4; ++m) { float* p = DT + (size_t)(row0 + ai * HALF + m * 16) * 64 + wc * 32 + 8 * fq;
                        *(f32x4*)p = acc[ai][0][m][0]; *(f32x4*)(p + 4) = acc[ai][0][m][1]; }
            }
            return;
        }
        const bool sg = u.pn >= 58, zs = u.pn >= 18 && u.pn < 34;
        const int col0 = u.pn * BM + wc * 32 + 8 * fq;
#pragma unroll
        for (int ai = 0; ai < 2; ++ai)
#pragma unroll
            for (int m = 0; m < 4; ++m) { bf16_t* rowp = O + (size_t)(row0 + ai * HALF + m * 16) * NPROJ + col0;
#pragma unroll
                for (int bj = 0; bj < 2; ++bj) { f32x4 v0 = acc[ai][bj][m][0], v1 = acc[ai][bj][m][1];
                    if (sg || zs) { f32x4 t0, t1;
#pragma unroll
                        for (int j = 0; j < 4; ++j) { t0[j] = __expf(-v0[j]); t1[j] = __expf(-v1[j]); }
#pragma unroll
                        for (int j = 0; j < 4; ++j) { t0[j] = __builtin_amdgcn_rcpf(1.f + t0[j]); t1[j] = __builtin_amdgcn_rcpf(1.f + t1[j]); }
                        if (sg) { v0 = t0; v1 = t1; } else { v0 = v0 * t0; v1 = v1 * t1; } }
                    u32x4 w; w.x = cvt_pk_bf16(v0[0], v0[1]); w.y = cvt_pk_bf16(v0[2], v0[3]); w.z = cvt_pk_bf16(v1[0], v1[1]); w.w = cvt_pk_bf16(v1[2], v1[3]);
                    *(u32x4*)(rowp + bj * HALF) = w; } }
    }
};
template <int MODE> struct EpiGate {
    static constexpr bool PERM = true, AFTER_DRAIN = false;
    bf16_t* O; int ldc; const bf16_t* G; int ldg;
    __device__ __forceinline__ void operator()(const f32x4 (&acc)[2][2][4][2], const Unit& u, int wr, int wc, int fr, int fq) const {
        const int row0 = u.pm * BM + wr * 64 + fr; const int col0 = u.pn * BM + wc * 32 + 8 * fq;
#pragma unroll
        for (int ai = 0; ai < 2; ++ai)
#pragma unroll
            for (int m = 0; m < 4; ++m) { const size_t row = (size_t)(row0 + ai * HALF + m * 16);
#pragma unroll
                for (int bj = 0; bj < 2; ++bj) { const int col = col0 + bj * HALF;
                    const u32x4 gv = *(const u32x4*)(G + row * ldg + col);
                    f32x4 v0 = acc[ai][bj][m][0], v1 = acc[ai][bj][m][1];
                    v0[0] *= bflo(gv.x); v0[1] *= bfhi(gv.x); v0[2] *= bflo(gv.y); v0[3] *= bfhi(gv.y);
                    v1[0] *= bflo(gv.z); v1[1] *= bfhi(gv.z); v1[2] *= bflo(gv.w); v1[3] *= bfhi(gv.w);
                    bf16_t* op = O + row * ldc + col;
                    if (MODE == 1) { const u32x4 ov = *(const u32x4*)op;
                        v0[0] += bflo(ov.x); v0[1] += bfhi(ov.x); v0[2] += bflo(ov.y); v0[3] += bfhi(ov.y);
                        v1[0] += bflo(ov.z); v1[1] += bfhi(ov.z); v1[2] += bflo(ov.w); v1[3] += bfhi(ov.w); }
                    u32x4 w; w.x = cvt_pk_bf16(v0[0], v0[1]); w.y = cvt_pk_bf16(v0[2], v0[3]); w.z = cvt_pk_bf16(v1[0], v1[1]); w.w = cvt_pk_bf16(v1[2], v1[3]);
                    *(u32x4*)op = w; } }
    }
};
struct EpiRes {
    static constexpr bool PERM = false, AFTER_DRAIN = false;
    const float* xin; float* out; const float* gate; int gstride;
    __device__ __forceinline__ void operator()(const f32x4 (&acc)[2][2][4][2], const Unit& u, int wr, int wc, int fr, int fq) const {
        const int row0 = u.pm * BM + wr * 64 + fr; const int col0 = u.pn * BM + wc * 32 + 4 * fq;
        const float* gp = gate + (size_t)(u.pm >> 4) * gstride + col0;
        f32x4 gv[2][2];
#pragma unroll
        for (int bj = 0; bj < 2; ++bj)
#pragma unroll
            for (int n = 0; n < 2; ++n) gv[bj][n] = *(const f32x4*)(gp + bj * HALF + n * 16);
#pragma unroll
        for (int ai = 0; ai < 2; ++ai)
#pragma unroll
            for (int m = 0; m < 4; ++m) { const size_t off = (size_t)(row0 + ai * HALF + m * 16) * 2048 + col0;
#pragma unroll
                for (int bj = 0; bj < 2; ++bj)
#pragma unroll
                    for (int n = 0; n < 2; ++n) { const f32x4 xv = *(const f32x4*)(xin + off + bj * HALF + n * 16);
                        *(f32x4*)(out + off + bj * HALF + n * 16) = xv + gv[bj][n] * acc[ai][bj][m][n]; } }
    }
};
struct EpiSwiglu {
    static constexpr bool PERM = true, AFTER_DRAIN = false;
    bf16_t* O; int ldc;
    __device__ __forceinline__ void operator()(const f32x4 (&acc)[2][2][4][2], const Unit& u, int wr, int wc, int fr, int fq) const {
        const int row0 = u.pm * BM + wr * 64 + fr; const int col0 = u.pn * HALF + wc * 32 + 8 * fq;
#pragma unroll
        for (int ai = 0; ai < 2; ++ai)
#pragma unroll
            for (int m = 0; m < 4; ++m) { bf16_t* op = O + (size_t)(row0 + ai * HALF + m * 16) * ldc + col0;
                f32x4 v0, v1;
#pragma unroll
                for (int j = 0; j < 4; ++j) { v0[j] = siluf_(acc[ai][0][m][0][j]) * acc[ai][1][m][0][j]; v1[j] = siluf_(acc[ai][0][m][1][j]) * acc[ai][1][m][1][j]; }
                u32x4 w; w.x = cvt_pk_bf16(v0[0], v0[1]); w.y = cvt_pk_bf16(v0[2], v0[3]); w.z = cvt_pk_bf16(v1[0], v1[1]); w.w = cvt_pk_bf16(v1[2], v1[3]);
                *(u32x4*)op = w; }
    }
};

template <class Epi, class Sched, bool ALIGN_EPI = false, bool SP2 = false>
__device__ __forceinline__ void gemm_phase(PG8_LAS unsigned char* lds, const Gemm g, const Sched& S, const Epi& E) {
    int tid = threadIdx.x; asm volatile("" : "+v"(tid)); const int wid = __builtin_amdgcn_readfirstlane(tid >> 6), lane = tid & 63, wr = wid >> 2, wc = wid & 3, fr = lane & 15, fq = lane >> 4;
    const int K = g.K, nt = K / BK;
    unsigned voffA[2], voffB[2];
#pragma unroll
    for (int i = 0; i < 2; ++i) { int R, C; stage_rc(tid * 16 + i * 8192, R, C); const int Rb = Epi::PERM ? ((R & ~31) + perm32(R & 31)) : R;
        voffA[i] = (unsigned)(R * g.lda + C) * 2u; voffB[i] = (unsigned)(Rb * K + C) * 2u; }
    const size_t kstep = (size_t)(BK * 2);
    const size_t hstepA = (size_t)HALF * g.lda * 2, hstepB = (size_t)HALF * K * 2;
    const size_t tstepA = 2 * hstepA, tstepB = 2 * hstepB;
    const unsigned ldsw = (unsigned)wid * 1024u;
    const int aoff = lds_byte(wr * 64 + fr, fq * 8), boff = lds_byte(wc * 32 + fr, fq * 8);
#define PG8_SA(b, h) (((b) * 2 + (h)) * HTB)
#define PG8_SB(b, h) ((4 + (b) * 2 + (h)) * HTB)
#define PG8_STAGE(bufoff, gbase, voff) do { _Pragma("unroll") for (int _i = 0; _i < 2; ++_i) \
        __builtin_amdgcn_global_load_lds((const unsigned*)((const char*)(gbase) + (voff)[_i]), (PG8_LAS unsigned*)(lds + (bufoff) + ldsw + _i * 8192), 16, 0, 0); } while (0)
#define PG8_LDA(dst, b, h) do { _Pragma("unroll") for (int m = 0; m < 4; ++m) _Pragma("unroll") for (int k = 0; k < 2; ++k) dst[m][k] = *(const PG8_LAS bf16x8*)(lds + PG8_SA(b, h) + aoff + m * 2048 + k * 1024); } while (0)
#define PG8_LDB(dst, b, h) do { _Pragma("unroll") for (int n = 0; n < 2; ++n) _Pragma("unroll") for (int k = 0; k < 2; ++k) dst[n][k] = *(const PG8_LAS bf16x8*)(lds + PG8_SB(b, h) + boff + n * 2048 + k * 1024); } while (0)
#define PG8_MMA(ai, bj, At, Bt) do { __builtin_amdgcn_s_setprio(1); _Pragma("unroll") for (int m = 0; m < 4; ++m) _Pragma("unroll") for (int n = 0; n < 2; ++n) _Pragma("unroll") for (int k = 0; k < 2; ++k) \
        acc[ai][bj][m][n] = __builtin_amdgcn_mfma_f32_16x16x32_bf16(Bt[n][k], At[m][k], acc[ai][bj][m][n], 0, 0, 0); __builtin_amdgcn_s_setprio(0); } while (0)
#define PG8_WAIT_V(n) asm volatile("s_waitcnt vmcnt(" #n ")" ::: "memory")
#define PG8_WAIT_L(n) asm volatile("s_waitcnt lgkmcnt(" #n ")" ::: "memory")
#define PG8_BAR __builtin_amdgcn_s_barrier()
#define PG8_SCHED __builtin_amdgcn_sched_barrier(0)
    Unit cur, nxt; int ui = 0;
    if (!S.next(0, cur)) return;
    f32x4 acc[2][2][4][2];
#pragma unroll
    for (int a = 0; a < 2; ++a)
#pragma unroll
        for (int b = 0; b < 2; ++b)
#pragma unroll
            for (int m = 0; m < 4; ++m)
#pragma unroll
                for (int n = 0; n < 2; ++n) acc[a][b][m][n] = (f32x4){0.f, 0.f, 0.f, 0.f};
    bf16x8 At[4][2], B0[2][2], B1[2][2];
    const char* cA = (const char*)g.A + (size_t)cur.pm * tstepA; const char* cB = (const char*)g.Bt + (size_t)cur.pn * tstepB;
    S.a_ready(cur);
    if constexpr (SP2) {
        PG8_STAGE(PG8_SB(0, 0), cB, voffB); PG8_STAGE(PG8_SB(0, 1), cB + hstepB, voffB); PG8_STAGE(PG8_SA(0, 0), cA, voffA); PG8_STAGE(PG8_SA(0, 1), cA + hstepA, voffA);
        if (wr == 1) PG8_BAR;
        PG8_WAIT_V(2); PG8_BAR;
        PG8_STAGE(PG8_SB(1, 0), cB + kstep, voffB); PG8_STAGE(PG8_SA(1, 0), cA + kstep, voffA); PG8_STAGE(PG8_SB(1, 1), cB + hstepB + kstep, voffB);
        PG8_WAIT_V(6); PG8_BAR;
    } else {
        PG8_STAGE(PG8_SB(0, 0), cB, voffB); PG8_STAGE(PG8_SA(0, 0), cA, voffA); PG8_STAGE(PG8_SB(0, 1), cB + hstepB, voffB); PG8_STAGE(PG8_SA(0, 1), cA + hstepA, voffA);
        if (wr == 1) PG8_BAR;
        PG8_WAIT_V(4); PG8_BAR;
        PG8_STAGE(PG8_SB(1, 0), cB + kstep, voffB); PG8_STAGE(PG8_SA(1, 0), cA + kstep, voffA); PG8_STAGE(PG8_SB(1, 1), cB + hstepB + kstep, voffB);
        PG8_WAIT_V(6); PG8_BAR;
    }
    for (;;) {
        const bool has_next = S.next(ui + 1, nxt);
        const char* nA = has_next ? (const char*)g.A + (size_t)nxt.pm * tstepA : cA; const char* nB = has_next ? (const char*)g.Bt + (size_t)nxt.pn * tstepB : cB;
        for (int t = 0; t < nt; t += 2) {
            const bool last = (t == nt - 2);
            const char* a1 = cA + (size_t)(t + 1) * kstep;
            const char* a2 = last ? nA : cA + (size_t)(t + 2) * kstep; const char* b2 = last ? nB : cB + (size_t)(t + 2) * kstep;
            const char* a3 = a2 + kstep; const char* b3 = b2 + kstep;
            if (last && has_next) S.a_ready(nxt);
            if constexpr (SP2) {
            PG8_LDB(B0, 0, 0); PG8_LDB(B1, 0, 1); PG8_SCHED; PG8_LDA(At, 0, 0); PG8_STAGE(PG8_SA(1, 1), a1 + hstepA, voffA);
            PG8_WAIT_V(8); PG8_WAIT_L(0); PG8_BAR; PG8_MMA(0, 0, At, B0); PG8_MMA(0, 1, At, B1); PG8_BAR; PG8_SCHED;
            PG8_LDA(At, 0, 1); PG8_STAGE(PG8_SB(0, 0), b2, voffB); PG8_STAGE(PG8_SB(0, 1), b2 + hstepB, voffB); PG8_STAGE(PG8_SA(0, 0), a2, voffA);
            PG8_WAIT_V(8); PG8_WAIT_L(0); PG8_BAR; PG8_MMA(1, 0, At, B0); PG8_MMA(1, 1, At, B1); PG8_BAR; PG8_SCHED;
            PG8_LDB(B0, 1, 0); PG8_LDB(B1, 1, 1); PG8_SCHED; PG8_LDA(At, 1, 0); PG8_STAGE(PG8_SA(0, 1), a2 + hstepA, voffA);
            PG8_WAIT_V(8); PG8_WAIT_L(0); PG8_BAR; PG8_MMA(0, 0, At, B0); PG8_MMA(0, 1, At, B1); PG8_BAR; PG8_SCHED;
            PG8_LDA(At, 1, 1); PG8_STAGE(PG8_SB(1, 0), b3, voffB); PG8_STAGE(PG8_SB(1, 1), b3 + hstepB, voffB); PG8_STAGE(PG8_SA(1, 0), a3, voffA);
            PG8_WAIT_V(8); PG8_WAIT_L(0); PG8_BAR; PG8_MMA(1, 0, At, B0); PG8_MMA(1, 1, At, B1); PG8_BAR; PG8_SCHED;
            } else {
            PG8_LDB(B0, 0, 0); PG8_SCHED; PG8_LDA(At, 0, 0); PG8_STAGE(PG8_SA(1, 1), a1 + hstepA, voffA);
            PG8_WAIT_L(8); PG8_BAR; PG8_WAIT_L(0); PG8_MMA(0, 0, At, B0); PG8_BAR; PG8_SCHED;
            PG8_LDB(B1, 0, 1); PG8_STAGE(PG8_SB(0, 0), b2, voffB);
            PG8_BAR; PG8_WAIT_L(0); PG8_MMA(0, 1, At, B1); PG8_BAR;
            PG8_LDA(At, 0, 1); PG8_STAGE(PG8_SA(0, 0), a2, voffA);
            PG8_BAR; PG8_WAIT_L(0); PG8_MMA(1, 0, At, B0); PG8_BAR; PG8_SCHED;
            PG8_STAGE(PG8_SB(0, 1), b2 + hstepB, voffB);
            PG8_WAIT_V(6); PG8_BAR; PG8_MMA(1, 1, At, B1); PG8_BAR;
            PG8_LDB(B0, 1, 0); PG8_SCHED; PG8_LDA(At, 1, 0); PG8_STAGE(PG8_SA(0, 1), a2 + hstepA, voffA);
            PG8_WAIT_L(8); PG8_BAR; PG8_WAIT_L(0); PG8_MMA(0, 0, At, B0); PG8_BAR; PG8_SCHED;
            PG8_LDB(B1, 1, 1); PG8_STAGE(PG8_SB(1, 0), b3, voffB);
            PG8_BAR; PG8_WAIT_L(0); PG8_MMA(0, 1, At, B1); PG8_BAR;
            PG8_LDA(At, 1, 1); PG8_STAGE(PG8_SA(1, 0), a3, voffA);
            PG8_BAR; PG8_WAIT_L(0); PG8_MMA(1, 0, At, B0); PG8_BAR; PG8_SCHED;
            PG8_STAGE(PG8_SB(1, 1), b3 + hstepB, voffB);
            PG8_WAIT_V(6); PG8_BAR; PG8_MMA(1, 1, At, B1); PG8_BAR;
            }
        }
        if constexpr (ALIGN_EPI) { if (wr == 0) PG8_BAR; }
        if constexpr (!Epi::AFTER_DRAIN) { E(acc, cur, wr, wc, fr, fq); S.done(cur); }
        if (!has_next) break;
#pragma unroll
        for (int a = 0; a < 2; ++a)
#pragma unroll
            for (int b = 0; b < 2; ++b)
#pragma unroll
                for (int m = 0; m < 4; ++m)
#pragma unroll
                    for (int n = 0; n < 2; ++n) acc[a][b][m][n] = (f32x4){0.f, 0.f, 0.f, 0.f};
        cur = nxt; cA = nA; cB = nB; ++ui;
        if constexpr (ALIGN_EPI) { if (wr == 1) PG8_BAR; }
    }
    PG8_WAIT_V(0);
    if constexpr (!ALIGN_EPI) { if (wr == 0) PG8_BAR; }
    PG8_BAR;
    if constexpr (Epi::AFTER_DRAIN) { E.fused(acc, cur, wr, wc, fr, fq, lds, wid, lane); S.done(cur); }
#undef PG8_SA
#undef PG8_SB
#undef PG8_STAGE
#undef PG8_LDA
#undef PG8_LDB
#undef PG8_MMA
#undef PG8_WAIT_V
#undef PG8_WAIT_L
#undef PG8_BAR
#undef PG8_SCHED
}
}
#define LAS __attribute__((address_space(3)))
typedef unsigned short bf16_t;
typedef short bf16x8 __attribute__((ext_vector_type(8)));
typedef short s16x4 __attribute__((ext_vector_type(4)));
typedef float f32x4 __attribute__((ext_vector_type(4)));
typedef unsigned u32x4 __attribute__((ext_vector_type(4)));
typedef unsigned u32x2 __attribute__((ext_vector_type(2)));
using pg8::cvt_pk_bf16; using pg8::bflo; using pg8::bfhi; using pg8::siluf_;

constexpr int D_MODEL = 2048, SEQ = 4096, M_TOK = 16384;
constexpr int NPROJ = pg8::NPROJ;
constexpr int N_IN = 19008, D_FF = 5632;
constexpr int COL_Q = 0, COL_K = 1536, COL_V = 3072, COL_Z = 4608, COL_XBC = 8704, COL_GA = 14848, COL_GS = 16896;
constexpr int NPHASE = 22;

constexpr size_t MiB = 1u << 20;
constexpr size_t WS_CTL = 0, CTL_ZERO_BYTES = 1 * MiB;
constexpr size_t WS_MOD = 65536;
constexpr size_t WS_LSE = 1 * MiB;
constexpr size_t WS_DT = 2 * MiB;
constexpr size_t WS_W = 8 * MiB;
constexpr size_t WO_IN = 0, WO_A = 78643200, WO_S = 80740352, WO_O = 97517568, WO_FI = 105906176, WO_FO = 152043520, WL_BYTES = 175112192;
constexpr size_t WS_H = WS_W + 2 * WL_BYTES;
constexpr size_t WS_PROJ = WS_H + (size_t)M_TOK * 2048 * 2;
constexpr size_t WS_END = WS_PROJ + (size_t)M_TOK * NPROJ * 2;
constexpr int LDS_BYTES = 147456;

struct Args { const float* in[20]; float* out; unsigned char* ws; int ph_lo, ph_hi; };

__device__ __forceinline__ float wave_sum(float v) {
#pragma unroll
    for (int o = 1; o < 64; o <<= 1) v += __shfl_xor(v, o);
    return v;
}
__device__ __forceinline__ float wave_incl_scan(float v, int lane) {
#pragma unroll
    for (int o = 1; o < 64; o <<= 1) { const float t = __shfl_up(v, o); if (lane >= o) v += t; }
    return v;
}
typedef short v4i16_t __attribute__((ext_vector_type(4)));
__device__ __forceinline__ s16x4 ldtr(LAS unsigned char* p) { return __builtin_bit_cast(s16x4, __builtin_amdgcn_ds_read_tr16_b64_v4i16((LAS v4i16_t*)p)); }
__device__ __forceinline__ bf16x8 cat8(s16x4 lo, s16x4 hi) { return (bf16x8){lo[0], lo[1], lo[2], lo[3], hi[0], hi[1], hi[2], hi[3]}; }
__device__ __forceinline__ f32x4 mfma16(bf16x8 a, bf16x8 b, f32x4 c) { return __builtin_amdgcn_mfma_f32_16x16x32_bf16(a, b, c, 0, 0, 0); }
#define LDS_WAIT() asm volatile("s_waitcnt lgkmcnt(0)" ::: "memory")

__device__ __forceinline__ void tr_item(const float* W, int Nsrc, bf16_t* WT, int K, int k0, int s0, int n0, LAS float* scr, int lane) {
    const int c = lane & 7;
    if (s0 < 0) {
#pragma unroll
        for (int j = 0; j < 4; ++j) { const int n = (lane >> 3) + 8 * j; *(u32x4*)(WT + (size_t)(n0 + n) * K + k0 + 8 * c) = (u32x4){0u, 0u, 0u, 0u}; }
        return;
    }
    { const float* wp = W + (size_t)(k0 + (lane >> 5)) * Nsrc + s0 + (lane & 31); float v[32];
#pragma unroll
        for (int i = 0; i < 32; ++i) v[i] = wp[(size_t)(2 * i) * Nsrc];
#pragma unroll
        for (int i = 0; i < 32; ++i) scr[(2 * i + (lane >> 5)) * 33 + (lane & 31)] = v[i]; }
    LDS_WAIT();
#pragma unroll
    for (int j = 0; j < 4; ++j) { const int n = (lane >> 3) + 8 * j; const LAS float* s = scr + (8 * c) * 33 + n;
        u32x4 o; o.x = cvt_pk_bf16(s[0 * 33], s[1 * 33]); o.y = cvt_pk_bf16(s[2 * 33], s[3 * 33]); o.z = cvt_pk_bf16(s[4 * 33], s[5 * 33]); o.w = cvt_pk_bf16(s[6 * 33], s[7 * 33]);
        *(u32x4*)(WT + (size_t)(n0 + n) * K + k0 + 8 * c) = o; }
    LDS_WAIT();
}

__device__ __forceinline__ void phase_prep(const Args& a, LAS unsigned char* lds, int tid, int lane, int wave, int bx, int G) {
    float* MOD = (float*)(a.ws + WS_MOD);
    const float* cin = a.in[1]; const float* w_mod = a.in[5]; const float* b_mod = a.in[6];
    LAS f32x4* red = (LAS f32x4*)lds;
    for (int it = bx; it < 256; it += G) {
        const int l = it >> 7, c96 = it & 127;
        const int par = lane >= 24 ? 1 : 0, cl = lane - 24 * par; const bool act = lane < 48;
        const float* Wm = w_mod + (size_t)l * 2048 * 12288 + c96 * 96 + (act ? cl : 0) * 4;
        const int k0 = wave * 256 + par;
        f32x4 acc0 = {0.f, 0.f, 0.f, 0.f}, acc1 = acc0, acc2 = acc0, acc3 = acc0;
#pragma unroll 8
        for (int kk = 0; kk < 128; ++kk) { const int k = k0 + 2 * kk; const f32x4 wv = *(const f32x4*)(Wm + (size_t)k * 12288);
            acc0 += siluf_(cin[k]) * wv; acc1 += siluf_(cin[2048 + k]) * wv; acc2 += siluf_(cin[4096 + k]) * wv; acc3 += siluf_(cin[6144 + k]) * wv; }
        if (act) { LAS f32x4* rp = red + ((wave * 2 + par) * 4) * 24 + cl; rp[0] = acc0; rp[24] = acc1; rp[48] = acc2; rp[72] = acc3; }
        __syncthreads();
        if (tid < 384) { const int b = tid / 96, ci = tid % 96; float s = b_mod[l * 12288 + c96 * 96 + ci];
#pragma unroll
            for (int w = 0; w < 16; ++w) s += ((const LAS float*)lds)[((w * 4 + b) * 24 + (ci >> 2)) * 4 + (ci & 3)];
            MOD[(size_t)(l * 4 + b) * 12288 + c96 * 96 + ci] = s; }
        __syncthreads();
    }
    LAS float* scr = (LAS float*)(lds + wave * 8704);
    const int gw = bx * 8 + wave, NGW = G * 8;
    constexpr int IPL = 19200 + 512 + 4096 + 2048 + 11264 + 5632;
    for (int it = gw; it < 2 * IPL; it += NGW) {
        const int l = it / IPL; int r = it % IPL;
        unsigned char* wb = a.ws + WS_W + (size_t)l * WL_BYTES;
        if (r < 19200) { const int kb = r / 600, nb = r % 600, n0 = nb * 32;
            const int s0 = n0 < 14848 ? n0 : (n0 < 18944 ? n0 + 64 : (n0 < 19008 ? 14848 + (n0 - 18944) : -1));
            tr_item(a.in[7] + (size_t)l * 2048 * N_IN, N_IN, (bf16_t*)(wb + WO_IN), 2048, kb * 64, s0, n0, scr, lane); continue; }
        r -= 19200;
        if (r < 512) { const int kb = r >> 6, nb = r & 63; tr_item(a.in[14] + (size_t)l * 512 * 2048, 2048, (bf16_t*)(wb + WO_A), 512, kb * 64, nb * 32, nb * 32, scr, lane); continue; }
        r -= 512;
        if (r < 4096) { const int kb = r >> 6, nb = r & 63; tr_item(a.in[15] + (size_t)l * 4096 * 2048, 2048, (bf16_t*)(wb + WO_S), 4096, kb * 64, nb * 32, nb * 32, scr, lane); continue; }
        r -= 4096;
        if (r < 2048) { const int kb = r >> 6, nb = r & 63; tr_item(a.in[16] + (size_t)l * 2048 * 2048, 2048, (bf16_t*)(wb + WO_O), 2048, kb * 64, nb * 32, nb * 32, scr, lane); continue; }
        r -= 2048;
        if (r < 11264) { const int kb = r / 352, nb = r % 352, n0 = nb * 32, t = n0 >> 8, j = n0 & 255;
            const int s0 = j < 128 ? 128 * t + j : D_FF + 128 * t + (j - 128);
            tr_item(a.in[17] + (size_t)l * 2048 * 2 * D_FF, 2 * D_FF, (bf16_t*)(wb + WO_FI), 2048, kb * 64, s0, n0, scr, lane); continue; }
        r -= 11264;
        { const int kb = r >> 6, nb = r & 63; tr_item(a.in[18] + (size_t)l * D_FF * 2048, 2048, (bf16_t*)(wb + WO_FO), D_FF, kb * 64, nb * 32, nb * 32, scr, lane); }
    }
}

template <bool FINAL>
__device__ __forceinline__ void phase_norm(const float* x, const float* w, const float* sc, const float* sh, bf16_t* H, float* outf, int lane, int gw, int NGW) {
    for (int blk = gw; blk < M_TOK / 8; blk += NGW) {
        const int m0 = blk * 8, b = m0 >> 12;
        f32x4 A[8], B[8];
#pragma unroll
        for (int j = 0; j < 8; ++j) { const int col = 4 * (lane + 64 * j); A[j] = *(const f32x4*)(w + col);
            if (!FINAL) { const f32x4 scv = *(const f32x4*)(sc + (size_t)b * 12288 + col); A[j] = A[j] * (1.0f + scv); B[j] = *(const f32x4*)(sh + (size_t)b * 12288 + col); } }
        f32x4 v[8], nx[8];
        { const f32x4* xr = (const f32x4*)(x + (size_t)m0 * 2048) + lane;
#pragma unroll
            for (int j = 0; j < 8; ++j) nx[j] = xr[64 * j]; }
#pragma unroll 1
        for (int r = 0; r < 8; ++r) { const int m = m0 + r;
#pragma unroll
            for (int j = 0; j < 8; ++j) v[j] = nx[j];
            if (r + 1 < 8) { const f32x4* xr = (const f32x4*)(x + (size_t)(m + 1) * 2048) + lane;
#pragma unroll
                for (int j = 0; j < 8; ++j) nx[j] = xr[64 * j]; }
            float ss = 0.f;
#pragma unroll
            for (int j = 0; j < 8; ++j) ss += (v[j].x * v[j].x + v[j].y * v[j].y) + (v[j].z * v[j].z + v[j].w * v[j].w);
            ss = wave_sum(ss);
            const float rstd = 1.0f / sqrtf(ss * (1.0f / 2048.0f) + 1e-6f);
#pragma unroll
            for (int j = 0; j < 8; ++j) { const int col = 4 * (lane + 64 * j);
                if (FINAL) { *(f32x4*)(outf + (size_t)m * 2048 + col) = v[j] * rstd * A[j]; }
                else { const f32x4 o = v[j] * rstd * A[j] + B[j];
                    u32x2 pk; pk.x = cvt_pk_bf16(o.x, o.y); pk.y = cvt_pk_bf16(o.z, o.w);
                    *(u32x2*)(H + (size_t)m * 2048 + col) = pk; } }
        }
    }
}

__device__ __forceinline__ void att_decode(int u, int& g, int& b, int& hh, int& d, int& r, int& n) {
    g = u >> 9; const int rem = u & 511; b = rem >> 7; hh = (rem >> 5) & 3; const int bi = rem & 31;
    d = g == 0 ? 1 : (g == 1 ? 4 : 16); const int nb = 32 / d; r = bi / nb; n = bi % nb;
}
__device__ __forceinline__ void phase_attn(bf16_t* P, float* LSE, const float* rel_bias, LAS unsigned char* lds, int bx, int G, int tid_) {
    int tid = tid_; asm volatile("" : "+v"(tid)); const int lane = tid & 63, wave = __builtin_amdgcn_readfirstlane(tid >> 6);
    constexpr int RS = 272;
    LAS unsigned char* Ks = lds; LAS unsigned char* Vs = lds + 256 * RS; LAS float* biasT = (LAS float*)(lds + 2 * 256 * RS);
    const int l15 = lane & 15, q4 = lane >> 4, qi = 16 * wave + l15;
    int u = bx; if (u >= 1536) return;
    u32x4 kr[8], vr[8]; bf16x8 Qn[4];
#define ATT_LOAD(uu) do { int g_, b_, hh_, d_, r_, n_; att_decode((uu), g_, b_, hh_, d_, r_, n_); const int colq_ = g_ * 512 + hh_ * 128; \
        _Pragma("unroll") for (int i = 0; i < 8; ++i) { const int idx = tid + 512 * i, key = idx >> 4, ch = idx & 15; const int si = (n_ - 1) * 128 + key; \
            kr[i] = (u32x4){0u, 0u, 0u, 0u}; vr[i] = (u32x4){0u, 0u, 0u, 0u}; \
            if (n_ > 0 || i >= 4) { const bf16_t* rp = P + (size_t)(b_ * SEQ + si * d_ + r_) * NPROJ + colq_ + ch * 8; kr[i] = *(const u32x4*)(rp + COL_K); vr[i] = *(const u32x4*)(rp + COL_V); } } \
        { const bf16_t* qp_ = P + (size_t)(b_ * SEQ + (n_ * 128 + qi) * d_ + r_) * NPROJ + colq_; \
          _Pragma("unroll") for (int ks = 0; ks < 4; ++ks) Qn[ks] = *(const bf16x8*)(qp_ + 32 * ks + 8 * q4); } } while (0)
    ATT_LOAD(u);
    for (;;) {
        int g, b, hh, d, r, n; att_decode(u, g, b, hh, d, r, n);
        const int colq = g * 512 + hh * 128;
#pragma unroll
        for (int i = 0; i < 8; ++i) { const int idx = tid + 512 * i, key = idx >> 4, ch = idx & 15;
            *(LAS u32x4*)(Ks + key * RS + ch * 16) = kr[i]; *(LAS u32x4*)(Vs + key * RS + ch * 16) = vr[i]; }
        if (tid < 160) { const int steps = tid - 15; float bv = -INFINITY;
            if (steps >= 0 && steps <= 128) { const int dist = steps * d; int bk;
                if (dist < 16) bk = dist; else { const int lg = 16 + (int)(logf((float)dist / 16.0f) / 4.852030263919617f * 16.0f); bk = lg < 31 ? lg : 31; }
                bv = rel_bias[bk * 12 + g * 4 + hh]; }
            biasT[tid] = bv; }
        bf16x8 Qf[4];
#pragma unroll
        for (int ks = 0; ks < 4; ++ks) Qf[ks] = Qn[ks];
        __syncthreads();
        const int un = u + G;
        if (un < 1536) ATT_LOAD(un);
        const size_t tq = (size_t)(b * SEQ + (n * 128 + qi) * d + r);
        bf16_t* qp = P + tq * NPROJ + colq;
        f32x4 S[9];
        LAS unsigned char* kbase = Ks + (16 * wave + l15) * RS + q4 * 16;
#pragma unroll
        for (int tt = 0; tt < 9; ++tt) { S[tt] = (f32x4){0.f, 0.f, 0.f, 0.f};
#pragma unroll
            for (int ks = 0; ks < 4; ++ks) { const bf16x8 Kf = *(const LAS bf16x8*)(kbase + tt * 16 * RS + ks * 64); S[tt] = mfma16(Kf, Qf[ks], S[tt]); } }
        __builtin_amdgcn_sched_barrier(0);
        const float scale = 0.08838834764831845f;
        float mx = -INFINITY;
        {
            const LAS float* bp = biasT + (143 + l15 - 4 * q4);
#pragma unroll
            for (int tt = 0; tt < 9; ++tt)
#pragma unroll
                for (int e = 0; e < 4; ++e) S[tt][e] = S[tt][e] * scale + bp[-(16 * tt + e)];
            if (n == 0) {
#pragma unroll
                for (int tt = 0; tt < 9; ++tt)
#pragma unroll
                    for (int e = 0; e < 4; ++e) { if (wave + tt < 8) S[tt][e] = -INFINITY; }
            }
#pragma unroll
            for (int tt = 0; tt < 9; ++tt)
#pragma unroll
                for (int e = 0; e < 4; ++e) mx = fmaxf(mx, S[tt][e]);
        }
        mx = fmaxf(mx, __shfl_xor(mx, 16)); mx = fmaxf(mx, __shfl_xor(mx, 32));
        float sum = 0.f;
#pragma unroll
        for (int tt = 0; tt < 9; ++tt)
#pragma unroll
            for (int e = 0; e < 4; ++e) { const float p = __expf(S[tt][e] - mx); S[tt][e] = p; sum += p; }
        sum += __shfl_xor(sum, 16); sum += __shfl_xor(sum, 32);
        bf16x8 Pf[5];
#pragma unroll
        for (int kk = 0; kk < 5; ++kk) { u32x4 w; w.x = cvt_pk_bf16(S[2 * kk][0], S[2 * kk][1]); w.y = cvt_pk_bf16(S[2 * kk][2], S[2 * kk][3]);
            if (kk < 4) { w.z = cvt_pk_bf16(S[2 * kk + 1][0], S[2 * kk + 1][1]); w.w = cvt_pk_bf16(S[2 * kk + 1][2], S[2 * kk + 1][3]); } else { w.z = 0u; w.w = 0u; }
            Pf[kk] = __builtin_bit_cast(bf16x8, w); }
        const float inv = 1.0f / sum;
        LAS unsigned char* vbase = Vs + (16 * wave + 4 * q4 + (l15 >> 2)) * RS + (l15 & 3) * 8;
        bf16_t* op = qp + 4 * q4;
#pragma unroll
        for (int dt = 0; dt < 8; ++dt) { f32x4 o = {0.f, 0.f, 0.f, 0.f};
#pragma unroll
            for (int kk = 0; kk < 5; ++kk) {
                const s16x4 lo = ldtr(vbase + (32 * kk) * RS + dt * 32);
                s16x4 hi = {0, 0, 0, 0};
                if (kk < 4) hi = ldtr(vbase + (32 * kk + 16) * RS + dt * 32);
                o = mfma16(cat8(lo, hi), Pf[kk], o); }
            u32x2 pk; pk.x = cvt_pk_bf16(o[0] * inv, o[1] * inv); pk.y = cvt_pk_bf16(o[2] * inv, o[3] * inv);
            *(u32x2*)(op + 16 * dt) = pk;
            __builtin_amdgcn_sched_barrier(0); }
        if (q4 == 0) LSE[tq * 12 + g * 4 + hh] = mx + logf(sum);
        __syncthreads();
        if (un >= 1536) break;
        u = un;
    }
#undef ATT_LOAD
}

__device__ __forceinline__ void phase_convbc(const bf16_t* P, bf16_t* HBC, const float* conv_w, const float* conv_b, int tid, int bx, int G) {
    const int chunk = tid & 255, rh = tid >> 8, col = 4096 + chunk * 8;
    float cw[4][8], cbias[8];
#pragma unroll
    for (int e = 0; e < 8; ++e) { cbias[e] = conv_b[col + e];
#pragma unroll
        for (int j = 0; j < 4; ++j) cw[j][e] = conv_w[j * 6144 + col + e]; }
    for (int it = bx; it < M_TOK / 32; it += G) {
        const int r0 = it * 32 + rh * 16; const bool halo = (r0 & (SEQ - 1)) != 0;
        const bf16_t* src = P + (size_t)r0 * NPROJ + COL_XBC + col;
        u32x4 raw[19];
#pragma unroll
        for (int i = 0; i < 19; ++i) { raw[i] = (u32x4){0u, 0u, 0u, 0u}; if (i >= 3 || halo) raw[i] = *(const u32x4*)(src + (ptrdiff_t)(i - 3) * NPROJ); }
#pragma unroll
        for (int rr = 0; rr < 16; ++rr) { float o[8];
#pragma unroll
            for (int e = 0; e < 8; ++e) o[e] = cbias[e];
#pragma unroll
            for (int j = 0; j < 4; ++j) { const u32x4 rv = raw[rr + j];
                o[0] += bflo(rv.x) * cw[j][0]; o[1] += bfhi(rv.x) * cw[j][1]; o[2] += bflo(rv.y) * cw[j][2]; o[3] += bfhi(rv.y) * cw[j][3];
                o[4] += bflo(rv.z) * cw[j][4]; o[5] += bfhi(rv.z) * cw[j][5]; o[6] += bflo(rv.w) * cw[j][6]; o[7] += bfhi(rv.w) * cw[j][7]; }
#pragma unroll
            for (int e = 0; e < 8; ++e) o[e] = siluf_(o[e]);
            u32x4 w; w.x = cvt_pk_bf16(o[0], o[1]); w.y = cvt_pk_bf16(o[2], o[3]); w.z = cvt_pk_bf16(o[4], o[5]); w.w = cvt_pk_bf16(o[6], o[7]);
            *(u32x4*)(HBC + (size_t)(r0 + rr) * 2048 + chunk * 8) = w; }
    }
}

template <int VAR>
__device__ __forceinline__ void ssd_unit(bf16_t* P, const bf16_t* HBC, const float* DT, const float* conv_w, const float* conv_b, float dtb, float Aneg, float Dk,
                                         LAS unsigned char* lds, int b, int hd, int tid_, int lane_, int wave_) {
    int tid = tid_; asm volatile("" : "+v"(tid)); const int lane = tid & 63, wave = __builtin_amdgcn_readfirstlane(tid >> 6);
    constexpr int XS = 144, BS = 272;
    LAS unsigned char* Xs = lds; LAS unsigned char* Xw = lds + 18432; LAS unsigned char* Bm = lds + 36864; LAS unsigned char* Cm = lds + 71680; LAS unsigned char* Hs = lds + 106496;
    LAS float* scal = (LAS float*)(lds + 123904);
    const int g = hd >> 3, l15 = lane & 15, q4 = lane >> 4;
    const int xch = tid & 7, xr0 = (tid >> 3) * 2;
    const int xcol = hd * 64 + xch * 8;
    const int bcch = tid & 31, bcrow = tid >> 5;
    const int bccol = bcch < 16 ? g * 128 + bcch * 8 : 1024 + g * 128 + (bcch - 16) * 8;
    LAS unsigned char* bcdst = (bcch < 16 ? Bm + bcch * 16 : Cm + (bcch - 16) * 16) + bcrow * BS;
    LAS float* cwt = (LAS float*)(lds + 126976);
    if (tid < 320) { const int j = tid >> 6, cc = tid & 63; cwt[tid] = j < 4 ? conv_w[j * 6144 + hd * 64 + cc] : conv_b[hd * 64 + cc]; }
    for (int i = tid; i < 17408 / 16; i += 512) *(LAS u32x4*)(Hs + i * 16) = (u32x4){0u, 0u, 0u, 0u};
    f32x4 hacc[4];
#pragma unroll
    for (int pt = 0; pt < 4; ++pt) hacc[pt] = (f32x4){0.f, 0.f, 0.f, 0.f};
    u32x4 xraw[5], bcraw[8]; float dr0 = 0.f, dr1 = 0.f;
#define SSD_LOADS(c_) do { const int tok0_ = b * SEQ + (c_) * 128; \
        _Pragma("unroll") for (int i = 0; i < 5; ++i) { xraw[i] = (u32x4){0u, 0u, 0u, 0u}; \
            if (i >= 3 || (c_) > 0 || xr0 + i >= 3) xraw[i] = *(const u32x4*)(P + (size_t)(tok0_ + xr0 - 3 + i) * NPROJ + COL_XBC + xcol); } \
        if (wave == 0) { dr0 = DT[(size_t)(tok0_ + lane) * 64 + hd]; dr1 = DT[(size_t)(tok0_ + 64 + lane) * 64 + hd]; } } while (0)
#define SSD_LOADS_BC(c_) do { const int tok0_ = b * SEQ + (c_) * 128; \
        _Pragma("unroll") for (int i = 0; i < 8; ++i) bcraw[i] = *(const u32x4*)(HBC + (size_t)(tok0_ + bcrow + 16 * i) * 2048 + bccol); } while (0)
#define SSD_SCAN(par_) do { LAS float* dtv_ = scal + (par_) * 128; LAS float* acum_ = scal + 256 + (par_) * 128; LAS float* wl_ = scal + 512 + (par_) * 128; \
        const float x0 = dr0 + dtb, x1 = dr1 + dtb; \
        const float dt0 = x0 > 20.f ? x0 : log1pf(expf(x0)), dt1 = x1 > 20.f ? x1 : log1pf(expf(x1)); \
        const float s0 = wave_incl_scan(dt0 * Aneg, lane); const float tot0 = __shfl(s0, 63); \
        const float s1 = wave_incl_scan(dt1 * Aneg, lane) + tot0; const float tot = __shfl(s1, 63); \
        dtv_[lane] = dt0; dtv_[64 + lane] = dt1; acum_[lane] = s0 * 1.4426950408889634f; acum_[64 + lane] = s1 * 1.4426950408889634f;     \
        wl_[lane] = dt0 * __expf(tot - s0); wl_[64 + lane] = dt1 * __expf(tot - s1); } while (0)
    SSD_LOADS(0); SSD_LOADS_BC(0);
    if (wave == 0) SSD_SCAN(0);
    __syncthreads();
    for (int c = 0; c < 32; ++c) {
        const int par = c & 1;
        LAS float* dtv = scal + par * 128; LAS float* acum = scal + 256 + par * 128; LAS float* wl = scal + 512 + par * 128;
        const int tok0 = b * SEQ + c * 128;
        f32x4 o2[2][2];
        { const f32x4 ba = *(const LAS f32x4*)(cwt + 256 + xch * 8), bb = *(const LAS f32x4*)(cwt + 256 + xch * 8 + 4); o2[0][0] = ba; o2[0][1] = bb; o2[1][0] = ba; o2[1][1] = bb; }
#pragma unroll
        for (int j = 0; j < 4; ++j) { const f32x4 wa = *(const LAS f32x4*)(cwt + j * 64 + xch * 8), wb = *(const LAS f32x4*)(cwt + j * 64 + xch * 8 + 4);
#pragma unroll
            for (int rr = 0; rr < 2; ++rr) { const u32x4 rv = xraw[rr + j];
                o2[rr][0] += (f32x4){bflo(rv.x), bfhi(rv.x), bflo(rv.y), bfhi(rv.y)} * wa; o2[rr][1] += (f32x4){bflo(rv.z), bfhi(rv.z), bflo(rv.w), bfhi(rv.w)} * wb; } }
        { f32x4 t[2][2];
#pragma unroll
            for (int rr = 0; rr < 2; ++rr)
#pragma unroll
                for (int hq = 0; hq < 2; ++hq)
                    { const f32x4 ta = o2[rr][hq] * -1.4426950408889634f;
#pragma unroll
                      for (int e = 0; e < 4; ++e) t[rr][hq][e] = __builtin_amdgcn_exp2f(ta[e]); }
#pragma unroll
            for (int rr = 0; rr < 2; ++rr)
#pragma unroll
                for (int hq = 0; hq < 2; ++hq)
                    { const f32x4 tb = t[rr][hq] + 1.0f;
#pragma unroll
                      for (int e = 0; e < 4; ++e) t[rr][hq][e] = __builtin_amdgcn_rcpf(tb[e]); }
#pragma unroll
            for (int rr = 0; rr < 2; ++rr)
#pragma unroll
                for (int hq = 0; hq < 2; ++hq) o2[rr][hq] = o2[rr][hq] * t[rr][hq]; }
#pragma unroll
        for (int rr = 0; rr < 2; ++rr) { const f32x4 oa = o2[rr][0], ob = o2[rr][1];
            u32x4 w; w.x = cvt_pk_bf16(oa[0], oa[1]); w.y = cvt_pk_bf16(oa[2], oa[3]); w.z = cvt_pk_bf16(ob[0], ob[1]); w.w = cvt_pk_bf16(ob[2], ob[3]);
            *(LAS u32x4*)(Xs + (xr0 + rr) * XS + xch * 16) = w;
            const float f = wl[xr0 + rr]; const f32x4 pa = oa * f, pb = ob * f;
            w.x = cvt_pk_bf16(pa[0], pa[1]); w.y = cvt_pk_bf16(pa[2], pa[3]); w.z = cvt_pk_bf16(pb[0], pb[1]); w.w = cvt_pk_bf16(pb[2], pb[3]);
            *(LAS u32x4*)(Xw + (xr0 + rr) * XS + xch * 16) = w; }
#pragma unroll
        for (int i = 0; i < 8; ++i) *(LAS u32x4*)(bcdst + 16 * i * BS) = bcraw[i];
        __syncthreads();
        if (c + 1 < 32 && !(VAR & 2)) SSD_LOADS(c + 1);
        {
            const int lt = wave < 4 ? wave : 11 - wave;
            const int l = 16 * lt + l15; const float acl = acum[l];
            const size_t token = (size_t)(tok0 + l);
            bf16_t* zp = P + token * NPROJ + COL_Z + hd * 64 + 4 * q4;
            u32x2 zv[4];
#pragma unroll
            for (int pt = 0; pt < 4; ++pt) { zv[pt] = (u32x2){0x3f803f80u, 0x3f803f80u}; if (!(VAR & 1)) zv[pt] = *(const u32x2*)(zp + 16 * pt); }
            f32x4 Y[4];
#pragma unroll
            for (int pt = 0; pt < 4; ++pt) Y[pt] = (f32x4){0.f, 0.f, 0.f, 0.f};
            bf16x8 Cf[4];
            LAS unsigned char* cbase = Cm + l * BS + q4 * 16;
#pragma unroll
            for (int ks = 0; ks < 4; ++ks) Cf[ks] = *(const LAS bf16x8*)(cbase + ks * 64);
            LAS unsigned char* hbase = Hs + l15 * BS + q4 * 16;
#pragma unroll
            for (int pt = 0; pt < 4; ++pt)
#pragma unroll
                for (int ks = 0; ks < 4; ++ks) { const bf16x8 Hf = *(const LAS bf16x8*)(hbase + pt * 16 * BS + ks * 64); Y[pt] = mfma16(Hf, Cf[ks], Y[pt]); }
            const float eal = __builtin_amdgcn_exp2f(acl);
#pragma unroll
            for (int pt = 0; pt < 4; ++pt) Y[pt] *= eal;
            f32x4 Gt[8];
            f32x4 penv;
#pragma unroll
            for (int e = 0; e < 4; ++e) penv[e] = (4 * q4 + e <= l15) ? 0.f : 1e30f;
            LAS unsigned char* bbase = Bm + l15 * BS + q4 * 16;
#pragma unroll
            for (int st = 0; st < 8; ++st) { Gt[st] = (f32x4){0.f, 0.f, 0.f, 0.f};
                if (st <= lt) {
#pragma unroll
                    for (int ks = 0; ks < 4; ++ks) { const bf16x8 Bf = *(const LAS bf16x8*)(bbase + st * 16 * BS + ks * 64); Gt[st] = mfma16(Bf, Cf[ks], Gt[st]); }
                    const f32x4 as = *(const LAS f32x4*)(acum + 16 * st + 4 * q4), ds = *(const LAS f32x4*)(dtv + 16 * st + 4 * q4);
#pragma unroll
                    for (int e = 0; e < 1; ++e) { const float flagf = (st == lt) ? 1.0f : 0.0f;
                        const f32x4 dv = (acl - as) - penv * flagf;
                        f32x4 fv; fv[0] = __builtin_amdgcn_exp2f(dv[0]); fv[1] = __builtin_amdgcn_exp2f(dv[1]); fv[2] = __builtin_amdgcn_exp2f(dv[2]); fv[3] = __builtin_amdgcn_exp2f(dv[3]);
                        Gt[st] = Gt[st] * (fv * ds); }
                } }
            LAS unsigned char* xbase = Xs + (4 * q4 + (l15 >> 2)) * XS + (l15 & 3) * 8;
#pragma unroll
            for (int kk = 0; kk < 4; ++kk) {
                if (2 * kk <= lt) {
                    u32x4 w; w.x = cvt_pk_bf16(Gt[2 * kk][0], Gt[2 * kk][1]); w.y = cvt_pk_bf16(Gt[2 * kk][2], Gt[2 * kk][3]);
                    w.z = cvt_pk_bf16(Gt[2 * kk + 1][0], Gt[2 * kk + 1][1]); w.w = cvt_pk_bf16(Gt[2 * kk + 1][2], Gt[2 * kk + 1][3]);
                    const bf16x8 Pf = __builtin_bit_cast(bf16x8, w);
#pragma unroll
                    for (int pt = 0; pt < 4; ++pt) {
                        const s16x4 xlo = ldtr(xbase + (32 * kk) * XS + pt * 32);
                        const s16x4 xhi = ldtr(xbase + (32 * kk + 16) * XS + pt * 32);
                        Y[pt] = mfma16(cat8(xlo, xhi), Pf, Y[pt]); }
                } }
            if (c + 1 < 32 && !(VAR & 2)) SSD_LOADS_BC(c + 1);
#pragma unroll
            for (int pt = 0; pt < 4; ++pt) { const int p0 = 16 * pt + 4 * q4;
                const u32x2 xv = *(const LAS u32x2*)(Xs + l * XS + p0 * 2);
                const f32x4 xf = {bflo(xv.x), bfhi(xv.x), bflo(xv.y), bfhi(xv.y)}, zf = {bflo(zv[pt].x), bfhi(zv[pt].x), bflo(zv[pt].y), bfhi(zv[pt].y)};
                const f32x4 yv = (Y[pt] + Dk * xf) * zf;
                u32x2 pk; pk.x = cvt_pk_bf16(yv[0], yv[1]); pk.y = cvt_pk_bf16(yv[2], yv[3]); if (!(VAR & 1)) *(u32x2*)(zp + 16 * pt) = pk; else asm volatile("" :: "v"(pk.x), "v"(pk.y)); }
            const float et = __builtin_amdgcn_exp2f(acum[127]);
#pragma unroll
            for (int pt = 0; pt < 4; ++pt) hacc[pt] *= et;
            LAS unsigned char* btbase = Bm + (4 * q4 + (l15 >> 2)) * BS + (16 * wave + 4 * (l15 & 3)) * 2;
            LAS unsigned char* xwbase = Xw + (4 * q4 + (l15 >> 2)) * XS + (l15 & 3) * 8;
#pragma unroll
            for (int kk = 0; kk < 4; ++kk) {
                const s16x4 blo = ldtr(btbase + (32 * kk) * BS);
                const s16x4 bhi = ldtr(btbase + (32 * kk + 16) * BS);
                const bf16x8 Bf = cat8(blo, bhi);
#pragma unroll
                for (int pt = 0; pt < 4; ++pt) {
                    const s16x4 xlo = ldtr(xwbase + (32 * kk) * XS + pt * 32);
                    const s16x4 xhi = ldtr(xwbase + (32 * kk + 16) * XS + pt * 32);
                    hacc[pt] = mfma16(Bf, cat8(xlo, xhi), hacc[pt]); }
            }
        }
        if (wave == 0 && c + 1 < 32) SSD_SCAN(par ^ 1);
        __syncthreads();
#pragma unroll
        for (int pt = 0; pt < 4; ++pt) { u32x2 pk; pk.x = cvt_pk_bf16(hacc[pt][0], hacc[pt][1]); pk.y = cvt_pk_bf16(hacc[pt][2], hacc[pt][3]);
            *(LAS u32x2*)(Hs + (16 * pt + l15) * BS + (16 * wave + 4 * q4) * 2) = pk; }
    }
#undef SSD_LOADS
#undef SSD_LOADS_BC
#undef SSD_SCAN
    __syncthreads();
}

__device__ __forceinline__ void phase_attn_merge(bf16_t* P, const float* LSE, int lane, int gw, int NGW) {
    const int hh = lane >> 4, dd = (lane & 15) * 8;
#pragma unroll 2
    for (int m = gw; m < M_TOK; m += NGW) {
        bf16_t* op = P + (size_t)m * NPROJ + hh * 128 + dd;
        const float l0 = LSE[(size_t)m * 12 + hh], l1 = LSE[(size_t)m * 12 + 4 + hh], l2 = LSE[(size_t)m * 12 + 8 + hh];
        const u32x4 o0 = *(const u32x4*)op, o1 = *(const u32x4*)(op + 512), o2 = *(const u32x4*)(op + 1024);
        const float mx = fmaxf(l0, fmaxf(l1, l2)); float w0 = __expf(l0 - mx), w1 = __expf(l1 - mx), w2 = __expf(l2 - mx);
        const float inv = 1.0f / (w0 + w1 + w2); w0 *= inv; w1 *= inv; w2 *= inv;
        u32x4 w;
        w.x = cvt_pk_bf16(w0 * bflo(o0.x) + w1 * bflo(o1.x) + w2 * bflo(o2.x), w0 * bfhi(o0.x) + w1 * bfhi(o1.x) + w2 * bfhi(o2.x));
        w.y = cvt_pk_bf16(w0 * bflo(o0.y) + w1 * bflo(o1.y) + w2 * bflo(o2.y), w0 * bfhi(o0.y) + w1 * bfhi(o1.y) + w2 * bfhi(o2.y));
        w.z = cvt_pk_bf16(w0 * bflo(o0.z) + w1 * bflo(o1.z) + w2 * bflo(o2.z), w0 * bfhi(o0.z) + w1 * bfhi(o1.z) + w2 * bfhi(o2.z));
        w.w = cvt_pk_bf16(w0 * bflo(o0.w) + w1 * bflo(o1.w) + w2 * bflo(o2.w), w0 * bfhi(o0.w) + w1 * bfhi(o1.w) + w2 * bfhi(o2.w));
        *(u32x4*)op = w;
    }
}
__device__ __forceinline__ void phase_merge(bf16_t* P, const float* LSE, const float* nw, int lane, int gw, int NGW) {
    f32x4 wa[8], wb[8];
#pragma unroll
    for (int gg = 0; gg < 8; ++gg) { wa[gg] = *(const f32x4*)(nw + gg * 512 + lane * 8); wb[gg] = *(const f32x4*)(nw + gg * 512 + lane * 8 + 4); }
    for (int m = gw; m < M_TOK; m += NGW) {
        bf16_t* rp = P + (size_t)m * NPROJ;
        u32x4 yv[8];
#pragma unroll
        for (int gg = 0; gg < 8; ++gg) yv[gg] = *(const u32x4*)(rp + COL_Z + gg * 512 + lane * 8);
        float ss[8];
#pragma unroll
        for (int gg = 0; gg < 8; ++gg) { const u32x4 v = yv[gg];
            ss[gg] = (bflo(v.x) * bflo(v.x) + bfhi(v.x) * bfhi(v.x)) + (bflo(v.y) * bflo(v.y) + bfhi(v.y) * bfhi(v.y)) + (bflo(v.z) * bflo(v.z) + bfhi(v.z) * bfhi(v.z)) + (bflo(v.w) * bflo(v.w) + bfhi(v.w) * bfhi(v.w)); }
#pragma unroll
        for (int o = 1; o < 64; o <<= 1) {
#pragma unroll
            for (int gg = 0; gg < 8; ++gg) ss[gg] += __shfl_xor(ss[gg], o); }
#pragma unroll
        for (int gg = 0; gg < 8; ++gg) { const u32x4 v = yv[gg];
            const float rs = 1.0f / sqrtf(ss[gg] * (1.0f / 512.0f) + 1e-6f);
            u32x4 w; w.x = cvt_pk_bf16(bflo(v.x) * rs * wa[gg].x, bfhi(v.x) * rs * wa[gg].y); w.y = cvt_pk_bf16(bflo(v.y) * rs * wa[gg].z, bfhi(v.y) * rs * wa[gg].w);
            w.z = cvt_pk_bf16(bflo(v.z) * rs * wb[gg].x, bfhi(v.z) * rs * wb[gg].y); w.w = cvt_pk_bf16(bflo(v.w) * rs * wb[gg].z, bfhi(v.w) * rs * wb[gg].w);
            *(u32x4*)(rp + COL_Z + gg * 512 + lane * 8) = w; }
    }
}

#define GAS __attribute__((address_space(1)))
#define XB_TMO      128
#define XB_XCNT(j)  (256  + 64 * (j))
#define XB_XSUB(j)  (1280 + 64 * (j))
#define XB_XGEN(j)  (2304 + 64 * (j))
#define XB_TOP      3328
#define XB_TOPGEN   3392
#define XCD_BAR_WORDS 3456
#define XB_SPIN_CAP (1u << 18)

__device__ __forceinline__ unsigned xb_ld(unsigned* p)              { return __hip_atomic_load(p, __ATOMIC_RELAXED, __HIP_MEMORY_SCOPE_AGENT); }
__device__ __forceinline__ unsigned xb_add(unsigned* p, unsigned v) { return __hip_atomic_fetch_add(p, v, __ATOMIC_RELAXED, __HIP_MEMORY_SCOPE_AGENT); }
__device__ __forceinline__ unsigned xb_xcc_id() { return (unsigned)__builtin_amdgcn_s_getreg((3 << 11) | 20) & 0xFu; }
#define XB_SPIN(cond, bar) do { unsigned _sp = 0; while (cond) { __builtin_amdgcn_s_sleep(1); \
    if ((++_sp & 255u) == 0u) { if (xb_ld(&(bar)[XB_TMO])) break; if (_sp > XB_SPIN_CAP) { atomicAdd(&(bar)[XB_TMO], 1u); break; } } } } while (0)

struct XcdBarrier {
    unsigned* bar; unsigned x;
    volatile LAS unsigned* st;
};

__device__ __forceinline__ XcdBarrier xcd_barrier_post(unsigned* bar, volatile LAS unsigned* st) {
    XcdBarrier b; b.bar = bar; b.x = xb_xcc_id(); b.st = st;
    if (threadIdx.x == 0) (void)xb_add(&bar[XB_XCNT(b.x)], 1u);
    return b;
}
__device__ __forceinline__ void xcd_barrier_complete(unsigned* bar, unsigned x, unsigned& nloc, unsigned& nx) {
    const unsigned G = gridDim.x * gridDim.y * gridDim.z;
    unsigned sum, cnt, mine, sp = 0u;
    for (;;) {
        sum = 0u; cnt = 0u; mine = 0u;
#pragma unroll
        for (unsigned j = 0; j < 16; ++j) { const unsigned c = xb_ld(&bar[XB_XCNT(j)]); sum += c; cnt += (c > 0u) ? 1u : 0u; mine = (j == x) ? c : mine; }
        if (sum == G) break;
        __builtin_amdgcn_s_sleep(1);
        if ((++sp & 255u) == 0u) { if (xb_ld(&bar[XB_TMO])) break; if (sp > XB_SPIN_CAP) { atomicAdd(&bar[XB_TMO], 1u); break; } }
    }
    nloc = mine > 0u ? mine : 1u; nx = cnt > 0u ? cnt : 1u;
}

__device__ __forceinline__ void xcd_barrier(const XcdBarrier& b) {
    asm volatile("s_waitcnt vmcnt(0)" ::: "memory");
    __syncthreads();
    if (threadIdx.x == 0) {
        unsigned* bar = b.bar;
        __builtin_amdgcn_s_waitcnt(0);
        unsigned nloc = b.st[0], nx = b.st[1];
        if (nloc == 0u) { xcd_barrier_complete(bar, b.x, nloc, nx); b.st[0] = nloc; b.st[1] = nx; }
        const unsigned old = xb_add(&bar[XB_XSUB(b.x)], 1u);
        const unsigned gen = old / nloc;
        if (old + 1u == (gen + 1u) * nloc) {
            __builtin_amdgcn_fence(__ATOMIC_RELEASE, "agent");
            asm volatile("s_waitcnt vmcnt(0)" ::: "memory");
            const unsigned og = xb_add(&bar[XB_TOP], 1u);
            const unsigned tg = og / nx;
            if (og + 1u == (tg + 1u) * nx) xb_add(&bar[XB_TOPGEN], 1u);
            else XB_SPIN(xb_ld(&bar[XB_TOPGEN]) == tg, bar);
            __builtin_amdgcn_fence(__ATOMIC_ACQUIRE, "agent");
            xb_add(&bar[XB_XGEN(b.x)], 1u);
            asm volatile("s_waitcnt vmcnt(0)" ::: "memory");
        } else {
            XB_SPIN(xb_ld(&bar[XB_XGEN(b.x)]) == gen, bar);
            __builtin_amdgcn_fence(__ATOMIC_ACQUIRE, "agent");
            asm volatile("s_waitcnt vmcnt(0)" ::: "memory");
        }
    }
    __syncthreads();
}

#ifndef PROBE_MODE
#define PROBE_MODE 0
#endif
#ifndef PROBE_VAR
#define PROBE_VAR 0
#endif
#ifndef MK_SINGLE
#define MK_SINGLE 1
#endif
__global__ void __launch_bounds__(512, 2) fwd_kernel(Args a) {
    extern __shared__ __attribute__((aligned(16))) unsigned char lds_raw[];
    LAS unsigned char* lds = (LAS unsigned char*)lds_raw;
    cg::grid_group grid = cg::this_grid();
    const int bx = blockIdx.x, G = gridDim.x, NGW = G * 8;
    const int lo = a.ph_lo, hi = a.ph_hi;
    volatile LAS unsigned* MISC = (volatile LAS unsigned*)(lds + LDS_BYTES - 64);
    if (threadIdx.x < 16) MISC[threadIdx.x] = 0u;
    __syncthreads();
    const XcdBarrier xbar = xcd_barrier_post((unsigned*)(a.ws + WS_CTL), MISC);
#define PH_IDS int tid = threadIdx.x; asm volatile("" : "+v"(tid)); const int lane = tid & 63, wave = __builtin_amdgcn_readfirstlane(tid >> 6), gw = bx * 8 + wave; (void)lane; (void)gw
    unsigned char* ws = a.ws;
    float* MOD = (float*)(ws + WS_MOD); float* LSE = (float*)(ws + WS_LSE); float* DT = (float*)(ws + WS_DT);
    bf16_t* H = (bf16_t*)(ws + WS_H); bf16_t* P = (bf16_t*)(ws + WS_PROJ);
    float* out = a.out;
#define IN(k) (lo <= (k) && (k) < hi)
#define SEAM(k) do { if (IN(k) && IN((k) + 1)) xcd_barrier(xbar); } while (0)
    if (lo < -1000) grid.sync();
    if (IN(0)) { PH_IDS; phase_prep(a, lds, tid, lane, wave, bx, G); }
    SEAM(0);
#if PROBE_MODE == 5
    if (IN(0) && IN(1)) { { PH_IDS; phase_prep(a, lds, tid, lane, wave, bx, G); } grid.sync(); }
#endif
#pragma unroll 1
    for (int l = 0; l < 2; ++l) {
        const int pb = 1 + 10 * l;
        const float* mod = MOD + (size_t)l * 4 * 12288;
        unsigned char* wb = ws + WS_W + (size_t)l * WL_BYTES;
        const float* xin = (l == 0) ? a.in[0] : out;
        if (IN(pb + 0)) { PH_IDS; phase_norm<false>(xin, a.in[3] + l * 2048, mod + 2048, mod, H, nullptr, lane, gw, NGW); }
        SEAM(pb + 0);
#if PROBE_MODE == 6
        if (IN(pb + 0) && IN(pb + 1)) { { PH_IDS; phase_norm<false>(xin, a.in[3] + l * 2048, mod + 2048, mod, H, nullptr, lane, gw, NGW); } grid.sync(); }
#endif
        if (IN(pb + 1)) { pg8::Gemm g{H, (const bf16_t*)(wb + WO_IN), M_TOK, NPROJ, 2048, 2048}; pg8::StaticOrder S; S.init(M_TOK, NPROJ, G, bx);
            pg8::EpiProj E{P, DT}; pg8::gemm_phase<pg8::EpiProj, pg8::StaticOrder, true, true>(lds, g, S, E); }
        SEAM(pb + 1);
        if (IN(pb + 2)) { PH_IDS;
            phase_attn(P, LSE, a.in[2], lds, bx, G, tid);
            phase_convbc(P, H, a.in[8] + (size_t)l * 4 * 6144, a.in[9] + (size_t)l * 6144, tid, bx, G);
        }
        SEAM(pb + 2);
        if (IN(pb + 3)) { PH_IDS;
            for (int u = bx; u < 256; u += G) {
                const int xcd = u & 7, slot = u >> 3, gb = xcd * 4 + (slot >> 3), b = gb >> 3, hd = (gb & 7) * 8 + (slot & 7);
                ssd_unit<0>(P, H, DT, a.in[8] + (size_t)l * 4 * 6144, a.in[9] + (size_t)l * 6144, a.in[10][l * 64 + hd], -expf(a.in[11][l * 64 + hd]), a.in[12][l * 64 + hd], lds, b, hd, tid, lane, wave); }
            phase_attn_merge(P, LSE, lane, gw, NGW);
        }
        SEAM(pb + 3);
        if (IN(pb + 4)) { PH_IDS; phase_merge(P, LSE, a.in[13] + (size_t)l * 4096, lane, gw, NGW); }
        SEAM(pb + 4);
        if (IN(pb + 5)) {
            { pg8::Gemm g{P + COL_Q, (const bf16_t*)(wb + WO_A), M_TOK, 2048, 512, NPROJ}; pg8::StaticOrder S; S.init(M_TOK, 2048, G, bx);
              pg8::EpiGate<0> E{H, 2048, P + COL_GA, NPROJ}; pg8::gemm_phase<pg8::EpiGate<0>, pg8::StaticOrder, true, true>(lds, g, S, E); }
            { pg8::Gemm g{P + COL_Z, (const bf16_t*)(wb + WO_S), M_TOK, 2048, 4096, NPROJ}; pg8::StaticOrder S; S.init(M_TOK, 2048, G, bx);
              pg8::EpiGate<1> E{H, 2048, P + COL_GS, NPROJ}; pg8::gemm_phase<pg8::EpiGate<1>, pg8::StaticOrder, true, true>(lds, g, S, E); }
        }
        SEAM(pb + 5);
#if PROBE_MODE > 0
        if (IN(pb + 5) && IN(pb + 6)) { PH_IDS;
#if PROBE_MODE == 1
            phase_attn(P, LSE, a.in[2], lds, bx, G, tid);
#elif PROBE_MODE == 2
            for (int u = bx; u < 256; u += G) {
                const int xcd = u & 7, slot = u >> 3, gb = xcd * 4 + (slot >> 3), b = gb >> 3, hd = (gb & 7) * 8 + (slot & 7);
                ssd_unit<PROBE_VAR>(P, H, DT, a.in[8] + (size_t)l * 4 * 6144, a.in[9] + (size_t)l * 6144, a.in[10][l * 64 + hd], -expf(a.in[11][l * 64 + hd]), a.in[12][l * 64 + hd], lds, b, hd, tid, lane, wave); }
#elif PROBE_MODE == 3
            phase_merge(P, LSE, a.in[13] + (size_t)l * 4096, lane, gw, NGW);
#elif PROBE_MODE == 4
            phase_convbc(P, P + (size_t)200000000, a.in[8] + (size_t)l * 4 * 6144, a.in[9] + (size_t)l * 6144, tid, bx, G);
#endif
            grid.sync(); }
#endif
        if (IN(pb + 6)) { pg8::Gemm g{H, (const bf16_t*)(wb + WO_O), M_TOK, 2048, 2048, 2048}; pg8::StaticOrder S; S.init(M_TOK, 2048, G, bx);
            pg8::EpiRes E{xin, out, mod + 4096, 12288}; pg8::gemm_phase<pg8::EpiRes, pg8::StaticOrder, true, true>(lds, g, S, E); }
        SEAM(pb + 6);
        if (IN(pb + 7)) { PH_IDS; phase_norm<false>(out, a.in[4] + l * 2048, mod + 8192, mod + 6144, H, nullptr, lane, gw, NGW); }
        SEAM(pb + 7);
        if (IN(pb + 8)) { pg8::Gemm g{H, (const bf16_t*)(wb + WO_FI), M_TOK, 2 * D_FF, 2048, 2048}; pg8::StaticOrder S; S.init(M_TOK, 2 * D_FF, G, bx);
            pg8::EpiSwiglu E{P, D_FF}; pg8::gemm_phase<pg8::EpiSwiglu, pg8::StaticOrder, true, true>(lds, g, S, E); }
        SEAM(pb + 8);
        if (IN(pb + 9)) { pg8::Gemm g{P, (const bf16_t*)(wb + WO_FO), M_TOK, 2048, D_FF, D_FF}; pg8::StaticOrder S; S.init(M_TOK, 2048, G, bx);
            pg8::EpiRes E{out, out, mod + 10240, 12288}; pg8::gemm_phase<pg8::EpiRes, pg8::StaticOrder, true, true>(lds, g, S, E); }
        SEAM(pb + 9);
    }
#if PROBE_MODE == 7
    if (IN(20) && IN(21)) { for (int i = 0; i < 20; ++i) grid.sync(); }
#endif
    if (IN(21)) { PH_IDS; phase_norm<true>(out, a.in[19], nullptr, nullptr, nullptr, out, lane, gw, NGW); }
#undef IN
#undef SEAM
}

extern "C" void kernel_launch(void* const* d_in, const int* in_sizes, int n_in, void* d_out, int out_size, void* d_ws, size_t ws_size, hipStream_t stream) {
    static int grid = 0;
    if (grid == 0) {
        if (n_in != 20 || out_size != M_TOK * D_MODEL || ws_size < WS_END + MiB) { fprintf(stderr, "kernel_launch: unexpected shapes (n_in %d out %d ws %zu need %zu)\n", n_in, out_size, ws_size, (size_t)WS_END); grid = -1; return; }
        int dev = 0, cus = 0, per_cu = 0;
        (void)hipGetDevice(&dev); (void)hipDeviceGetAttribute(&cus, hipDeviceAttributeMultiprocessorCount, dev);
        if (hipFuncSetAttribute((const void*)fwd_kernel, hipFuncAttributeMaxDynamicSharedMemorySize, LDS_BYTES) != hipSuccess) { fprintf(stderr, "kernel_launch: hipFuncSetAttribute failed\n"); grid = -1; return; }
        if (hipOccupancyMaxActiveBlocksPerMultiprocessor(&per_cu, (const void*)fwd_kernel, 512, LDS_BYTES) != hipSuccess || per_cu < 1) { fprintf(stderr, "kernel_launch: occupancy query gave %d\n", per_cu); per_cu = 1; }
        (void)hipGetLastError();
        grid = cus * 1;
        if (grid <= 0) grid = 256;
    }
    if (grid < 0) return;
    (void)hipMemsetAsync((char*)d_ws + WS_CTL, 0, 16384, stream);
    Args a{};
    for (int i = 0; i < 20; ++i) a.in[i] = (const float*)d_in[i];
    a.out = (float*)d_out; a.ws = (unsigned char*)d_ws;
    void* args[] = {&a};
#if MK_SINGLE
    a.ph_lo = 0; a.ph_hi = NPHASE;
    hipError_t e = hipLaunchCooperativeKernel((const void*)fwd_kernel, dim3(grid), dim3(512), args, LDS_BYTES, stream);
    if (e != hipSuccess) fprintf(stderr, "cooperative launch failed: %s (grid %d)\n", hipGetErrorString(e), grid);
#else
    for (int ph = 0; ph < NPHASE; ++ph) { a.ph_lo = ph; a.ph_hi = ph + 1;
        hipError_t e = hipLaunchCooperativeKernel((const void*)fwd_kernel, dim3(grid), dim3(512), args, LDS_BYTES, stream);
        if (e != hipSuccess) { fprintf(stderr, "cooperative launch %d failed: %s (grid %d)\n", ph, hipGetErrorString(e), grid); break; } }
#endif
}
```

```cpp
#include <hip/hip_runtime.h>
#include <hip/hip_cooperative_groups.h>
#include <cstdio>
#include <cstdint>
#include <cmath>
namespace cg = cooperative_groups;
namespace pg8 {
#define PG8_LAS __attribute__((address_space(3)))
typedef unsigned short bf16_t;
typedef short bf16x8 __attribute__((ext_vector_type(8)));
typedef float f32x4 __attribute__((ext_vector_type(4)));
typedef unsigned u32x4 __attribute__((ext_vector_type(4)));
__device__ __forceinline__ int lane_id_mbcnt() { int l; asm volatile("v_mbcnt_lo_u32_b32 %0, -1, 0\n\tv_mbcnt_hi_u32_b32 %0, -1, %0" : "=v"(l)); return l; }
constexpr int BM = 256, BK = 64, HALF = 128, HTB = HALF * BK * 2  , STAGE_BYTES = 8 * HTB, NXCD = 8, WGM = 8;

__host__ __device__ __forceinline__ int lds_byte(int r, int c) { const int st = (r >> 4) * 2 + (c >> 5), rr = r & 15, cc = c & 31, ob = rr * 64 + cc * 2; return st * 1024 + (ob ^ (((ob >> 9) & 1) << 5)); }
__host__ __device__ __forceinline__ void stage_rc(int b, int& R, int& C) { const int st = b / 1024, sb = b % 1024, swz = sb ^ (((sb >> 9) & 1) << 5); R = (st >> 1) * 16 + swz / 64; C = (st & 1) * 32 + (swz % 64) / 2; }
__host__ __device__ __forceinline__ int perm32(int rho) { const int n = rho >> 4, i = rho & 15; return 8 * (i >> 2) + 4 * n + (i & 3); }

struct Unit { int pm, pn; };
struct Gemm { const bf16_t* A; const bf16_t* Bt; int M, N, K, lda; };

struct StaticOrder {
    int nM, nN, nwg, G, c;
    __host__ __device__ void init(int M, int N, int G_, int c_) { nM = M / BM; nN = N / BM; nwg = nM * nN; G = G_; c = c_; }
    __host__ __device__ bool next(int i, Unit& u) const {
        const long L = (long)i * G + c; if (L >= nwg) return false;
        int wgid = (int)L; { const int q = nwg / NXCD, r = nwg % NXCD, xcd = wgid % NXCD, off = wgid / NXCD; wgid = (xcd < r ? xcd * (q + 1) : r * (q + 1) + (xcd - r) * q) + off; }
        const int nig = WGM * nN, gid = wgid / nig, fm = gid * WGM, gsz = (nM - fm) < WGM ? (nM - fm) : WGM;
        u.pm = fm + ((wgid % nig) % gsz); u.pn = (wgid % nig) / gsz; return true;
    }
    __device__ __forceinline__ void a_ready(const Unit&) const {}
    __device__ __forceinline__ void done(const Unit&) const {}
};

__device__ __forceinline__ unsigned cvt_pk_bf16(float lo, float hi) { unsigned r; asm volatile("v_cvt_pk_bf16_f32 %0, %1, %2" : "=v"(r) : "v"(lo), "v"(hi)); return r; }
__device__ __forceinline__ float bflo(unsigned u) { return __uint_as_float(u << 16); }
__device__ __forceinline__ float bfhi(unsigned u) { return __uint_as_float(u & 0xffff0000u); }
__device__ __forceinline__ float sigmoidf_(float x) { return __builtin_amdgcn_rcpf(1.f + __expf(-x)); }
__device__ __forceinline__ float siluf_(float x) { return x * __builtin_amdgcn_rcpf(1.f + __expf(-x)); }

constexpr int NPROJ = 19200;
struct EpiProj {
    static constexpr bool PERM = true, AFTER_DRAIN = false;
    bf16_t* O; float* DT;
    __device__ __forceinline__ void operator()(const f32x4 (&acc)[2][2][4][2], const Unit& u, int wr, int wc, int fr, int fq) const {
        const int row0 = u.pm * BM + wr * 64 + fr;
        if (u.pn == 74) {
            if (wc < 2) {
#pragma unroll
                for (int ai = 0; ai < 2; ++ai)
#pragma unroll
                    for (int m = 0; m < 4; ++m) { float* p = DT + (size_t)(row0 + ai * HALF + m * 16) * 64 + wc * 32 + 8 * fq;
                        *(f32x4*)p = acc[ai][0][m][0]; *(f32x4*)(p + 4) = acc[ai][0][m][1]; }
            }
            return;
        }
        const bool sg = u.pn >= 58, zs = u.pn >= 18 && u.pn < 34;
        const int col0 = u.pn * BM + wc * 32 + 8 * fq;
#pragma unroll
        for (int ai = 0; ai < 2; ++ai)
#pragma unroll
            for (int m = 0; m < 4; ++m) { bf16_t* rowp = O + (size_t)(row0 + ai * HALF + m * 16) * NPROJ + col0;
#pragma unroll
                for (int bj = 0; bj < 2; ++bj) { f32x4 v0 = acc[ai][bj][m][0], v1 = acc[ai][bj][m][1];
                    if (sg || zs) { f32x4 t0, t1;
#pragma unroll
                        for (int j = 0; j < 4; ++j) { t0[j] = __expf(-v0[j]); t1[j] = __expf(-v1[j]); }
#pragma unroll
                        for (int j = 0; j < 4; ++j) { t0[j] = __builtin_amdgcn_rcpf(1.f + t0[j]); t1[j] = __builtin_amdgcn_rcpf(1.f + t1[j]); }
                        if (sg) { v0 = t0; v1 = t1; } else { v0 = v0 * t0; v1 = v1 * t1; } }
                    u32x4 w; w.x = cvt_pk_bf16(v0[0], v0[1]); w.y = cvt_pk_bf16(v0[2], v0[3]); w.z = cvt_pk_bf16(v1[0], v1[1]); w.w = cvt_pk_bf16(v1[2], v1[3]);
                    *(u32x4*)(rowp + bj * HALF) = w; } }
    }
};
template <int MODE> struct EpiGate {
    static constexpr bool PERM = true, AFTER_DRAIN = false;
    bf16_t* O; int ldc; const bf16_t* G; int ldg;
    __device__ __forceinline__ void operator()(const f32x4 (&acc)[2][2][4][2], const Unit& u, int wr, int wc, int fr, int fq) const {
        const int row0 = u.pm * BM + wr * 64 + fr; const int col0 = u.pn * BM + wc * 32 + 8 * fq;
#pragma unroll
        for (int ai = 0; ai < 2; ++ai)
#pragma unroll
            for (int m = 0; m < 4; ++m) { const size_t row = (size_t)(row0 + ai * HALF + m * 16);
#pragma unroll
                for (int bj = 0; bj < 2; ++bj) { const int col = col0 + bj * HALF;
                    const u32x4 gv = *(const u32x4*)(G + row * ldg + col);
                    f32x4 v0 = acc[ai][bj][m][0], v1 = acc[ai][bj][m][1];
                    v0[0] *= bflo(gv.x); v0[1] *= bfhi(gv.x); v0[2] *= bflo(gv.y); v0[3] *= bfhi(gv.y);
                    v1[0] *= bflo(gv.z); v1[1] *= bfhi(gv.z); v1[2] *= bflo(gv.w); v1[3] *= bfhi(gv.w);
                    bf16_t* op = O + row * ldc + col;
                    if (MODE == 1) { const u32x4 ov = *(const u32x4*)op;
                        v0[0] += bflo(ov.x); v0[1] += bfhi(ov.x); v0[2] += bflo(ov.y); v0[3] += bfhi(ov.y);
                        v1[0] += bflo(ov.z); v1[1] += bfhi(ov.z); v1[2] += bflo(ov.w); v1[3] += bfhi(ov.w); }
                    u32x4 w; w.x = cvt_pk_bf16(v0[0], v0[1]); w.y = cvt_pk_bf16(v0[2], v0[3]); w.z = cvt_pk_bf16(v1[0], v1[1]); w.w = cvt_pk_bf16(v1[2], v1[3]);
                    *(u32x4*)op = w; } }
    }
};
struct EpiRes {
    static constexpr bool PERM = false, AFTER_DRAIN = false;
    const float* xin; float* out; const float* gate; int gstride;
    __device__ __forceinline__ void operator()(const f32x4 (&acc)[2][2][4][2], const Unit& u, int wr, int wc, int fr, int fq) const {
        const int row0 = u.pm * BM + wr * 64 + fr; const int col0 = u.pn * BM + wc * 32 + 4 * fq;
        const float* gp = gate + (size_t)(u.pm >> 4) * gstride + col0;
        f32x4 gv[2][2];
#pragma unroll
        for (int bj = 0; bj < 2; ++bj)
#pragma unroll
            for (int n = 0; n < 2; ++n) gv[bj][n] = *(const f32x4*)(gp + bj * HALF + n * 16);
#pragma unroll
        for (int ai = 0; ai < 2; ++ai)
#pragma unroll
            for (int m = 0; m < 4; ++m) { const size_t off = (size_t)(row0 + ai * HALF + m * 16) * 2048 + col0;
#pragma unroll
                for (int bj = 0; bj < 2; ++bj)
#pragma unroll
                    for (int n = 0; n < 2; ++n) { const f32x4 xv = *(const f32x4*)(xin + off + bj * HALF + n * 16);
                        *(f32x4*)(out + off + bj * HALF + n * 16) = xv + gv[bj][n] * acc[ai][bj][m][n]; } }
    }
};
struct EpiSwiglu {
    static constexpr bool PERM = true, AFTER_DRAIN = false;
    bf16_t* O; int ldc;
    __device__ __forceinline__ void operator()(const f32x4 (&acc)[2][2][4][2], const Unit& u, int wr, int wc, int fr, int fq) const {
        const int row0 = u.pm * BM + wr * 64 + fr; const int col0 = u.pn * HALF + wc * 32 + 8 * fq;
#pragma unroll
        for (int ai = 0; ai < 2; ++ai)
#pragma unroll
            for (int m = 0; m < 4; ++m) { bf16_t* op = O + (size_t)(row0 + ai * HALF + m * 16) * ldc + col0;
                f32x4 v0, v1;
#pragma unroll
                for (int j = 0; j < 4; ++j) { v0[j] = siluf_(acc[ai][0][m][0][j]) * acc[ai][1][m][0][j]; v1[j] = siluf_(acc[ai][0][m][1][j]) * acc[ai][1][m][1][j]; }
                u32x4 w; w.x = cvt_pk_bf16(v0[0], v0[1]); w.y = cvt_pk_bf16(v0[2], v0[3]); w.z = cvt_pk_bf16(v1[0], v1[1]); w.w = cvt_pk_bf16(v1[2], v1[3]);
                *(u32x4*)op = w; }
    }
};

template <class Epi, class Sched, bool ALIGN_EPI = false, bool SP2 = false>
__device__ __forceinline__ void gemm_phase(PG8_LAS unsigned char* lds, const Gemm g, const Sched& S, const Epi& E, int wave_s) {
    int tid = wave_s * 64 + lane_id_mbcnt(); asm volatile("" : "+v"(tid));        const int wid = __builtin_amdgcn_readfirstlane(tid >> 6), lane = tid & 63, wr = wid >> 2, wc = wid & 3, fr = lane & 15, fq = lane >> 4;
    const int K = g.K, nt = K / BK;
    unsigned voffA[2], voffB[2];
#pragma unroll
    for (int i = 0; i < 2; ++i) { int R, C; stage_rc(tid * 16 + i * 8192, R, C); const int Rb = Epi::PERM ? ((R & ~31) + perm32(R & 31)) : R;
        voffA[i] = (unsigned)(R * g.lda + C) * 2u; voffB[i] = (unsigned)(Rb * K + C) * 2u; }
    const size_t kstep = (size_t)(BK * 2);
    const size_t hstepA = (size_t)HALF * g.lda * 2, hstepB = (size_t)HALF * K * 2;
    const size_t tstepA = 2 * hstepA, tstepB = 2 * hstepB;
    const unsigned ldsw = (unsigned)wid * 1024u;
    const int aoff = lds_byte(wr * 64 + fr, fq * 8), boff = lds_byte(wc * 32 + fr, fq * 8);
#define PG8_SA(b, h) (((b) * 2 + (h)) * HTB)
#define PG8_SB(b, h) ((4 + (b) * 2 + (h)) * HTB)
#define PG8_STAGE(bufoff, gbase, voff) do { _Pragma("unroll") for (int _i = 0; _i < 2; ++_i) \
        __builtin_amdgcn_global_load_lds((const unsigned*)((const char*)(gbase) + (voff)[_i]), (PG8_LAS unsigned*)(lds + (bufoff) + ldsw + _i * 8192), 16, 0, 0); } while (0)
#define PG8_LDA(dst, b, h) do { _Pragma("unroll") for (int m = 0; m < 4; ++m) _Pragma("unroll") for (int k = 0; k < 2; ++k) dst[m][k] = *(const PG8_LAS bf16x8*)(lds + PG8_SA(b, h) + aoff + m * 2048 + k * 1024); } while (0)
#define PG8_LDB(dst, b, h) do { _Pragma("unroll") for (int n = 0; n < 2; ++n) _Pragma("unroll") for (int k = 0; k < 2; ++k) dst[n][k] = *(const PG8_LAS bf16x8*)(lds + PG8_SB(b, h) + boff + n * 2048 + k * 1024); } while (0)
#define PG8_MMA(ai, bj, At, Bt) do { __builtin_amdgcn_s_setprio(1); _Pragma("unroll") for (int m = 0; m < 4; ++m) _Pragma("unroll") for (int n = 0; n < 2; ++n) _Pragma("unroll") for (int k = 0; k < 2; ++k) \
        acc[ai][bj][m][n] = __builtin_amdgcn_mfma_f32_16x16x32_bf16(Bt[n][k], At[m][k], acc[ai][bj][m][n], 0, 0, 0); __builtin_amdgcn_s_setprio(0); } while (0)
#define PG8_WAIT_V(n) asm volatile("s_waitcnt vmcnt(" #n ")" ::: "memory")
#define PG8_WAIT_L(n) asm volatile("s_waitcnt lgkmcnt(" #n ")" ::: "memory")
#define PG8_BAR __builtin_amdgcn_s_barrier()
#define PG8_SCHED __builtin_amdgcn_sched_barrier(0)
    Unit cur, nxt; int ui = 0;
    if (!S.next(0, cur)) return;
    f32x4 acc[2][2][4][2];
#pragma unroll
    for (int a = 0; a < 2; ++a)
#pragma unroll
        for (int b = 0; b < 2; ++b)
#pragma unroll
            for (int m = 0; m < 4; ++m)
#pragma unroll
                for (int n = 0; n < 2; ++n) acc[a][b][m][n] = (f32x4){0.f, 0.f, 0.f, 0.f};
    bf16x8 At[4][2], B0[2][2], B1[2][2];
    const char* cA = (const char*)g.A + (size_t)cur.pm * tstepA; const char* cB = (const char*)g.Bt + (size_t)cur.pn * tstepB;
    S.a_ready(cur);
    if constexpr (SP2) {
        PG8_STAGE(PG8_SB(0, 0), cB, voffB); PG8_STAGE(PG8_SB(0, 1), cB + hstepB, voffB); PG8_STAGE(PG8_SA(0, 0), cA, voffA); PG8_STAGE(PG8_SA(0, 1), cA + hstepA, voffA);
        if (wr == 1) PG8_BAR;
        PG8_WAIT_V(2); PG8_BAR;
        PG8_STAGE(PG8_SB(1, 0), cB + kstep, voffB); PG8_STAGE(PG8_SA(1, 0), cA + kstep, voffA); PG8_STAGE(PG8_SB(1, 1), cB + hstepB + kstep, voffB);
        PG8_WAIT_V(6); PG8_BAR;
    } else {
        PG8_STAGE(PG8_SB(0, 0), cB, voffB); PG8_STAGE(PG8_SA(0, 0), cA, voffA); PG8_STAGE(PG8_SB(0, 1), cB + hstepB, voffB); PG8_STAGE(PG8_SA(0, 1), cA + hstepA, voffA);
        if (wr == 1) PG8_BAR;
        PG8_WAIT_V(4); PG8_BAR;
        PG8_STAGE(PG8_SB(1, 0), cB + kstep, voffB); PG8_STAGE(PG8_SA(1, 0), cA + kstep, voffA); PG8_STAGE(PG8_SB(1, 1), cB + hstepB + kstep, voffB);
        PG8_WAIT_V(6); PG8_BAR;
    }
    for (;;) {
        const bool has_next = S.next(ui + 1, nxt);
        const char* nA = has_next ? (const char*)g.A + (size_t)nxt.pm * tstepA : cA; const char* nB = has_next ? (const char*)g.Bt + (size_t)nxt.pn * tstepB : cB;
        for (int t = 0; t < nt; t += 2) {
            const bool last = (t == nt - 2);
            const char* a1 = cA + (size_t)(t + 1) * kstep;
            const char* a2 = last ? nA : cA + (size_t)(t + 2) * kstep; const char* b2 = last ? nB : cB + (size_t)(t + 2) * kstep;
            const char* a3 = a2 + kstep; const char* b3 = b2 + kstep;
            if (last && has_next) S.a_ready(nxt);
            if constexpr (SP2) {
            PG8_LDB(B0, 0, 0); PG8_LDB(B1, 0, 1); PG8_SCHED; PG8_LDA(At, 0, 0); PG8_STAGE(PG8_SA(1, 1), a1 + hstepA, voffA);
            PG8_WAIT_V(8); PG8_WAIT_L(0); PG8_BAR; PG8_MMA(0, 0, At, B0); PG8_MMA(0, 1, At, B1); PG8_BAR; PG8_SCHED;
            PG8_LDA(At, 0, 1); PG8_STAGE(PG8_SB(0, 0), b2, voffB); PG8_STAGE(PG8_SB(0, 1), b2 + hstepB, voffB); PG8_STAGE(PG8_SA(0, 0), a2, voffA);
            PG8_WAIT_V(8); PG8_WAIT_L(0); PG8_BAR; PG8_MMA(1, 0, At, B0); PG8_MMA(1, 1, At, B1); PG8_BAR; PG8_SCHED;
            PG8_LDB(B0, 1, 0); PG8_LDB(B1, 1, 1); PG8_SCHED; PG8_LDA(At, 1, 0); PG8_STAGE(PG8_SA(0, 1), a2 + hstepA, voffA);
            PG8_WAIT_V(8); PG8_WAIT_L(0); PG8_BAR; PG8_MMA(0, 0, At, B0); PG8_MMA(0, 1, At, B1); PG8_BAR; PG8_SCHED;
            PG8_LDA(At, 1, 1); PG8_STAGE(PG8_SB(1, 0), b3, voffB); PG8_STAGE(PG8_SB(1, 1), b3 + hstepB, voffB); PG8_STAGE(PG8_SA(1, 0), a3, voffA);
            PG8_WAIT_V(8); PG8_WAIT_L(0); PG8_BAR; PG8_MMA(1, 0, At, B0); PG8_MMA(1, 1, At, B1); PG8_BAR; PG8_SCHED;
            } else {
            PG8_LDB(B0, 0, 0); PG8_SCHED; PG8_LDA(At, 0, 0); PG8_STAGE(PG8_SA(1, 1), a1 + hstepA, voffA);
            PG8_WAIT_L(8); PG8_BAR; PG8_WAIT_L(0); PG8_MMA(0, 0, At, B0); PG8_BAR; PG8_SCHED;
            PG8_LDB(B1, 0, 1); PG8_STAGE(PG8_SB(0, 0), b2, voffB);
            PG8_BAR; PG8_WAIT_L(0); PG8_MMA(0, 1, At, B1); PG8_BAR;
            PG8_LDA(At, 0, 1); PG8_STAGE(PG8_SA(0, 0), a2, voffA);
            PG8_BAR; PG8_WAIT_L(0); PG8_MMA(1, 0, At, B0); PG8_BAR; PG8_SCHED;
            PG8_STAGE(PG8_SB(0, 1), b2 + hstepB, voffB);
            PG8_WAIT_V(6); PG8_BAR; PG8_MMA(1, 1, At, B1); PG8_BAR;
            PG8_LDB(B0, 1, 0); PG8_SCHED; PG8_LDA(At, 1, 0); PG8_STAGE(PG8_SA(0, 1), a2 + hstepA, voffA);
            PG8_WAIT_L(8); PG8_BAR; PG8_WAIT_L(0); PG8_MMA(0, 0, At, B0); PG8_BAR; PG8_SCHED;
            PG8_LDB(B1, 1, 1); PG8_STAGE(PG8_SB(1, 0), b3, voffB);
            PG8_BAR; PG8_WAIT_L(0); PG8_MMA(0, 1, At, B1); PG8_BAR;
            PG8_LDA(At, 1, 1); PG8_STAGE(PG8_SA(1, 0), a3, voffA);
            PG8_BAR; PG8_WAIT_L(0); PG8_MMA(1, 0, At, B0); PG8_BAR; PG8_SCHED;
            PG8_STAGE(PG8_SB(1, 1), b3 + hstepB, voffB);
            PG8_WAIT_V(6); PG8_BAR; PG8_MMA(1, 1, At, B1); PG8_BAR;
            }
        }
        if constexpr (ALIGN_EPI) { if (wr == 0) PG8_BAR; }
        if constexpr (!Epi::AFTER_DRAIN) { E(acc, cur, wr, wc, fr, fq); S.done(cur); }
        if (!has_next) break;
#pragma unroll
        for (int a = 0; a < 2; ++a)
#pragma unroll
            for (int b = 0; b < 2; ++b)
#pragma unroll
                for (int m = 0; m < 4; ++m)
#pragma unroll
                    for (int n = 0; n < 2; ++n) acc[a][b][m][n] = (f32x4){0.f, 0.f, 0.f, 0.f};
        cur = nxt; cA = nA; cB = nB; ++ui;
        if constexpr (ALIGN_EPI) { if (wr == 1) PG8_BAR; }
    }
    PG8_WAIT_V(0);
    if constexpr (!ALIGN_EPI) { if (wr == 0) PG8_BAR; }
    PG8_BAR;
    if constexpr (Epi::AFTER_DRAIN) { E.fused(acc, cur, wr, wc, fr, fq, lds, wid, lane); S.done(cur); }
#undef PG8_SA
#undef PG8_SB
#undef PG8_STAGE
#undef PG8_LDA
#undef PG8_LDB
#undef PG8_MMA
#undef PG8_WAIT_V
#undef PG8_WAIT_L
#undef PG8_BAR
#undef PG8_SCHED
}
}
#define LAS __attribute__((address_space(3)))
typedef unsigned short bf16_t;
typedef short bf16x8 __attribute__((ext_vector_type(8)));
typedef short s16x4 __attribute__((ext_vector_type(4)));
typedef float f32x4 __attribute__((ext_vector_type(4)));
typedef unsigned u32x4 __attribute__((ext_vector_type(4)));
typedef unsigned u32x2 __attribute__((ext_vector_type(2)));
using pg8::cvt_pk_bf16; using pg8::bflo; using pg8::bfhi; using pg8::siluf_;

constexpr int D_MODEL = 2048, SEQ = 4096, M_TOK = 16384;
constexpr int NPROJ = pg8::NPROJ;
constexpr int N_IN = 19008, D_FF = 5632;
constexpr int COL_Q = 0, COL_K = 1536, COL_V = 3072, COL_Z = 4608, COL_XBC = 8704, COL_GA = 14848, COL_GS = 16896;
constexpr int NPHASE = 22;

constexpr size_t MiB = 1u << 20;
constexpr size_t WS_CTL = 0, CTL_ZERO_BYTES = 1 * MiB;
constexpr size_t WS_MOD = 65536;
constexpr size_t WS_LSE = 1 * MiB;
constexpr size_t WS_DT = 2 * MiB;
constexpr size_t WS_W = 8 * MiB;
constexpr size_t WO_IN = 0, WO_A = 78643200, WO_S = 80740352, WO_O = 97517568, WO_FI = 105906176, WO_FO = 152043520, WL_BYTES = 175112192;
constexpr size_t WS_H = WS_W + 2 * WL_BYTES;
constexpr size_t WS_PROJ = WS_H + (size_t)M_TOK * 2048 * 2;
constexpr size_t WS_END = WS_PROJ + (size_t)M_TOK * NPROJ * 2;
constexpr int LDS_BYTES = 147456;

struct Args { const float* in[20]; float* out; unsigned char* ws; int ph_lo, ph_hi; };

template <int CTRL> __device__ __forceinline__ float dpp_f(float v) { return __int_as_float(__builtin_amdgcn_update_dpp(0, __float_as_int(v), CTRL, 0xf, 0xf, false)); }
__device__ __forceinline__ float xor16_sum(float v) { const auto r = __builtin_amdgcn_permlane16_swap(__float_as_uint(v), __float_as_uint(v), false, false); return __uint_as_float(r[0]) + __uint_as_float(r[1]); }
__device__ __forceinline__ float xor32_sum(float v) { const auto r = __builtin_amdgcn_permlane32_swap(__float_as_uint(v), __float_as_uint(v), false, false); return __uint_as_float(r[0]) + __uint_as_float(r[1]); }
__device__ __forceinline__ float xor16_max(float v) { const auto r = __builtin_amdgcn_permlane16_swap(__float_as_uint(v), __float_as_uint(v), false, false); return fmaxf(__uint_as_float(r[0]), __uint_as_float(r[1])); }
__device__ __forceinline__ float xor32_max(float v) { const auto r = __builtin_amdgcn_permlane32_swap(__float_as_uint(v), __float_as_uint(v), false, false); return fmaxf(__uint_as_float(r[0]), __uint_as_float(r[1])); }
__device__ __forceinline__ float wave_sum(float v) {
    v += dpp_f<0x128>(v); v += dpp_f<0x124>(v); v += dpp_f<0x122>(v); v += dpp_f<0x121>(v);
    v = xor16_sum(v); v = xor32_sum(v);
    return v;
}
__device__ __forceinline__ float wave_incl_scan(float v, int lane) {
#pragma unroll
    for (int o = 1; o < 64; o <<= 1) { const float t = __int_as_float(__builtin_amdgcn_ds_bpermute(((lane - o) & 63) << 2, __float_as_int(v))); if (lane >= o) v += t; }
    return v;
}
__device__ __forceinline__ float lane63(float v) { return __int_as_float(__builtin_amdgcn_readlane(__float_as_int(v), 63)); }
typedef short v4i16_t __attribute__((ext_vector_type(4)));
__device__ __forceinline__ s16x4 ldtr(LAS unsigned char* p) { return __builtin_bit_cast(s16x4, __builtin_amdgcn_ds_read_tr16_b64_v4i16((LAS v4i16_t*)p)); }
__device__ __forceinline__ bf16x8 cat8(s16x4 lo, s16x4 hi) { return (bf16x8){lo[0], lo[1], lo[2], lo[3], hi[0], hi[1], hi[2], hi[3]}; }
__device__ __forceinline__ f32x4 mfma16(bf16x8 a, bf16x8 b, f32x4 c) { return __builtin_amdgcn_mfma_f32_16x16x32_bf16(a, b, c, 0, 0, 0); }
#define LDS_WAIT() asm volatile("s_waitcnt lgkmcnt(0)" ::: "memory")

__device__ __forceinline__ void tr_item(const float* W, int Nsrc, bf16_t* WT, int K, int k0, int s0, int n0, LAS float* scr, int lane) {
    const int c = lane & 7;
    if (s0 < 0) {
#pragma unroll
        for (int j = 0; j < 4; ++j) { const int n = (lane >> 3) + 8 * j; *(u32x4*)(WT + (size_t)(n0 + n) * K + k0 + 8 * c) = (u32x4){0u, 0u, 0u, 0u}; }
        return;
    }
    { const float* wp = W + (size_t)(k0 + (lane >> 5)) * Nsrc + s0 + (lane & 31); float v[32];
#pragma unroll
        for (int i = 0; i < 32; ++i) v[i] = wp[(size_t)(2 * i) * Nsrc];
#pragma unroll
        for (int i = 0; i < 32; ++i) scr[(2 * i + (lane >> 5)) * 33 + (lane & 31)] = v[i]; }
    LDS_WAIT();
#pragma unroll
    for (int j = 0; j < 4; ++j) { const int n = (lane >> 3) + 8 * j; const LAS float* s = scr + (8 * c) * 33 + n;
        u32x4 o; o.x = cvt_pk_bf16(s[0 * 33], s[1 * 33]); o.y = cvt_pk_bf16(s[2 * 33], s[3 * 33]); o.z = cvt_pk_bf16(s[4 * 33], s[5 * 33]); o.w = cvt_pk_bf16(s[6 * 33], s[7 * 33]);
        *(u32x4*)(WT + (size_t)(n0 + n) * K + k0 + 8 * c) = o; }
    LDS_WAIT();
}

struct SideItem { const float* src; bf16_t* dst; int nsrc; int mode; };
constexpr int IPL32 = 38400 + 1024 + 8192 + 4096 + 22528 + 11264;
__device__ __forceinline__ SideItem side_decode(const Args& a, int l, int it, int lane);
__device__ __forceinline__ void side_issue(const SideItem& s, float (&v)[16]);
__device__ __forceinline__ void side_drain(const SideItem& s, const float (&v)[16]);
__device__ __forceinline__ void phase_prep(const Args& a, LAS unsigned char* lds, int tid, int lane, int wave, int bx, int G, int nlayers) {
    float* MOD = (float*)(a.ws + WS_MOD);
    const float* cin = a.in[1]; const float* w_mod = a.in[5]; const float* b_mod = a.in[6];
    LAS f32x4* red = (LAS f32x4*)lds;
    for (int it = bx; it < 256; it += G) {
        const int l = it >> 7, c96 = it & 127;
        const int par = lane >= 24 ? 1 : 0, cl = lane - 24 * par; const bool act = lane < 48;
        const float* Wm = w_mod + (size_t)l * 2048 * 12288 + c96 * 96 + (act ? cl : 0) * 4;
        const int k0 = wave * 256 + par;
        f32x4 acc0 = {0.f, 0.f, 0.f, 0.f}, acc1 = acc0, acc2 = acc0, acc3 = acc0;
#pragma unroll 8
        for (int kk = 0; kk < 128; ++kk) { const int k = k0 + 2 * kk; const f32x4 wv = *(const f32x4*)(Wm + (size_t)k * 12288);
            acc0 += siluf_(cin[k]) * wv; acc1 += siluf_(cin[2048 + k]) * wv; acc2 += siluf_(cin[4096 + k]) * wv; acc3 += siluf_(cin[6144 + k]) * wv; }
        if (act) { LAS f32x4* rp = red + ((wave * 2 + par) * 4) * 24 + cl; rp[0] = acc0; rp[24] = acc1; rp[48] = acc2; rp[72] = acc3; }
        __syncthreads();
        if (tid < 384) { const int b = tid / 96, ci = tid % 96; float s = b_mod[l * 12288 + c96 * 96 + ci];
#pragma unroll
            for (int w = 0; w < 16; ++w) s += ((const LAS float*)lds)[((w * 4 + b) * 24 + (ci >> 2)) * 4 + (ci & 3)];
            MOD[(size_t)(l * 4 + b) * 12288 + c96 * 96 + ci] = s; }
        __syncthreads();
    }
    LAS float* scr = (LAS float*)(lds + wave * 8704);
    const int gw = bx * 8 + wave, NGW = G * 8;
    constexpr int IPL = 19200 + 512 + 4096 + 2048 + 11264 + 5632;
    for (int it = gw; it < nlayers * IPL; it += NGW) {
        const int l = it / IPL; int r = it % IPL;
        unsigned char* wb = a.ws + WS_W + (size_t)l * WL_BYTES;
        if (r < 19200) { const int kb = r / 600, nb = r % 600, n0 = nb * 32;
            const int s0 = n0 < 14848 ? n0 : (n0 < 18944 ? n0 + 64 : (n0 < 19008 ? 14848 + (n0 - 18944) : -1));
            tr_item(a.in[7] + (size_t)l * 2048 * N_IN, N_IN, (bf16_t*)(wb + WO_IN), 2048, kb * 64, s0, n0, scr, lane); continue; }
        r -= 19200;
        if (r < 512) { const int kb = r >> 6, nb = r & 63; tr_item(a.in[14] + (size_t)l * 512 * 2048, 2048, (bf16_t*)(wb + WO_A), 512, kb * 64, nb * 32, nb * 32, scr, lane); continue; }
        r -= 512;
        if (r < 4096) { const int kb = r >> 6, nb = r & 63; tr_item(a.in[15] + (size_t)l * 4096 * 2048, 2048, (bf16_t*)(wb + WO_S), 4096, kb * 64, nb * 32, nb * 32, scr, lane); continue; }
        r -= 4096;
        if (r < 2048) { const int kb = r >> 6, nb = r & 63; tr_item(a.in[16] + (size_t)l * 2048 * 2048, 2048, (bf16_t*)(wb + WO_O), 2048, kb * 64, nb * 32, nb * 32, scr, lane); continue; }
        r -= 2048;
        if (r < 11264) { const int kb = r / 352, nb = r % 352, n0 = nb * 32, t = n0 >> 8, j = n0 & 255;
            const int s0 = j < 128 ? 128 * t + j : D_FF + 128 * t + (j - 128);
            tr_item(a.in[17] + (size_t)l * 2048 * 2 * D_FF, 2 * D_FF, (bf16_t*)(wb + WO_FI), 2048, kb * 64, s0, n0, scr, lane); continue; }
        r -= 11264;
        { const int kb = r >> 6, nb = r & 63; tr_item(a.in[18] + (size_t)l * D_FF * 2048, 2048, (bf16_t*)(wb + WO_FO), D_FF, kb * 64, nb * 32, nb * 32, scr, lane); }
    }
    if (nlayers == 1) {
        for (int it = 32 * NGW + gw; it < IPL32; it += NGW) { float v[16]; const SideItem sd = side_decode(a, 1, it, lane); side_issue(sd, v); side_drain(sd, v); }
    }
}

template <bool FINAL>
__device__ __forceinline__ void phase_norm(const float* x, const float* w, const float* sc, const float* sh, bf16_t* H, float* outf, int lane, int gw, int NGW) {
    for (int blk = gw; blk < M_TOK / 8; blk += NGW) {
        const int m0 = blk * 8, b = m0 >> 12;
        f32x4 A[8], B[8];
#pragma unroll
        for (int j = 0; j < 8; ++j) { const int col = 4 * (lane + 64 * j); A[j] = *(const f32x4*)(w + col);
            if (!FINAL) { const f32x4 scv = *(const f32x4*)(sc + (size_t)b * 12288 + col); A[j] = A[j] * (1.0f + scv); B[j] = *(const f32x4*)(sh + (size_t)b * 12288 + col); } }
        f32x4 v[8], nx[8];
        { const f32x4* xr = (const f32x4*)(x + (size_t)m0 * 2048) + lane;
#pragma unroll
            for (int j = 0; j < 8; ++j) nx[j] = xr[64 * j]; }
#pragma unroll 1
        for (int r = 0; r < 8; ++r) { const int m = m0 + r;
#pragma unroll
            for (int j = 0; j < 8; ++j) v[j] = nx[j];
            if (r + 1 < 8) { const f32x4* xr = (const f32x4*)(x + (size_t)(m + 1) * 2048) + lane;
#pragma unroll
                for (int j = 0; j < 8; ++j) nx[j] = xr[64 * j]; }
            float ss = 0.f;
#pragma unroll
            for (int j = 0; j < 8; ++j) ss += (v[j].x * v[j].x + v[j].y * v[j].y) + (v[j].z * v[j].z + v[j].w * v[j].w);
            ss = wave_sum(ss);
            const float rstd = 1.0f / sqrtf(ss * (1.0f / 2048.0f) + 1e-6f);
#pragma unroll
            for (int j = 0; j < 8; ++j) { const int col = 4 * (lane + 64 * j);
                if (FINAL) { *(f32x4*)(outf + (size_t)m * 2048 + col) = v[j] * rstd * A[j]; }
                else { const f32x4 o = v[j] * rstd * A[j] + B[j];
                    u32x2 pk; pk.x = cvt_pk_bf16(o.x, o.y); pk.y = cvt_pk_bf16(o.z, o.w);
                    *(u32x2*)(H + (size_t)m * 2048 + col) = pk; } }
        }
    }
}

__device__ __forceinline__ void att_decode(int u, int& g, int& b, int& hh, int& d, int& r, int& n) {
    g = u >> 9; const int rem = u & 511; b = rem >> 7; hh = (rem >> 5) & 3; const int bi = rem & 31;
    d = g == 0 ? 1 : (g == 1 ? 4 : 16); const int nb = 32 / d; r = bi / nb; n = bi % nb;
}
__device__ __forceinline__ void phase_attn(bf16_t* P, float* LSE, const float* rel_bias, LAS unsigned char* lds, int bx, int G, int tid_) {
    int tid = tid_; asm volatile("" : "+v"(tid)); const int lane = tid & 63, wave = __builtin_amdgcn_readfirstlane(tid >> 6);
    constexpr int RS = 272;
    LAS unsigned char* Ks = lds; LAS unsigned char* Vs = lds + 256 * RS; LAS float* biasT = (LAS float*)(lds + 2 * 256 * RS);
    const int l15 = lane & 15, q4 = lane >> 4, qi = 16 * wave + l15;
    int u = bx; if (u >= 1536) return;
    u32x4 kr[8], vr[8]; bf16x8 Qn[4];
#define ATT_LOAD(uu) do { int g_, b_, hh_, d_, r_, n_; att_decode((uu), g_, b_, hh_, d_, r_, n_); const int colq_ = g_ * 512 + hh_ * 128; \
        _Pragma("unroll") for (int i = 0; i < 8; ++i) { const int idx = tid + 512 * i, key = idx >> 4, ch = idx & 15; const int si = (n_ - 1) * 128 + key; \
            kr[i] = (u32x4){0u, 0u, 0u, 0u}; vr[i] = (u32x4){0u, 0u, 0u, 0u}; \
            if (n_ > 0 || i >= 4) { const bf16_t* rp = P + (size_t)(b_ * SEQ + si * d_ + r_) * NPROJ + colq_ + ch * 8; kr[i] = *(const u32x4*)(rp + COL_K); vr[i] = *(const u32x4*)(rp + COL_V); } } \
        { const bf16_t* qp_ = P + (size_t)(b_ * SEQ + (n_ * 128 + qi) * d_ + r_) * NPROJ + colq_; \
          _Pragma("unroll") for (int ks = 0; ks < 4; ++ks) Qn[ks] = *(const bf16x8*)(qp_ + 32 * ks + 8 * q4); } } while (0)
    ATT_LOAD(u);
    for (;;) {
        int g, b, hh, d, r, n; att_decode(u, g, b, hh, d, r, n);
        const int colq = g * 512 + hh * 128;
#pragma unroll
        for (int i = 0; i < 8; ++i) { const int idx = tid + 512 * i, key = idx >> 4, ch = idx & 15;
            *(LAS u32x4*)(Ks + key * RS + ch * 16) = kr[i]; *(LAS u32x4*)(Vs + key * RS + ch * 16) = vr[i]; }
        if (tid < 160) { const int steps = tid - 15; float bv = -INFINITY;
            if (steps >= 0 && steps <= 128) { const int dist = steps * d; int bk;
                if (dist < 16) bk = dist; else { const int lg = 16 + (int)(logf((float)dist / 16.0f) / 4.852030263919617f * 16.0f); bk = lg < 31 ? lg : 31; }
                bv = rel_bias[bk * 12 + g * 4 + hh]; }
            biasT[tid] = bv; }
        bf16x8 Qf[4];
#pragma unroll
        for (int ks = 0; ks < 4; ++ks) Qf[ks] = Qn[ks];
        __syncthreads();
        const int un = u + G;
        if (un < 1536) ATT_LOAD(un);
        const size_t tq = (size_t)(b * SEQ + (n * 128 + qi) * d + r);
        bf16_t* qp = P + tq * NPROJ + colq;
        f32x4 S[9];
        LAS unsigned char* kbase = Ks + (16 * wave + l15) * RS + q4 * 16;
#pragma unroll
        for (int tt = 0; tt < 9; ++tt) { S[tt] = (f32x4){0.f, 0.f, 0.f, 0.f};
#pragma unroll
            for (int ks = 0; ks < 4; ++ks) { const bf16x8 Kf = *(const LAS bf16x8*)(kbase + tt * 16 * RS + ks * 64); S[tt] = mfma16(Kf, Qf[ks], S[tt]); } }
        __builtin_amdgcn_sched_barrier(0);
        const float scale = 0.08838834764831845f;
        float mx = -INFINITY;
        {
            const LAS float* bp = biasT + (143 + l15 - 4 * q4);
#pragma unroll
            for (int tt = 0; tt < 9; ++tt)
#pragma unroll
                for (int e = 0; e < 4; ++e) S[tt][e] = S[tt][e] * scale + bp[-(16 * tt + e)];
            if (n == 0) {
#pragma unroll
                for (int tt = 0; tt < 9; ++tt)
#pragma unroll
                    for (int e = 0; e < 4; ++e) { if (wave + tt < 8) S[tt][e] = -INFINITY; }
            }
#pragma unroll
            for (int tt = 0; tt < 9; ++tt)
#pragma unroll
                for (int e = 0; e < 4; ++e) mx = fmaxf(mx, S[tt][e]);
        }
        mx = xor16_max(mx); mx = xor32_max(mx);
        float sum = 0.f;
#pragma unroll
        for (int tt = 0; tt < 9; ++tt)
#pragma unroll
            for (int e = 0; e < 4; ++e) { const float p = __expf(S[tt][e] - mx); S[tt][e] = p; sum += p; }
        sum = xor16_sum(sum); sum = xor32_sum(sum);
        bf16x8 Pf[5];
#pragma unroll
        for (int kk = 0; kk < 5; ++kk) { u32x4 w; w.x = cvt_pk_bf16(S[2 * kk][0], S[2 * kk][1]); w.y = cvt_pk_bf16(S[2 * kk][2], S[2 * kk][3]);
            if (kk < 4) { w.z = cvt_pk_bf16(S[2 * kk + 1][0], S[2 * kk + 1][1]); w.w = cvt_pk_bf16(S[2 * kk + 1][2], S[2 * kk + 1][3]); } else { w.z = 0u; w.w = 0u; }
            Pf[kk] = __builtin_bit_cast(bf16x8, w); }
        const float inv = 1.0f / sum;
        LAS unsigned char* vbase = Vs + (16 * wave + 4 * q4 + (l15 >> 2)) * RS + (l15 & 3) * 8;
        bf16_t* op = qp + 4 * q4;
#pragma unroll
        for (int dt = 0; dt < 8; ++dt) { f32x4 o = {0.f, 0.f, 0.f, 0.f};
#pragma unroll
            for (int kk = 0; kk < 5; ++kk) {
                const s16x4 lo = ldtr(vbase + (32 * kk) * RS + dt * 32);
                s16x4 hi = {0, 0, 0, 0};
                if (kk < 4) hi = ldtr(vbase + (32 * kk + 16) * RS + dt * 32);
                o = mfma16(cat8(lo, hi), Pf[kk], o); }
            u32x2 pk; pk.x = cvt_pk_bf16(o[0] * inv, o[1] * inv); pk.y = cvt_pk_bf16(o[2] * inv, o[3] * inv);
            *(u32x2*)(op + 16 * dt) = pk;
            __builtin_amdgcn_sched_barrier(0); }
        if (q4 == 0) LSE[tq * 12 + g * 4 + hh] = mx + logf(sum);
        __syncthreads();
        if (un >= 1536) break;
        u = un;
    }
#undef ATT_LOAD
}

__device__ __forceinline__ SideItem side_decode(const Args& a, int l, int it, int lane) {
    SideItem s; s.src = nullptr; s.dst = nullptr; s.nsrc = 0; s.mode = 0;
    if (it >= IPL32) return s;
    unsigned char* wb = a.ws + WS_W + (size_t)l * WL_BYTES;
    const float* W; bf16_t* WT; int K, Nsrc, kb, nb, s0;
    int r = it;
    if (r < 38400) { kb = r / 600; nb = r % 600; const int n0 = nb * 32; s0 = n0 < 14848 ? n0 : (n0 < 18944 ? n0 + 64 : (n0 < 19008 ? 14848 + (n0 - 18944) : -1));
        W = a.in[7] + (size_t)l * 2048 * N_IN; Nsrc = N_IN; WT = (bf16_t*)(wb + WO_IN); K = 2048; }
    else if ((r -= 38400) < 1024) { kb = r >> 6; nb = r & 63; s0 = nb * 32; W = a.in[14] + (size_t)l * 512 * 2048; Nsrc = 2048; WT = (bf16_t*)(wb + WO_A); K = 512; }
    else if ((r -= 1024) < 8192) { kb = r >> 6; nb = r & 63; s0 = nb * 32; W = a.in[15] + (size_t)l * 4096 * 2048; Nsrc = 2048; WT = (bf16_t*)(wb + WO_S); K = 4096; }
    else if ((r -= 8192) < 4096) { kb = r >> 6; nb = r & 63; s0 = nb * 32; W = a.in[16] + (size_t)l * 2048 * 2048; Nsrc = 2048; WT = (bf16_t*)(wb + WO_O); K = 2048; }
    else if ((r -= 4096) < 22528) { kb = r / 352; nb = r % 352; const int n0 = nb * 32, t = n0 >> 8, j = n0 & 255; s0 = j < 128 ? 128 * t + j : D_FF + 128 * t + (j - 128);
        W = a.in[17] + (size_t)l * 2048 * 2 * D_FF; Nsrc = 2 * D_FF; WT = (bf16_t*)(wb + WO_FI); K = 2048; }
    else { r -= 22528; kb = r >> 6; nb = r & 63; s0 = nb * 32; W = a.in[18] + (size_t)l * D_FF * 2048; Nsrc = 2048; WT = (bf16_t*)(wb + WO_FO); K = D_FF; }
    const int n = lane & 31, kh = lane >> 5, k0 = kb * 32 + 16 * kh;
    s.dst = WT + (size_t)(nb * 32 + n) * K + k0; s.nsrc = Nsrc;
    if (s0 < 0) { s.mode = 2; } else { s.mode = 1; s.src = W + (size_t)k0 * Nsrc + s0 + n; }
    return s;
}
__device__ __forceinline__ void side_issue(const SideItem& s, float (&v)[16]) {
    if (s.mode == 1) {
#pragma unroll
        for (int j = 0; j < 16; ++j) v[j] = s.src[(size_t)j * s.nsrc]; }
}
__device__ __forceinline__ void side_drain(const SideItem& s, const float (&v)[16]) {
    if (s.mode == 0) return;
    u32x4 w0 = {0u, 0u, 0u, 0u}, w1 = {0u, 0u, 0u, 0u};
    if (s.mode == 1) { w0.x = cvt_pk_bf16(v[0], v[1]); w0.y = cvt_pk_bf16(v[2], v[3]); w0.z = cvt_pk_bf16(v[4], v[5]); w0.w = cvt_pk_bf16(v[6], v[7]);
        w1.x = cvt_pk_bf16(v[8], v[9]); w1.y = cvt_pk_bf16(v[10], v[11]); w1.z = cvt_pk_bf16(v[12], v[13]); w1.w = cvt_pk_bf16(v[14], v[15]); }
    *(u32x4*)s.dst = w0; *(u32x4*)(s.dst + 8) = w1;
}

__device__ __forceinline__ void phase_convbc(const bf16_t* P, bf16_t* HBC, const float* conv_w, const float* conv_b, int tid, int bx, int G) {
    const int chunk = tid & 255, rh = tid >> 8, col = 4096 + chunk * 8;
    float cw[4][8], cbias[8];
#pragma unroll
    for (int e = 0; e < 8; ++e) { cbias[e] = conv_b[col + e];
#pragma unroll
        for (int j = 0; j < 4; ++j) cw[j][e] = conv_w[j * 6144 + col + e]; }
    for (int it = bx; it < M_TOK / 32; it += G) {
        const int r0 = it * 32 + rh * 16; const bool halo = (r0 & (SEQ - 1)) != 0;
        const bf16_t* src = P + (size_t)r0 * NPROJ + COL_XBC + col;
        u32x4 raw[19];
#pragma unroll
        for (int i = 0; i < 19; ++i) { raw[i] = (u32x4){0u, 0u, 0u, 0u}; if (i >= 3 || halo) raw[i] = *(const u32x4*)(src + (ptrdiff_t)(i - 3) * NPROJ); }
#pragma unroll
        for (int rr = 0; rr < 16; ++rr) { float o[8];
#pragma unroll
            for (int e = 0; e < 8; ++e) o[e] = cbias[e];
#pragma unroll
            for (int j = 0; j < 4; ++j) { const u32x4 rv = raw[rr + j];
                o[0] += bflo(rv.x) * cw[j][0]; o[1] += bfhi(rv.x) * cw[j][1]; o[2] += bflo(rv.y) * cw[j][2]; o[3] += bfhi(rv.y) * cw[j][3];
                o[4] += bflo(rv.z) * cw[j][4]; o[5] += bfhi(rv.z) * cw[j][5]; o[6] += bflo(rv.w) * cw[j][6]; o[7] += bfhi(rv.w) * cw[j][7]; }
#pragma unroll
            for (int e = 0; e < 8; ++e) o[e] = siluf_(o[e]);
            u32x4 w; w.x = cvt_pk_bf16(o[0], o[1]); w.y = cvt_pk_bf16(o[2], o[3]); w.z = cvt_pk_bf16(o[4], o[5]); w.w = cvt_pk_bf16(o[6], o[7]);
            *(u32x4*)(HBC + (size_t)(r0 + rr) * 2048 + chunk * 8) = w; }
    }
}

template <int VAR, bool SIDE>
__device__ __forceinline__ void ssd_unit(bf16_t* P, const bf16_t* HBC, const float* DT, const float* conv_w, const float* conv_b, float dtb, float Aneg, float Dk,
                                         LAS unsigned char* lds, int b, int hd, int tid_, int lane_, int wave_, const Args& sa, int sgw, int sngw) {
    int tid = tid_; asm volatile("" : "+v"(tid)); const int lane = tid & 63, wave = __builtin_amdgcn_readfirstlane(tid >> 6);
    constexpr int XS = 144, BS = 272;
    LAS unsigned char* Xs = lds; LAS unsigned char* Xw = lds + 18432; LAS unsigned char* Bm = lds + 36864; LAS unsigned char* Cm = lds + 71680; LAS unsigned char* Hs = lds + 106496;
    LAS float* scal = (LAS float*)(lds + 123904);
    const int g = hd >> 3, l15 = lane & 15, q4 = lane >> 4;
    const int xch = tid & 7, xr0 = (tid >> 3) * 2;
    const int xcol = hd * 64 + xch * 8;
    const int bcch = tid & 31, bcrow = tid >> 5;
    const int bccol = bcch < 16 ? g * 128 + bcch * 8 : 1024 + g * 128 + (bcch - 16) * 8;
    LAS unsigned char* bcdst = (bcch < 16 ? Bm + bcch * 16 : Cm + (bcch - 16) * 16) + bcrow * BS;
    LAS float* cwt = (LAS float*)(lds + 126976);
    if (tid < 320) { const int j = tid >> 6, cc = tid & 63; cwt[tid] = j < 4 ? conv_w[j * 6144 + hd * 64 + cc] : conv_b[hd * 64 + cc]; }
    { u32x4 zq = {0u, 0u, 0u, 0u}; asm volatile("" : "+v"(zq));
      for (int i = tid; i < 17408 / 16; i += 512) *(LAS u32x4*)(Hs + i * 16) = zq; }
    f32x4 hacc[4];
#pragma unroll
    for (int pt = 0; pt < 4; ++pt) hacc[pt] = (f32x4){0.f, 0.f, 0.f, 0.f};
    u32x4 xraw[5], bcraw[8]; float dr0 = 0.f, dr1 = 0.f;
#define SSD_LOADS(c_) do { const int tok0_ = b * SEQ + (c_) * 128; \
        _Pragma("unroll") for (int i = 0; i < 5; ++i) { xraw[i] = (u32x4){0u, 0u, 0u, 0u}; \
            if (i >= 3 || (c_) > 0 || xr0 + i >= 3) xraw[i] = *(const u32x4*)(P + (size_t)(tok0_ + xr0 - 3 + i) * NPROJ + COL_XBC + xcol); } \
        if (wave == 0) { dr0 = DT[(size_t)(tok0_ + lane) * 64 + hd]; dr1 = DT[(size_t)(tok0_ + 64 + lane) * 64 + hd]; } } while (0)
#define SSD_LOADS_BC(c_) do { const int tok0_ = b * SEQ + (c_) * 128; \
        _Pragma("unroll") for (int i = 0; i < 8; ++i) bcraw[i] = *(const u32x4*)(HBC + (size_t)(tok0_ + bcrow + 16 * i) * 2048 + bccol); } while (0)
#define SSD_SCAN(par_) do { LAS float* dtv_ = scal + (par_) * 128; LAS float* acum_ = scal + 256 + (par_) * 128; LAS float* wl_ = scal + 512 + (par_) * 128; \
        const float x0 = dr0 + dtb, x1 = dr1 + dtb; \
        const float dt0 = x0 > 20.f ? x0 : log1pf(expf(x0)), dt1 = x1 > 20.f ? x1 : log1pf(expf(x1)); \
        const float s0 = wave_incl_scan(dt0 * Aneg, lane); const float tot0 = lane63(s0); \
        const float s1 = wave_incl_scan(dt1 * Aneg, lane) + tot0; const float tot = lane63(s1); \
        dtv_[lane] = dt0; dtv_[64 + lane] = dt1; acum_[lane] = s0 * 1.4426950408889634f; acum_[64 + lane] = s1 * 1.4426950408889634f;     \
        wl_[lane] = dt0 * __expf(tot - s0); wl_[64 + lane] = dt1 * __expf(tot - s1); } while (0)
    SideItem sd0; float sv0[16]; sd0.src = nullptr; sd0.dst = nullptr; sd0.nsrc = 0; sd0.mode = 0;
#pragma unroll
    for (int j = 0; j < 16; ++j) sv0[j] = 0.f;
    SSD_LOADS(0); SSD_LOADS_BC(0);
    if (wave == 0) SSD_SCAN(0);
    __syncthreads();
    for (int c = 0; c < 32; ++c) {
        const int par = c & 1;
        LAS float* dtv = scal + par * 128; LAS float* acum = scal + 256 + par * 128; LAS float* wl = scal + 512 + par * 128;
        const int tok0 = b * SEQ + c * 128;
        f32x4 o2[2][2];
        { const f32x4 ba = *(const LAS f32x4*)(cwt + 256 + xch * 8), bb = *(const LAS f32x4*)(cwt + 256 + xch * 8 + 4); o2[0][0] = ba; o2[0][1] = bb; o2[1][0] = ba; o2[1][1] = bb; }
#pragma unroll
        for (int j = 0; j < 4; ++j) { const f32x4 wa = *(const LAS f32x4*)(cwt + j * 64 + xch * 8), wb = *(const LAS f32x4*)(cwt + j * 64 + xch * 8 + 4);
#pragma unroll
            for (int rr = 0; rr < 2; ++rr) { const u32x4 rv = xraw[rr + j];
                o2[rr][0] += (f32x4){bflo(rv.x), bfhi(rv.x), bflo(rv.y), bfhi(rv.y)} * wa; o2[rr][1] += (f32x4){bflo(rv.z), bfhi(rv.z), bflo(rv.w), bfhi(rv.w)} * wb; } }
        { f32x4 t[2][2];
#pragma unroll
            for (int rr = 0; rr < 2; ++rr)
#pragma unroll
                for (int hq = 0; hq < 2; ++hq)
                    { const f32x4 ta = o2[rr][hq] * -1.4426950408889634f;
#pragma unroll
                      for (int e = 0; e < 4; ++e) t[rr][hq][e] = __builtin_amdgcn_exp2f(ta[e]); }
#pragma unroll
            for (int rr = 0; rr < 2; ++rr)
#pragma unroll
                for (int hq = 0; hq < 2; ++hq)
                    { const f32x4 tb = t[rr][hq] + 1.0f;
#pragma unroll
                      for (int e = 0; e < 4; ++e) t[rr][hq][e] = __builtin_amdgcn_rcpf(tb[e]); }
#pragma unroll
            for (int rr = 0; rr < 2; ++rr)
#pragma unroll
                for (int hq = 0; hq < 2; ++hq) o2[rr][hq] = o2[rr][hq] * t[rr][hq]; }
#pragma unroll
        for (int rr = 0; rr < 2; ++rr) { const f32x4 oa = o2[rr][0], ob = o2[rr][1];
            u32x4 w; w.x = cvt_pk_bf16(oa[0], oa[1]); w.y = cvt_pk_bf16(oa[2], oa[3]); w.z = cvt_pk_bf16(ob[0], ob[1]); w.w = cvt_pk_bf16(ob[2], ob[3]);
            *(LAS u32x4*)(Xs + (xr0 + rr) * XS + xch * 16) = w;
            const float f = wl[xr0 + rr]; const f32x4 pa = oa * f, pb = ob * f;
            w.x = cvt_pk_bf16(pa[0], pa[1]); w.y = cvt_pk_bf16(pa[2], pa[3]); w.z = cvt_pk_bf16(pb[0], pb[1]); w.w = cvt_pk_bf16(pb[2], pb[3]);
            *(LAS u32x4*)(Xw + (xr0 + rr) * XS + xch * 16) = w; }
#pragma unroll
        for (int i = 0; i < 8; ++i) *(LAS u32x4*)(bcdst + 16 * i * BS) = bcraw[i];
        if (SIDE) { side_drain(sd0, sv0); sd0.mode = 0; }
        __syncthreads();
        if (c + 1 < 32 && !(VAR & 2)) SSD_LOADS(c + 1);
        {
            const int lt = wave < 4 ? wave : 11 - wave;
            const int l = 16 * lt + l15; const float acl = acum[l];
            const size_t token = (size_t)(tok0 + l);
            bf16_t* zp = P + token * NPROJ + COL_Z + hd * 64 + 4 * q4;
            u32x2 zv[4];
#pragma unroll
            for (int pt = 0; pt < 4; ++pt) { zv[pt] = (u32x2){0x3f803f80u, 0x3f803f80u}; if (!(VAR & 1)) zv[pt] = *(const u32x2*)(zp + 16 * pt); }
            f32x4 Y[4];
#pragma unroll
            for (int pt = 0; pt < 4; ++pt) Y[pt] = (f32x4){0.f, 0.f, 0.f, 0.f};
            bf16x8 Cf[4];
            LAS unsigned char* cbase = Cm + l * BS + q4 * 16;
#pragma unroll
            for (int ks = 0; ks < 4; ++ks) Cf[ks] = *(const LAS bf16x8*)(cbase + ks * 64);
            LAS unsigned char* hbase = Hs + l15 * BS + q4 * 16;
#pragma unroll
            for (int pt = 0; pt < 4; ++pt)
#pragma unroll
                for (int ks = 0; ks < 4; ++ks) { const bf16x8 Hf = *(const LAS bf16x8*)(hbase + pt * 16 * BS + ks * 64); Y[pt] = mfma16(Hf, Cf[ks], Y[pt]); }
            const float eal = __builtin_amdgcn_exp2f(acl);
#pragma unroll
            for (int pt = 0; pt < 4; ++pt) Y[pt] *= eal;
            __builtin_amdgcn_sched_barrier(0);
            f32x4 Gt[8];
            f32x4 penv;
#pragma unroll
            for (int e = 0; e < 4; ++e) penv[e] = (4 * q4 + e <= l15) ? 0.f : 1e30f;
            LAS unsigned char* bbase = Bm + l15 * BS + q4 * 16;
#pragma unroll
            for (int st = 0; st < 8; ++st) { Gt[st] = (f32x4){0.f, 0.f, 0.f, 0.f};
                if (st <= lt) {
#pragma unroll
                    for (int ks = 0; ks < 4; ++ks) { const bf16x8 Bf = *(const LAS bf16x8*)(bbase + st * 16 * BS + ks * 64); Gt[st] = mfma16(Bf, Cf[ks], Gt[st]); }
                    const f32x4 as = *(const LAS f32x4*)(acum + 16 * st + 4 * q4), ds = *(const LAS f32x4*)(dtv + 16 * st + 4 * q4);
#pragma unroll
                    for (int e = 0; e < 1; ++e) { const float flagf = (st == lt) ? 1.0f : 0.0f;
                        const f32x4 dv = (acl - as) - penv * flagf;
                        f32x4 fv; fv[0] = __builtin_amdgcn_exp2f(dv[0]); fv[1] = __builtin_amdgcn_exp2f(dv[1]); fv[2] = __builtin_amdgcn_exp2f(dv[2]); fv[3] = __builtin_amdgcn_exp2f(dv[3]);
                        Gt[st] = Gt[st] * (fv * ds); }
                } }
            LAS unsigned char* xbase = Xs + (4 * q4 + (l15 >> 2)) * XS + (l15 & 3) * 8;
#pragma unroll
            for (int kk = 0; kk < 4; ++kk) {
                if (2 * kk <= lt) {
                    u32x4 w; w.x = cvt_pk_bf16(Gt[2 * kk][0], Gt[2 * kk][1]); w.y = cvt_pk_bf16(Gt[2 * kk][2], Gt[2 * kk][3]);
                    w.z = cvt_pk_bf16(Gt[2 * kk + 1][0], Gt[2 * kk + 1][1]); w.w = cvt_pk_bf16(Gt[2 * kk + 1][2], Gt[2 * kk + 1][3]);
                    const bf16x8 Pf = __builtin_bit_cast(bf16x8, w);
#pragma unroll
                    for (int pt = 0; pt < 4; ++pt) {
                        const s16x4 xlo = ldtr(xbase + (32 * kk) * XS + pt * 32);
                        const s16x4 xhi = ldtr(xbase + (32 * kk + 16) * XS + pt * 32);
                        Y[pt] = mfma16(cat8(xlo, xhi), Pf, Y[pt]); }
                } }
            __builtin_amdgcn_sched_barrier(0);
            if (c + 1 < 32 && !(VAR & 2)) SSD_LOADS_BC(c + 1);
            if (SIDE) { sd0 = side_decode(sa, 1, sgw + sngw * c, lane); side_issue(sd0, sv0); }
#pragma unroll
            for (int pt = 0; pt < 4; ++pt) { const int p0 = 16 * pt + 4 * q4;
                const u32x2 xv = *(const LAS u32x2*)(Xs + l * XS + p0 * 2);
                const f32x4 xf = {bflo(xv.x), bfhi(xv.x), bflo(xv.y), bfhi(xv.y)}, zf = {bflo(zv[pt].x), bfhi(zv[pt].x), bflo(zv[pt].y), bfhi(zv[pt].y)};
                const f32x4 yv = (Y[pt] + Dk * xf) * zf;
                u32x2 pk; pk.x = cvt_pk_bf16(yv[0], yv[1]); pk.y = cvt_pk_bf16(yv[2], yv[3]); if (!(VAR & 1)) *(u32x2*)(zp + 16 * pt) = pk; else asm volatile("" :: "v"(pk.x), "v"(pk.y)); }
            __builtin_amdgcn_sched_barrier(0);
            const float et = __builtin_amdgcn_exp2f(acum[127]);
#pragma unroll
            for (int pt = 0; pt < 4; ++pt) hacc[pt] *= et;
            LAS unsigned char* btbase = Bm + (4 * q4 + (l15 >> 2)) * BS + (16 * wave + 4 * (l15 & 3)) * 2;
            LAS unsigned char* xwbase = Xw + (4 * q4 + (l15 >> 2)) * XS + (l15 & 3) * 8;
#pragma unroll
            for (int kk = 0; kk < 4; ++kk) {
                const s16x4 blo = ldtr(btbase + (32 * kk) * BS);
                const s16x4 bhi = ldtr(btbase + (32 * kk + 16) * BS);
                const bf16x8 Bf = cat8(blo, bhi);
#pragma unroll
                for (int pt = 0; pt < 4; ++pt) {
                    const s16x4 xlo = ldtr(xwbase + (32 * kk) * XS + pt * 32);
                    const s16x4 xhi = ldtr(xwbase + (32 * kk + 16) * XS + pt * 32);
                    hacc[pt] = mfma16(Bf, cat8(xlo, xhi), hacc[pt]); }
            }
        }
        if (wave == 0 && c + 1 < 32) SSD_SCAN(par ^ 1);
        __syncthreads();
#pragma unroll
        for (int pt = 0; pt < 4; ++pt) { u32x2 pk; pk.x = cvt_pk_bf16(hacc[pt][0], hacc[pt][1]); pk.y = cvt_pk_bf16(hacc[pt][2], hacc[pt][3]);
            *(LAS u32x2*)(Hs + (16 * pt + l15) * BS + (16 * wave + 4 * q4) * 2) = pk; }
    }
#undef SSD_LOADS
#undef SSD_LOADS_BC
#undef SSD_SCAN
    if (SIDE) { side_drain(sd0, sv0); }
    __syncthreads();
}

__device__ __forceinline__ void phase_attn_merge(bf16_t* P, const float* LSE, int lane, int gw, int NGW) {
    const int hh = lane >> 4, dd = (lane & 15) * 8;
#pragma unroll 2
    for (int m = gw; m < M_TOK; m += NGW) {
        bf16_t* op = P + (size_t)m * NPROJ + hh * 128 + dd;
        const float l0 = LSE[(size_t)m * 12 + hh], l1 = LSE[(size_t)m * 12 + 4 + hh], l2 = LSE[(size_t)m * 12 + 8 + hh];
        const u32x4 o0 = *(const u32x4*)op, o1 = *(const u32x4*)(op + 512), o2 = *(const u32x4*)(op + 1024);
        const float mx = fmaxf(l0, fmaxf(l1, l2)); float w0 = __expf(l0 - mx), w1 = __expf(l1 - mx), w2 = __expf(l2 - mx);
        const float inv = 1.0f / (w0 + w1 + w2); w0 *= inv; w1 *= inv; w2 *= inv;
        u32x4 w;
        w.x = cvt_pk_bf16(w0 * bflo(o0.x) + w1 * bflo(o1.x) + w2 * bflo(o2.x), w0 * bfhi(o0.x) + w1 * bfhi(o1.x) + w2 * bfhi(o2.x));
        w.y = cvt_pk_bf16(w0 * bflo(o0.y) + w1 * bflo(o1.y) + w2 * bflo(o2.y), w0 * bfhi(o0.y) + w1 * bfhi(o1.y) + w2 * bfhi(o2.y));
        w.z = cvt_pk_bf16(w0 * bflo(o0.z) + w1 * bflo(o1.z) + w2 * bflo(o2.z), w0 * bfhi(o0.z) + w1 * bfhi(o1.z) + w2 * bfhi(o2.z));
        w.w = cvt_pk_bf16(w0 * bflo(o0.w) + w1 * bflo(o1.w) + w2 * bflo(o2.w), w0 * bfhi(o0.w) + w1 * bfhi(o1.w) + w2 * bfhi(o2.w));
        *(u32x4*)op = w;
    }
}
__device__ __forceinline__ void phase_merge(bf16_t* P, const float* LSE, const float* nw, int lane, int gw, int NGW) {
    f32x4 wa[8], wb[8];
#pragma unroll
    for (int gg = 0; gg < 8; ++gg) { wa[gg] = *(const f32x4*)(nw + gg * 512 + lane * 8); wb[gg] = *(const f32x4*)(nw + gg * 512 + lane * 8 + 4); }
    for (int m = gw; m < M_TOK; m += NGW) {
        bf16_t* rp = P + (size_t)m * NPROJ;
        u32x4 yv[8];
#pragma unroll
        for (int gg = 0; gg < 8; ++gg) yv[gg] = *(const u32x4*)(rp + COL_Z + gg * 512 + lane * 8);
        float ss[8];
#pragma unroll
        for (int gg = 0; gg < 8; ++gg) { const u32x4 v = yv[gg];
            ss[gg] = (bflo(v.x) * bflo(v.x) + bfhi(v.x) * bfhi(v.x)) + (bflo(v.y) * bflo(v.y) + bfhi(v.y) * bfhi(v.y)) + (bflo(v.z) * bflo(v.z) + bfhi(v.z) * bfhi(v.z)) + (bflo(v.w) * bflo(v.w) + bfhi(v.w) * bfhi(v.w)); }
#pragma unroll
        for (int gg = 0; gg < 8; ++gg) ss[gg] = wave_sum(ss[gg]);
#pragma unroll
        for (int gg = 0; gg < 8; ++gg) { const u32x4 v = yv[gg];
            const float rs = 1.0f / sqrtf(ss[gg] * (1.0f / 512.0f) + 1e-6f);
            u32x4 w; w.x = cvt_pk_bf16(bflo(v.x) * rs * wa[gg].x, bfhi(v.x) * rs * wa[gg].y); w.y = cvt_pk_bf16(bflo(v.y) * rs * wa[gg].z, bfhi(v.y) * rs * wa[gg].w);
            w.z = cvt_pk_bf16(bflo(v.z) * rs * wb[gg].x, bfhi(v.z) * rs * wb[gg].y); w.w = cvt_pk_bf16(bflo(v.w) * rs * wb[gg].z, bfhi(v.w) * rs * wb[gg].w);
            *(u32x4*)(rp + COL_Z + gg * 512 + lane * 8) = w; }
    }
}

#define GAS __attribute__((address_space(1)))
#define XB_TMO      128
#define XB_XCNT(j)  (256  + 64 * (j))
#define XB_XSUB(j)  (1280 + 64 * (j))
#define XB_XGEN(j)  (2304 + 64 * (j))
#define XB_TOP      3328
#define XB_TOPGEN   3392
#define XCD_BAR_WORDS 3456
#define XB_SPIN_CAP (1u << 18)

__device__ __forceinline__ unsigned xb_ld(unsigned* p)              { return __hip_atomic_load(p, __ATOMIC_RELAXED, __HIP_MEMORY_SCOPE_AGENT); }
__device__ __forceinline__ unsigned xb_add(unsigned* p, unsigned v) { return __hip_atomic_fetch_add(p, v, __ATOMIC_RELAXED, __HIP_MEMORY_SCOPE_AGENT); }
__device__ __forceinline__ unsigned xb_xcc_id() { return (unsigned)__builtin_amdgcn_s_getreg((3 << 11) | 20) & 0xFu; }
#define XB_SPIN(cond, bar) do { unsigned _sp = 0; while (cond) { __builtin_amdgcn_s_sleep(1); \
    if ((++_sp & 255u) == 0u) { if (xb_ld(&(bar)[XB_TMO])) break; if (_sp > XB_SPIN_CAP) { atomicAdd(&(bar)[XB_TMO], 1u); break; } } } } while (0)

struct XcdBarrier {
    unsigned* bar; unsigned x; int w0;
    volatile LAS unsigned* st;
};

__device__ __forceinline__ XcdBarrier xcd_barrier_post(unsigned* bar, volatile LAS unsigned* st, int tid0_, int wv_) {
    XcdBarrier b; b.bar = bar; b.x = xb_xcc_id(); b.st = st; b.w0 = wv_;
    if (tid0_ == 0) (void)xb_add(&bar[XB_XCNT(b.x)], 1u);
    return b;
}
__device__ __forceinline__ void xcd_barrier_complete(unsigned* bar, unsigned x, unsigned& nloc, unsigned& nx) {
    const unsigned G = gridDim.x * gridDim.y * gridDim.z;
    unsigned sum, cnt, mine, sp = 0u;
    for (;;) {
        sum = 0u; cnt = 0u; mine = 0u;
#pragma unroll
        for (unsigned j = 0; j < 16; ++j) { const unsigned c = xb_ld(&bar[XB_XCNT(j)]); sum += c; cnt += (c > 0u) ? 1u : 0u; mine = (j == x) ? c : mine; }
        if (sum == G) break;
        __builtin_amdgcn_s_sleep(1);
        if ((++sp & 255u) == 0u) { if (xb_ld(&bar[XB_TMO])) break; if (sp > XB_SPIN_CAP) { atomicAdd(&bar[XB_TMO], 1u); break; } }
    }
    nloc = mine > 0u ? mine : 1u; nx = cnt > 0u ? cnt : 1u;
}

__device__ __forceinline__ void xcd_barrier(const XcdBarrier& b) {
    asm volatile("s_waitcnt vmcnt(0)" ::: "memory");
    __syncthreads();
    if (b.w0 == 0 && pg8::lane_id_mbcnt() == 0) {
        unsigned* bar = b.bar; asm volatile("" : "+s"(bar));
        __builtin_amdgcn_s_waitcnt(0);
        unsigned nloc = b.st[0], nx = b.st[1];
        if (nloc == 0u) { xcd_barrier_complete(bar, b.x, nloc, nx); b.st[0] = nloc; b.st[1] = nx; }
        const unsigned old = xb_add(&bar[XB_XSUB(b.x)], 1u);
        const unsigned gen = old / nloc;
        if (old + 1u == (gen + 1u) * nloc) {
            __builtin_amdgcn_fence(__ATOMIC_RELEASE, "agent");
            asm volatile("s_waitcnt vmcnt(0)" ::: "memory");
            const unsigned og = xb_add(&bar[XB_TOP], 1u);
            const unsigned tg = og / nx;
            if (og + 1u == (tg + 1u) * nx) xb_add(&bar[XB_TOPGEN], 1u);
            else XB_SPIN(xb_ld(&bar[XB_TOPGEN]) == tg, bar);
            __builtin_amdgcn_fence(__ATOMIC_ACQUIRE, "agent");
            xb_add(&bar[XB_XGEN(b.x)], 1u);
            asm volatile("s_waitcnt vmcnt(0)" ::: "memory");
        } else {
            XB_SPIN(xb_ld(&bar[XB_XGEN(b.x)]) == gen, bar);
            __builtin_amdgcn_fence(__ATOMIC_ACQUIRE, "agent");
            asm volatile("s_waitcnt vmcnt(0)" ::: "memory");
        }
    }
    __syncthreads();
}

#ifndef PROBE_MODE
#define PROBE_MODE 0
#endif
#ifndef PROBE_VAR
#define PROBE_VAR 0
#endif
#ifndef MK_SINGLE
#define MK_SINGLE 1
#endif
__global__ void __launch_bounds__(512, 2) fwd_kernel(Args a) {
    extern __shared__ __attribute__((aligned(16))) unsigned char lds_raw[];
    LAS unsigned char* lds = (LAS unsigned char*)lds_raw;
    cg::grid_group grid = cg::this_grid();
    const int bx = blockIdx.x, G = gridDim.x, NGW = G * 8;
    const int tid0 = threadIdx.x;
    const int wv_s = __builtin_amdgcn_readfirstlane(tid0 >> 6);
    const int lo = a.ph_lo, hi = a.ph_hi;
    volatile LAS unsigned* MISC = (volatile LAS unsigned*)(lds + LDS_BYTES - 64);
    if (tid0 < 16) MISC[tid0] = 0u;
    __syncthreads();
    const XcdBarrier xbar = xcd_barrier_post((unsigned*)(a.ws + WS_CTL), MISC, tid0, wv_s);
#define PH_IDS int tid = wv_s * 64 + pg8::lane_id_mbcnt(); asm volatile("" : "+v"(tid)); const int lane = tid & 63, wave = __builtin_amdgcn_readfirstlane(tid >> 6), gw = bx * 8 + wave; (void)lane; (void)gw
    float* out = a.out;
#define PH_PTRS unsigned char* ws = a.ws; asm volatile("" : "+s"(ws)); float* MOD = (float*)(ws + WS_MOD); float* LSE = (float*)(ws + WS_LSE); float* DT = (float*)(ws + WS_DT); \
    bf16_t* H = (bf16_t*)(ws + WS_H); bf16_t* P = (bf16_t*)(ws + WS_PROJ); const float* mod = MOD + (size_t)l * 4 * 12288; unsigned char* wb = ws + WS_W + (size_t)l * WL_BYTES; \
    (void)LSE; (void)DT; (void)H; (void)P; (void)mod; (void)wb
#define IN(k) (lo <= (k) && (k) < hi)
#define SEAM(k) do { if (IN(k) && IN((k) + 1)) xcd_barrier(xbar); } while (0)
    if (lo < -1000) grid.sync();
    const bool side = false;
    if (IN(0)) { PH_IDS; phase_prep(a, lds, tid, lane, wave, bx, G, side ? 1 : 2); }
    SEAM(0);
#if PROBE_MODE == 5
    if (IN(0) && IN(1)) { { PH_IDS; phase_prep(a, lds, tid, lane, wave, bx, G, 2); } xcd_barrier(xbar); }
#endif
#pragma unroll 1
    for (int l = 0; l < 2; ++l) {
        const int pb = 1 + 10 * l;
        const float* xin = (l == 0) ? a.in[0] : out;
        if (IN(pb + 0)) { PH_PTRS; PH_IDS; phase_norm<false>(xin, a.in[3] + l * 2048, mod + 2048, mod, H, nullptr, lane, gw, NGW); }
        SEAM(pb + 0);
#if PROBE_MODE == 6
        if (IN(pb + 0) && IN(pb + 1)) { { PH_IDS; phase_norm<false>(xin, a.in[3] + l * 2048, mod + 2048, mod, H, nullptr, lane, gw, NGW); } grid.sync(); }
#endif
        if (IN(pb + 1)) { PH_PTRS; pg8::Gemm g{H, (const bf16_t*)(wb + WO_IN), M_TOK, NPROJ, 2048, 2048}; pg8::StaticOrder S; S.init(M_TOK, NPROJ, G, bx);
            pg8::EpiProj E{P, DT}; pg8::gemm_phase<pg8::EpiProj, pg8::StaticOrder, true, true>(lds, g, S, E, wv_s); }
        SEAM(pb + 1);
        if (IN(pb + 2)) { PH_PTRS; PH_IDS;
            phase_attn(P, LSE, a.in[2], lds, bx, G, tid);
            phase_convbc(P, H, a.in[8] + (size_t)l * 4 * 6144, a.in[9] + (size_t)l * 6144, tid, bx, G);
        }
        SEAM(pb + 2);
        if (IN(pb + 3)) { PH_PTRS; PH_IDS;
            for (int u = bx; u < 256; u += G) {
                const int xcd = u & 7, slot = u >> 3, gb = xcd * 4 + (slot >> 3), b = gb >> 3, hd = (gb & 7) * 8 + (slot & 7);
                if (l == 0 && side) ssd_unit<0, true>(P, H, DT, a.in[8] + (size_t)l * 4 * 6144, a.in[9] + (size_t)l * 6144, a.in[10][l * 64 + hd], -expf(a.in[11][l * 64 + hd]), a.in[12][l * 64 + hd], lds, b, hd, tid, lane, wave, a, gw, NGW);
                else ssd_unit<0, false>(P, H, DT, a.in[8] + (size_t)l * 4 * 6144, a.in[9] + (size_t)l * 6144, a.in[10][l * 64 + hd], -expf(a.in[11][l * 64 + hd]), a.in[12][l * 64 + hd], lds, b, hd, tid, lane, wave, a, gw, NGW); }
            phase_attn_merge(P, LSE, lane, gw, NGW);
        }
        SEAM(pb + 3);
        if (IN(pb + 4)) { PH_PTRS; PH_IDS; phase_merge(P, LSE, a.in[13] + (size_t)l * 4096, lane, gw, NGW); }
        SEAM(pb + 4);
        if (IN(pb + 5)) { PH_PTRS;
            { pg8::Gemm g{P + COL_Q, (const bf16_t*)(wb + WO_A), M_TOK, 2048, 512, NPROJ}; pg8::StaticOrder S; S.init(M_TOK, 2048, G, bx);
              pg8::EpiGate<0> E{H, 2048, P + COL_GA, NPROJ}; pg8::gemm_phase<pg8::EpiGate<0>, pg8::StaticOrder, true, true>(lds, g, S, E, wv_s); }
            { pg8::Gemm g{P + COL_Z, (const bf16_t*)(wb + WO_S), M_TOK, 2048, 4096, NPROJ}; pg8::StaticOrder S; S.init(M_TOK, 2048, G, bx);
              pg8::EpiGate<1> E{H, 2048, P + COL_GS, NPROJ}; pg8::gemm_phase<pg8::EpiGate<1>, pg8::StaticOrder, true, true>(lds, g, S, E, wv_s); }
        }
        SEAM(pb + 5);
#if PROBE_MODE > 0
        if (IN(pb + 5) && IN(pb + 6)) { PH_IDS;
#if PROBE_MODE == 1
            phase_attn(P, LSE, a.in[2], lds, bx, G, tid);
#elif PROBE_MODE == 2
            for (int u = bx; u < 256; u += G) {
                const int xcd = u & 7, slot = u >> 3, gb = xcd * 4 + (slot >> 3), b = gb >> 3, hd = (gb & 7) * 8 + (slot & 7);
                ssd_unit<PROBE_VAR, false>(P, H, DT, a.in[8] + (size_t)l * 4 * 6144, a.in[9] + (size_t)l * 6144, a.in[10][l * 64 + hd], -expf(a.in[11][l * 64 + hd]), a.in[12][l * 64 + hd], lds, b, hd, tid, lane, wave, a, gw, NGW); }
#elif PROBE_MODE == 3
            phase_merge(P, LSE, a.in[13] + (size_t)l * 4096, lane, gw, NGW);
#elif PROBE_MODE == 4
            phase_convbc(P, P + (size_t)200000000, a.in[8] + (size_t)l * 4 * 6144, a.in[9] + (size_t)l * 6144, tid, bx, G);
#endif
            grid.sync(); }
#endif
        if (IN(pb + 6)) { PH_PTRS; pg8::Gemm g{H, (const bf16_t*)(wb + WO_O), M_TOK, 2048, 2048, 2048}; pg8::StaticOrder S; S.init(M_TOK, 2048, G, bx);
            pg8::EpiRes E{xin, out, mod + 4096, 12288}; pg8::gemm_phase<pg8::EpiRes, pg8::StaticOrder, true, true>(lds, g, S, E, wv_s); }
        SEAM(pb + 6);
        if (IN(pb + 7)) { PH_PTRS; PH_IDS; phase_norm<false>(out, a.in[4] + l * 2048, mod + 8192, mod + 6144, H, nullptr, lane, gw, NGW); }
        SEAM(pb + 7);
        if (IN(pb + 8)) { PH_PTRS; pg8::Gemm g{H, (const bf16_t*)(wb + WO_FI), M_TOK, 2 * D_FF, 2048, 2048}; pg8::StaticOrder S; S.init(M_TOK, 2 * D_FF, G, bx);
            pg8::EpiSwiglu E{P, D_FF}; pg8::gemm_phase<pg8::EpiSwiglu, pg8::StaticOrder, true, true>(lds, g, S, E, wv_s); }
        SEAM(pb + 8);
        if (IN(pb + 9)) { PH_PTRS; pg8::Gemm g{P, (const bf16_t*)(wb + WO_FO), M_TOK, 2048, D_FF, D_FF}; pg8::StaticOrder S; S.init(M_TOK, 2048, G, bx);
            pg8::EpiRes E{out, out, mod + 10240, 12288}; pg8::gemm_phase<pg8::EpiRes, pg8::StaticOrder, true, true>(lds, g, S, E, wv_s); }
        SEAM(pb + 9);
    }
#if PROBE_MODE == 7
    if (IN(20) && IN(21)) { for (int i = 0; i < 20; ++i) grid.sync(); }
#endif
    if (IN(21)) { PH_IDS; phase_norm<true>(out, a.in[19], nullptr, nullptr, nullptr, out, lane, gw, NGW); }
#undef IN
#undef SEAM
}

extern "C" void kernel_launch(void* const* d_in, const int* in_sizes, int n_in, void* d_out, int out_size, void* d_ws, size_t ws_size, hipStream_t stream) {
    static int grid = 0;
    if (grid == 0) {
        if (n_in != 20 || out_size != M_TOK * D_MODEL || ws_size < WS_END + MiB) { fprintf(stderr, "kernel_launch: unexpected shapes (n_in %d out %d ws %zu need %zu)\n", n_in, out_size, ws_size, (size_t)WS_END); grid = -1; return; }
        int dev = 0, cus = 0, per_cu = 0;
        (void)hipGetDevice(&dev); (void)hipDeviceGetAttribute(&cus, hipDeviceAttributeMultiprocessorCount, dev);
        if (hipFuncSetAttribute((const void*)fwd_kernel, hipFuncAttributeMaxDynamicSharedMemorySize, LDS_BYTES) != hipSuccess) { fprintf(stderr, "kernel_launch: hipFuncSetAttribute failed\n"); grid = -1; return; }
        if (hipOccupancyMaxActiveBlocksPerMultiprocessor(&per_cu, (const void*)fwd_kernel, 512, LDS_BYTES) != hipSuccess || per_cu < 1) { fprintf(stderr, "kernel_launch: occupancy query gave %d\n", per_cu); per_cu = 1; }
        (void)hipGetLastError();
        grid = cus * 1;
        if (grid <= 0) grid = 256;
    }
    if (grid < 0) return;
    (void)hipMemsetAsync((char*)d_ws + WS_CTL, 0, 16384, stream);
    Args a{};
    for (int i = 0; i < 20; ++i) a.in[i] = (const float*)d_in[i];
    a.out = (float*)d_out; a.ws = (unsigned char*)d_ws;
    void* args[] = {&a};
#if MK_SINGLE
    a.ph_lo = 0; a.ph_hi = NPHASE;
    hipError_t e = hipLaunchCooperativeKernel((const void*)fwd_kernel, dim3(grid), dim3(512), args, LDS_BYTES, stream);
    if (e != hipSuccess) fprintf(stderr, "cooperative launch failed: %s (grid %d)\n", hipGetErrorString(e), grid);
#else
    for (int ph = 0; ph < NPHASE; ++ph) { a.ph_lo = ph; a.ph_hi = ph + 1;
        hipError_t e = hipLaunchCooperativeKernel((const void*)fwd_kernel, dim3(grid), dim3(512), args, LDS_BYTES, stream);
        if (e != hipSuccess) { fprintf(stderr, "cooperative launch %d failed: %s (grid %d)\n", ph, hipGetErrorString(e), grid); break; } }
#endif
}
```

```cpp
#include <hip/hip_runtime.h>
#include <hip/hip_cooperative_groups.h>
#include <cstdio>
#include <cstdint>
#include <cmath>
namespace cg = cooperative_groups;
namespace pg8 {
#define PG8_LAS __attribute__((address_space(3)))
typedef unsigned short bf16_t;
typedef short bf16x8 __attribute__((ext_vector_type(8)));
typedef float f32x4 __attribute__((ext_vector_type(4)));
typedef unsigned u32x4 __attribute__((ext_vector_type(4)));
__device__ __forceinline__ int lane_id_mbcnt() { int l; asm volatile("v_mbcnt_lo_u32_b32 %0, -1, 0\n\tv_mbcnt_hi_u32_b32 %0, -1, %0" : "=v"(l)); return l; }
constexpr int BM = 256, BK = 64, HALF = 128, HTB = HALF * BK * 2  , STAGE_BYTES = 8 * HTB, NXCD = 8, WGM = 8;

__host__ __device__ __forceinline__ int lds_byte(int r, int c) { const int st = (r >> 4) * 2 + (c >> 5), rr = r & 15, cc = c & 31, ob = rr * 64 + cc * 2; return st * 1024 + (ob ^ (((ob >> 9) & 1) << 5)); }
__host__ __device__ __forceinline__ void stage_rc(int b, int& R, int& C) { const int st = b / 1024, sb = b % 1024, swz = sb ^ (((sb >> 9) & 1) << 5); R = (st >> 1) * 16 + swz / 64; C = (st & 1) * 32 + (swz % 64) / 2; }
__host__ __device__ __forceinline__ int perm32(int rho) { const int n = rho >> 4, i = rho & 15; return 8 * (i >> 2) + 4 * n + (i & 3); }

struct Unit { int pm, pn; };
struct Gemm { const bf16_t* A; const bf16_t* Bt; int M, N, K, lda; };

struct StaticOrder {
    int nM, nN, nwg, G, c;
    __host__ __device__ void init(int M, int N, int G_, int c_) { nM = M / BM; nN = N / BM; nwg = nM * nN; G = G_; c = c_; }
    __host__ __device__ bool next(int i, Unit& u) const {
        const long L = (long)i * G + c; if (L >= nwg) return false;
        int wgid = (int)L; { const int q = nwg / NXCD, r = nwg % NXCD, xcd = wgid % NXCD, off = wgid / NXCD; wgid = (xcd < r ? xcd * (q + 1) : r * (q + 1) + (xcd - r) * q) + off; }
        const int nig = WGM * nN, gid = wgid / nig, fm = gid * WGM, gsz = (nM - fm) < WGM ? (nM - fm) : WGM;
        u.pm = fm + ((wgid % nig) % gsz); u.pn = (wgid % nig) / gsz; return true;
    }
    __device__ __forceinline__ void a_ready(const Unit&) const {}
    __device__ __forceinline__ void done(const Unit&) const {}
};

__device__ __forceinline__ unsigned cvt_pk_bf16(float lo, float hi) { unsigned r; asm volatile("v_cvt_pk_bf16_f32 %0, %1, %2" : "=v"(r) : "v"(lo), "v"(hi)); return r; }
__device__ __forceinline__ float bflo(unsigned u) { return __uint_as_float(u << 16); }
__device__ __forceinline__ float bfhi(unsigned u) { return __uint_as_float(u & 0xffff0000u); }
__device__ __forceinline__ float sigmoidf_(float x) { return __builtin_amdgcn_rcpf(1.f + __expf(-x)); }
__device__ __forceinline__ float siluf_(float x) { return x * __builtin_amdgcn_rcpf(1.f + __expf(-x)); }

constexpr int NPROJ = 19200;
struct EpiProj {
    static constexpr bool PERM = true, AFTER_DRAIN = false;
    bf16_t* O; float* DT;
    __device__ __forceinline__ void operator()(const f32x4 (&acc)[2][2][4][2], const Unit& u, int wr, int wc, int fr, int fq) const {
        const int row0 = u.pm * BM + wr * 64 + fr;
        if (u.pn == 74) {
            if (wc < 2) {
#pragma unroll
                for (int ai = 0; ai < 2; ++ai)
#pragma unroll
                    for (int m = 0; m < 4; ++m) { float* p = DT + (size_t)(row0 + ai * HALF + m * 16) * 64 + wc * 32 + 8 * fq;
                        *(f32x4*)p = acc[ai][0][m][0]; *(f32x4*)(p + 4) = acc[ai][0][m][1]; }
            }
            return;
        }
        const bool sg = u.pn >= 58, zs = u.pn >= 18 && u.pn < 34;
        const int col0 = u.pn * BM + wc * 32 + 8 * fq;
#pragma unroll
        for (int ai = 0; ai < 2; ++ai)
#pragma unroll
            for (int m = 0; m < 4; ++m) { bf16_t* rowp = O + (size_t)(row0 + ai * HALF + m * 16) * NPROJ + col0;
#pragma unroll
                for (int bj = 0; bj < 2; ++bj) { f32x4 v0 = acc[ai][bj][m][0], v1 = acc[ai][bj][m][1];
                    if (sg || zs) { f32x4 t0, t1;
#pragma unroll
                        for (int j = 0; j < 4; ++j) { t0[j] = __expf(-v0[j]); t1[j] = __expf(-v1[j]); }
#pragma unroll
                        for (int j = 0; j < 4; ++j) { t0[j] = __builtin_amdgcn_rcpf(1.f + t0[j]); t1[j] = __builtin_amdgcn_rcpf(1.f + t1[j]); }
                        if (sg) { v0 = t0; v1 = t1; } else { v0 = v0 * t0; v1 = v1 * t1; } }
                    u32x4 w; w.x = cvt_pk_bf16(v0[0], v0[1]); w.y = cvt_pk_bf16(v0[2], v0[3]); w.z = cvt_pk_bf16(v1[0], v1[1]); w.w = cvt_pk_bf16(v1[2], v1[3]);
                    *(u32x4*)(rowp + bj * HALF) = w; } }
    }
};
template <int MODE> struct EpiGate {
    static constexpr bool PERM = true, AFTER_DRAIN = false;
    bf16_t* O; int ldc; const bf16_t* G; int ldg;
    __device__ __forceinline__ void operator()(const f32x4 (&acc)[2][2][4][2], const Unit& u, int wr, int wc, int fr, int fq) const {
        const int row0 = u.pm * BM + wr * 64 + fr; const int col0 = u.pn * BM + wc * 32 + 8 * fq;
#pragma unroll
        for (int ai = 0; ai < 2; ++ai)
#pragma unroll
            for (int m = 0; m < 4; ++m) { const size_t row = (size_t)(row0 + ai * HALF + m * 16);
#pragma unroll
                for (int bj = 0; bj < 2; ++bj) { const int col = col0 + bj * HALF;
                    const u32x4 gv = *(const u32x4*)(G + row * ldg + col);
                    f32x4 v0 = acc[ai][bj][m][0], v1 = acc[ai][bj][m][1];
                    v0[0] *= bflo(gv.x); v0[1] *= bfhi(gv.x); v0[2] *= bflo(gv.y); v0[3] *= bfhi(gv.y);
                    v1[0] *= bflo(gv.z); v1[1] *= bfhi(gv.z); v1[2] *= bflo(gv.w); v1[3] *= bfhi(gv.w);
                    bf16_t* op = O + row * ldc + col;
                    if (MODE == 1) { const u32x4 ov = *(const u32x4*)op;
                        v0[0] += bflo(ov.x); v0[1] += bfhi(ov.x); v0[2] += bflo(ov.y); v0[3] += bfhi(ov.y);
                        v1[0] += bflo(ov.z); v1[1] += bfhi(ov.z); v1[2] += bflo(ov.w); v1[3] += bfhi(ov.w); }
                    u32x4 w; w.x = cvt_pk_bf16(v0[0], v0[1]); w.y = cvt_pk_bf16(v0[2], v0[3]); w.z = cvt_pk_bf16(v1[0], v1[1]); w.w = cvt_pk_bf16(v1[2], v1[3]);
                    *(u32x4*)op = w; } }
    }
};
struct EpiRes {
    static constexpr bool PERM = false, AFTER_DRAIN = false;
    const float* xin; float* out; const float* gate; int gstride;
    __device__ __forceinline__ void operator()(const f32x4 (&acc)[2][2][4][2], const Unit& u, int wr, int wc, int fr, int fq) const {
        const int row0 = u.pm * BM + wr * 64 + fr; const int col0 = u.pn * BM + wc * 32 + 4 * fq;
        const float* gp = gate + (size_t)(u.pm >> 4) * gstride + col0;
        f32x4 gv[2][2];
#pragma unroll
        for (int bj = 0; bj < 2; ++bj)
#pragma unroll
            for (int n = 0; n < 2; ++n) gv[bj][n] = *(const f32x4*)(gp + bj * HALF + n * 16);
#pragma unroll
        for (int ai = 0; ai < 2; ++ai)
#pragma unroll
            for (int m = 0; m < 4; ++m) { const size_t off = (size_t)(row0 + ai * HALF + m * 16) * 2048 + col0;
#pragma unroll
                for (int bj = 0; bj < 2; ++bj)
#pragma unroll
                    for (int n = 0; n < 2; ++n) { const f32x4 xv = *(const f32x4*)(xin + off + bj * HALF + n * 16);
                        *(f32x4*)(out + off + bj * HALF + n * 16) = xv + gv[bj][n] * acc[ai][bj][m][n]; } }
    }
};
struct EpiRes2 {
    static constexpr bool PERM = true, AFTER_DRAIN = false;
    const float* xin_f; const bf16_t* xin_b; bf16_t* out; const float* gate; int gstride;
    __device__ __forceinline__ void operator()(const f32x4 (&acc)[2][2][4][2], const Unit& u, int wr, int wc, int fr, int fq) const {
        const int row0 = u.pm * BM + wr * 64 + fr; const int col0 = u.pn * BM + wc * 32 + 8 * fq;
        const float* gp = gate + (size_t)(u.pm >> 4) * gstride + col0;
        f32x4 g0[2], g1[2];
#pragma unroll
        for (int bj = 0; bj < 2; ++bj) { g0[bj] = *(const f32x4*)(gp + bj * HALF); g1[bj] = *(const f32x4*)(gp + bj * HALF + 4); }
#pragma unroll
        for (int ai = 0; ai < 2; ++ai)
#pragma unroll
            for (int m = 0; m < 4; ++m) { const size_t off = (size_t)(row0 + ai * HALF + m * 16) * 2048 + col0;
#pragma unroll
                for (int bj = 0; bj < 2; ++bj) { f32x4 x0, x1;
                    if (xin_f) { x0 = *(const f32x4*)(xin_f + off + bj * HALF); x1 = *(const f32x4*)(xin_f + off + bj * HALF + 4); }
                    else { const u32x4 xv = *(const u32x4*)(xin_b + off + bj * HALF);
                        x0 = (f32x4){bflo(xv.x), bfhi(xv.x), bflo(xv.y), bfhi(xv.y)}; x1 = (f32x4){bflo(xv.z), bfhi(xv.z), bflo(xv.w), bfhi(xv.w)}; }
                    const f32x4 v0 = x0 + g0[bj] * acc[ai][bj][m][0], v1 = x1 + g1[bj] * acc[ai][bj][m][1];
                    u32x4 w; w.x = cvt_pk_bf16(v0[0], v0[1]); w.y = cvt_pk_bf16(v0[2], v0[3]); w.z = cvt_pk_bf16(v1[0], v1[1]); w.w = cvt_pk_bf16(v1[2], v1[3]);
                    *(u32x4*)(out + off + bj * HALF) = w; } }
    }
};
struct EpiSwiglu {
    static constexpr bool PERM = true, AFTER_DRAIN = false;
    bf16_t* O; int ldc;
    __device__ __forceinline__ void operator()(const f32x4 (&acc)[2][2][4][2], const Unit& u, int wr, int wc, int fr, int fq) const {
        const int row0 = u.pm * BM + wr * 64 + fr; const int col0 = u.pn * HALF + wc * 32 + 8 * fq;
#pragma unroll
        for (int ai = 0; ai < 2; ++ai)
#pragma unroll
            for (int m = 0; m < 4; ++m) { bf16_t* op = O + (size_t)(row0 + ai * HALF + m * 16) * ldc + col0;
                f32x4 v0, v1;
#pragma unroll
                for (int j = 0; j < 4; ++j) { v0[j] = siluf_(acc[ai][0][m][0][j]) * acc[ai][1][m][0][j]; v1[j] = siluf_(acc[ai][0][m][1][j]) * acc[ai][1][m][1][j]; }
                u32x4 w; w.x = cvt_pk_bf16(v0[0], v0[1]); w.y = cvt_pk_bf16(v0[2], v0[3]); w.z = cvt_pk_bf16(v1[0], v1[1]); w.w = cvt_pk_bf16(v1[2], v1[3]);
                *(u32x4*)op = w; }
    }
};

template <class Epi, class Sched, bool ALIGN_EPI = false, bool SP2 = false>
__device__ __forceinline__ void gemm_phase(PG8_LAS unsigned char* lds, const Gemm g, const Sched& S, const Epi& E, int wave_s) {
    int tid = wave_s * 64 + lane_id_mbcnt(); asm volatile("" : "+v"(tid));        const int wid = __builtin_amdgcn_readfirstlane(tid >> 6), lane = tid & 63, wr = wid >> 2, wc = wid & 3, fr = lane & 15, fq = lane >> 4;
    const int K = g.K, nt = K / BK;
    unsigned voffA[2], voffB[2];
#pragma unroll
    for (int i = 0; i < 2; ++i) { int R, C; stage_rc(tid * 16 + i * 8192, R, C); const int Rb = Epi::PERM ? ((R & ~31) + perm32(R & 31)) : R;
        voffA[i] = (unsigned)(R * g.lda + C) * 2u; voffB[i] = (unsigned)(Rb * K + C) * 2u; }
    const size_t kstep = (size_t)(BK * 2);
    const size_t hstepA = (size_t)HALF * g.lda * 2, hstepB = (size_t)HALF * K * 2;
    const size_t tstepA = 2 * hstepA, tstepB = 2 * hstepB;
    const unsigned ldsw = (unsigned)wid * 1024u;
    const int aoff = lds_byte(wr * 64 + fr, fq * 8), boff = lds_byte(wc * 32 + fr, fq * 8);
#define PG8_SA(b, h) (((b) * 2 + (h)) * HTB)
#define PG8_SB(b, h) ((4 + (b) * 2 + (h)) * HTB)
#define PG8_STAGE(bufoff, gbase, voff) do { _Pragma("unroll") for (int _i = 0; _i < 2; ++_i) \
        __builtin_amdgcn_global_load_lds((const unsigned*)((const char*)(gbase) + (voff)[_i]), (PG8_LAS unsigned*)(lds + (bufoff) + ldsw + _i * 8192), 16, 0, 0); } while (0)
#define PG8_LDA(dst, b, h) do { _Pragma("unroll") for (int m = 0; m < 4; ++m) _Pragma("unroll") for (int k = 0; k < 2; ++k) dst[m][k] = *(const PG8_LAS bf16x8*)(lds + PG8_SA(b, h) + aoff + m * 2048 + k * 1024); } while (0)
#define PG8_LDB(dst, b, h) do { _Pragma("unroll") for (int n = 0; n < 2; ++n) _Pragma("unroll") for (int k = 0; k < 2; ++k) dst[n][k] = *(const PG8_LAS bf16x8*)(lds + PG8_SB(b, h) + boff + n * 2048 + k * 1024); } while (0)
#define PG8_MMA(ai, bj, At, Bt) do { __builtin_amdgcn_s_setprio(1); _Pragma("unroll") for (int m = 0; m < 4; ++m) _Pragma("unroll") for (int n = 0; n < 2; ++n) _Pragma("unroll") for (int k = 0; k < 2; ++k) \
        acc[ai][bj][m][n] = __builtin_amdgcn_mfma_f32_16x16x32_bf16(Bt[n][k], At[m][k], acc[ai][bj][m][n], 0, 0, 0); __builtin_amdgcn_s_setprio(0); } while (0)
#define PG8_WAIT_V(n) asm volatile("s_waitcnt vmcnt(" #n ")" ::: "memory")
#define PG8_WAIT_L(n) asm volatile("s_waitcnt lgkmcnt(" #n ")" ::: "memory")
#define PG8_BAR __builtin_amdgcn_s_barrier()
#define PG8_SCHED __builtin_amdgcn_sched_barrier(0)
    Unit cur, nxt; int ui = 0;
    if (!S.next(0, cur)) return;
    f32x4 acc[2][2][4][2];
#pragma unroll
    for (int a = 0; a < 2; ++a)
#pragma unroll
        for (int b = 0; b < 2; ++b)
#pragma unroll
            for (int m = 0; m < 4; ++m)
#pragma unroll
                for (int n = 0; n < 2; ++n) acc[a][b][m][n] = (f32x4){0.f, 0.f, 0.f, 0.f};
    bf16x8 At[4][2], B0[2][2], B1[2][2];
    const char* cA = (const char*)g.A + (size_t)cur.pm * tstepA; const char* cB = (const char*)g.Bt + (size_t)cur.pn * tstepB;
    S.a_ready(cur);
    if constexpr (SP2) {
        PG8_STAGE(PG8_SB(0, 0), cB, voffB); PG8_STAGE(PG8_SB(0, 1), cB + hstepB, voffB); PG8_STAGE(PG8_SA(0, 0), cA, voffA); PG8_STAGE(PG8_SA(0, 1), cA + hstepA, voffA);
        if (wr == 1) PG8_BAR;
        PG8_WAIT_V(2); PG8_BAR;
        PG8_STAGE(PG8_SB(1, 0), cB + kstep, voffB); PG8_STAGE(PG8_SA(1, 0), cA + kstep, voffA); PG8_STAGE(PG8_SB(1, 1), cB + hstepB + kstep, voffB);
        PG8_WAIT_V(6); PG8_BAR;
    } else {
        PG8_STAGE(PG8_SB(0, 0), cB, voffB); PG8_STAGE(PG8_SA(0, 0), cA, voffA); PG8_STAGE(PG8_SB(0, 1), cB + hstepB, voffB); PG8_STAGE(PG8_SA(0, 1), cA + hstepA, voffA);
        if (wr == 1) PG8_BAR;
        PG8_WAIT_V(4); PG8_BAR;
        PG8_STAGE(PG8_SB(1, 0), cB + kstep, voffB); PG8_STAGE(PG8_SA(1, 0), cA + kstep, voffA); PG8_STAGE(PG8_SB(1, 1), cB + hstepB + kstep, voffB);
        PG8_WAIT_V(6); PG8_BAR;
    }
    for (;;) {
        const bool has_next = S.next(ui + 1, nxt);
        const char* nA = has_next ? (const char*)g.A + (size_t)nxt.pm * tstepA : cA; const char* nB = has_next ? (const char*)g.Bt + (size_t)nxt.pn * tstepB : cB;
        for (int t = 0; t < nt; t += 2) {
            const bool last = (t == nt - 2);
            const char* a1 = cA + (size_t)(t + 1) * kstep;
            const char* a2 = last ? nA : cA + (size_t)(t + 2) * kstep; const char* b2 = last ? nB : cB + (size_t)(t + 2) * kstep;
            const char* a3 = a2 + kstep; const char* b3 = b2 + kstep;
            if (last && has_next) S.a_ready(nxt);
            if constexpr (SP2) {
            PG8_LDB(B0, 0, 0); PG8_LDB(B1, 0, 1); PG8_SCHED; PG8_LDA(At, 0, 0); PG8_STAGE(PG8_SA(1, 1), a1 + hstepA, voffA);
            PG8_WAIT_V(8); PG8_WAIT_L(0); PG8_BAR; PG8_MMA(0, 0, At, B0); PG8_MMA(0, 1, At, B1); PG8_BAR; PG8_SCHED;
            PG8_LDA(At, 0, 1); PG8_STAGE(PG8_SB(0, 0), b2, voffB); PG8_STAGE(PG8_SB(0, 1), b2 + hstepB, voffB); PG8_STAGE(PG8_SA(0, 0), a2, voffA);
            PG8_WAIT_V(8); PG8_WAIT_L(0); PG8_BAR; PG8_MMA(1, 0, At, B0); PG8_MMA(1, 1, At, B1); PG8_BAR; PG8_SCHED;
            PG8_LDB(B0, 1, 0); PG8_LDB(B1, 1, 1); PG8_SCHED; PG8_LDA(At, 1, 0); PG8_STAGE(PG8_SA(0, 1), a2 + hstepA, voffA);
            PG8_WAIT_V(8); PG8_WAIT_L(0); PG8_BAR; PG8_MMA(0, 0, At, B0); PG8_MMA(0, 1, At, B1); PG8_BAR; PG8_SCHED;
            PG8_LDA(At, 1, 1); PG8_STAGE(PG8_SB(1, 0), b3, voffB); PG8_STAGE(PG8_SB(1, 1), b3 + hstepB, voffB); PG8_STAGE(PG8_SA(1, 0), a3, voffA);
            PG8_WAIT_V(8); PG8_WAIT_L(0); PG8_BAR; PG8_MMA(1, 0, At, B0); PG8_MMA(1, 1, At, B1); PG8_BAR; PG8_SCHED;
            } else {
            PG8_LDB(B0, 0, 0); PG8_SCHED; PG8_LDA(At, 0, 0); PG8_STAGE(PG8_SA(1, 1), a1 + hstepA, voffA);
            PG8_WAIT_L(8); PG8_BAR; PG8_WAIT_L(0); PG8_MMA(0, 0, At, B0); PG8_BAR; PG8_SCHED;
            PG8_LDB(B1, 0, 1); PG8_STAGE(PG8_SB(0, 0), b2, voffB);
            PG8_BAR; PG8_WAIT_L(0); PG8_MMA(0, 1, At, B1); PG8_BAR;
            PG8_LDA(At, 0, 1); PG8_STAGE(PG8_SA(0, 0), a2, voffA);
            PG8_BAR; PG8_WAIT_L(0); PG8_MMA(1, 0, At, B0); PG8_BAR; PG8_SCHED;
            PG8_STAGE(PG8_SB(0, 1), b2 + hstepB, voffB);
            PG8_WAIT_V(6); PG8_BAR; PG8_MMA(1, 1, At, B1); PG8_BAR;
            PG8_LDB(B0, 1, 0); PG8_SCHED; PG8_LDA(At, 1, 0); PG8_STAGE(PG8_SA(0, 1), a2 + hstepA, voffA);
            PG8_WAIT_L(8); PG8_BAR; PG8_WAIT_L(0); PG8_MMA(0, 0, At, B0); PG8_BAR; PG8_SCHED;
            PG8_LDB(B1, 1, 1); PG8_STAGE(PG8_SB(1, 0), b3, voffB);
            PG8_BAR; PG8_WAIT_L(0); PG8_MMA(0, 1, At, B1); PG8_BAR;
            PG8_LDA(At, 1, 1); PG8_STAGE(PG8_SA(1, 0), a3, voffA);
            PG8_BAR; PG8_WAIT_L(0); PG8_MMA(1, 0, At, B0); PG8_BAR; PG8_SCHED;
            PG8_STAGE(PG8_SB(1, 1), b3 + hstepB, voffB);
            PG8_WAIT_V(6); PG8_BAR; PG8_MMA(1, 1, At, B1); PG8_BAR;
            }
        }
        if constexpr (ALIGN_EPI) { if (wr == 0) PG8_BAR; }
        if constexpr (!Epi::AFTER_DRAIN) { E(acc, cur, wr, wc, fr, fq); S.done(cur); }
        if (!has_next) break;
#pragma unroll
        for (int a = 0; a < 2; ++a)
#pragma unroll
            for (int b = 0; b < 2; ++b)
#pragma unroll
                for (int m = 0; m < 4; ++m)
#pragma unroll
                    for (int n = 0; n < 2; ++n) acc[a][b][m][n] = (f32x4){0.f, 0.f, 0.f, 0.f};
        cur = nxt; cA = nA; cB = nB; ++ui;
        if constexpr (ALIGN_EPI) { if (wr == 1) PG8_BAR; }
    }
    PG8_WAIT_V(0);
    if constexpr (!ALIGN_EPI) { if (wr == 0) PG8_BAR; }
    PG8_BAR;
    if constexpr (Epi::AFTER_DRAIN) { E.fused(acc, cur, wr, wc, fr, fq, lds, wid, lane); S.done(cur); }
#undef PG8_SA
#undef PG8_SB
#undef PG8_STAGE
#undef PG8_LDA
#undef PG8_LDB
#undef PG8_MMA
#undef PG8_WAIT_V
#undef PG8_WAIT_L
#undef PG8_BAR
#undef PG8_SCHED
}
}
#define LAS __attribute__((address_space(3)))
typedef unsigned short bf16_t;
typedef short bf16x8 __attribute__((ext_vector_type(8)));
typedef short s16x4 __attribute__((ext_vector_type(4)));
typedef float f32x4 __attribute__((ext_vector_type(4)));
typedef unsigned u32x4 __attribute__((ext_vector_type(4)));
typedef unsigned u32x2 __attribute__((ext_vector_type(2)));
using pg8::cvt_pk_bf16; using pg8::bflo; using pg8::bfhi; using pg8::siluf_;

constexpr int D_MODEL = 2048, SEQ = 4096, M_TOK = 16384;
constexpr int NPROJ = pg8::NPROJ;
constexpr int N_IN = 19008, D_FF = 5632;
constexpr int COL_Q = 0, COL_K = 1536, COL_V = 3072, COL_Z = 4608, COL_XBC = 8704, COL_GA = 14848, COL_GS = 16896;
constexpr int NPHASE = 22;

constexpr size_t MiB = 1u << 20;
constexpr size_t WS_CTL = 0, CTL_ZERO_BYTES = 1 * MiB;
constexpr size_t WS_MOD = 65536;
constexpr size_t WS_LSE = 1 * MiB;
constexpr size_t WS_DT = 2 * MiB;
constexpr size_t WS_W = 8 * MiB;
constexpr size_t WO_IN = 0, WO_A = 78643200, WO_S = 80740352, WO_O = 97517568, WO_FI = 105906176, WO_FO = 152043520, WL_BYTES = 175112192;
constexpr size_t WS_H = WS_W + 2 * WL_BYTES;
constexpr size_t WS_PROJ = WS_H + (size_t)M_TOK * 2048 * 2;
constexpr size_t WS_XB = WS_PROJ + (size_t)M_TOK * NPROJ * 2;
constexpr size_t WS_END = WS_XB + (size_t)M_TOK * 2048 * 2;
constexpr int LDS_BYTES = 147456;

struct Args { const float* in[20]; float* out; unsigned char* ws; int ph_lo, ph_hi; };

template <int CTRL> __device__ __forceinline__ float dpp_f(float v) { return __int_as_float(__builtin_amdgcn_update_dpp(0, __float_as_int(v), CTRL, 0xf, 0xf, false)); }
__device__ __forceinline__ float xor16_sum(float v) { const auto r = __builtin_amdgcn_permlane16_swap(__float_as_uint(v), __float_as_uint(v), false, false); return __uint_as_float(r[0]) + __uint_as_float(r[1]); }
__device__ __forceinline__ float xor32_sum(float v) { const auto r = __builtin_amdgcn_permlane32_swap(__float_as_uint(v), __float_as_uint(v), false, false); return __uint_as_float(r[0]) + __uint_as_float(r[1]); }
__device__ __forceinline__ float xor16_max(float v) { const auto r = __builtin_amdgcn_permlane16_swap(__float_as_uint(v), __float_as_uint(v), false, false); return fmaxf(__uint_as_float(r[0]), __uint_as_float(r[1])); }
__device__ __forceinline__ float xor32_max(float v) { const auto r = __builtin_amdgcn_permlane32_swap(__float_as_uint(v), __float_as_uint(v), false, false); return fmaxf(__uint_as_float(r[0]), __uint_as_float(r[1])); }
__device__ __forceinline__ float wave_sum(float v) {
    v += dpp_f<0x128>(v); v += dpp_f<0x124>(v); v += dpp_f<0x122>(v); v += dpp_f<0x121>(v);
    v = xor16_sum(v); v = xor32_sum(v);
    return v;
}
__device__ __forceinline__ float wave_incl_scan(float v, int lane) {
#pragma unroll
    for (int o = 1; o < 64; o <<= 1) { const float t = __int_as_float(__builtin_amdgcn_ds_bpermute(((lane - o) & 63) << 2, __float_as_int(v))); if (lane >= o) v += t; }
    return v;
}
__device__ __forceinline__ float lane63(float v) { return __int_as_float(__builtin_amdgcn_readlane(__float_as_int(v), 63)); }
typedef short v4i16_t __attribute__((ext_vector_type(4)));
__device__ __forceinline__ s16x4 ldtr(LAS unsigned char* p) { return __builtin_bit_cast(s16x4, __builtin_amdgcn_ds_read_tr16_b64_v4i16((LAS v4i16_t*)p)); }
__device__ __forceinline__ bf16x8 cat8(s16x4 lo, s16x4 hi) { return (bf16x8){lo[0], lo[1], lo[2], lo[3], hi[0], hi[1], hi[2], hi[3]}; }
__device__ __forceinline__ f32x4 mfma16(bf16x8 a, bf16x8 b, f32x4 c) { return __builtin_amdgcn_mfma_f32_16x16x32_bf16(a, b, c, 0, 0, 0); }
#define LDS_WAIT() asm volatile("s_waitcnt lgkmcnt(0)" ::: "memory")

__device__ __forceinline__ void tr_item(const float* W, int Nsrc, bf16_t* WT, int K, int k0, int s0, int n0, LAS float* scr, int lane) {
    const int c = lane & 7;
    if (s0 < 0) {
#pragma unroll
        for (int j = 0; j < 4; ++j) { const int n = (lane >> 3) + 8 * j; *(u32x4*)(WT + (size_t)(n0 + n) * K + k0 + 8 * c) = (u32x4){0u, 0u, 0u, 0u}; }
        return;
    }
    { const float* wp = W + (size_t)(k0 + (lane >> 5)) * Nsrc + s0 + (lane & 31); float v[32];
#pragma unroll
        for (int i = 0; i < 32; ++i) v[i] = wp[(size_t)(2 * i) * Nsrc];
#pragma unroll
        for (int i = 0; i < 32; ++i) scr[(2 * i + (lane >> 5)) * 33 + (lane & 31)] = v[i]; }
    LDS_WAIT();
#pragma unroll
    for (int j = 0; j < 4; ++j) { const int n = (lane >> 3) + 8 * j; const LAS float* s = scr + (8 * c) * 33 + n;
        u32x4 o; o.x = cvt_pk_bf16(s[0 * 33], s[1 * 33]); o.y = cvt_pk_bf16(s[2 * 33], s[3 * 33]); o.z = cvt_pk_bf16(s[4 * 33], s[5 * 33]); o.w = cvt_pk_bf16(s[6 * 33], s[7 * 33]);
        *(u32x4*)(WT + (size_t)(n0 + n) * K + k0 + 8 * c) = o; }
    LDS_WAIT();
}

struct SideItem { const float* src; bf16_t* dst; int nsrc; int mode; };
constexpr int IPL32 = 38400 + 1024 + 8192 + 4096 + 22528 + 11264;
__device__ __forceinline__ SideItem side_decode(const Args& a, int l, int it, int lane);
__device__ __forceinline__ void side_issue(const SideItem& s, float (&v)[16]);
__device__ __forceinline__ void side_drain(const SideItem& s, const float (&v)[16]);
__device__ __forceinline__ void phase_prep(const Args& a, LAS unsigned char* lds, int tid, int lane, int wave, int bx, int G, int nlayers) {
    float* MOD = (float*)(a.ws + WS_MOD);
    const float* cin = a.in[1]; const float* w_mod = a.in[5]; const float* b_mod = a.in[6];
    LAS f32x4* red = (LAS f32x4*)lds;
    for (int it = bx; it < 256; it += G) {
        const int l = it >> 7, c96 = it & 127;
        const int par = lane >= 24 ? 1 : 0, cl = lane - 24 * par; const bool act = lane < 48;
        const float* Wm = w_mod + (size_t)l * 2048 * 12288 + c96 * 96 + (act ? cl : 0) * 4;
        const int k0 = wave * 256 + par;
        f32x4 acc0 = {0.f, 0.f, 0.f, 0.f}, acc1 = acc0, acc2 = acc0, acc3 = acc0;
#pragma unroll 8
        for (int kk = 0; kk < 128; ++kk) { const int k = k0 + 2 * kk; const f32x4 wv = *(const f32x4*)(Wm + (size_t)k * 12288);
            acc0 += siluf_(cin[k]) * wv; acc1 += siluf_(cin[2048 + k]) * wv; acc2 += siluf_(cin[4096 + k]) * wv; acc3 += siluf_(cin[6144 + k]) * wv; }
        if (act) { LAS f32x4* rp = red + ((wave * 2 + par) * 4) * 24 + cl; rp[0] = acc0; rp[24] = acc1; rp[48] = acc2; rp[72] = acc3; }
        __syncthreads();
        if (tid < 384) { const int b = tid / 96, ci = tid % 96; float s = b_mod[l * 12288 + c96 * 96 + ci];
#pragma unroll
            for (int w = 0; w < 16; ++w) s += ((const LAS float*)lds)[((w * 4 + b) * 24 + (ci >> 2)) * 4 + (ci & 3)];
            MOD[(size_t)(l * 4 + b) * 12288 + c96 * 96 + ci] = s; }
        __syncthreads();
    }
    LAS float* scr = (LAS float*)(lds + wave * 8704);
    const int gw = bx * 8 + wave, NGW = G * 8;
    constexpr int IPL = 19200 + 512 + 4096 + 2048 + 11264 + 5632;
    for (int it = gw; it < nlayers * IPL; it += NGW) {
        const int l = it / IPL; int r = it % IPL;
        unsigned char* wb = a.ws + WS_W + (size_t)l * WL_BYTES;
        if (r < 19200) { const int kb = r / 600, nb = r % 600, n0 = nb * 32;
            const int s0 = n0 < 14848 ? n0 : (n0 < 18944 ? n0 + 64 : (n0 < 19008 ? 14848 + (n0 - 18944) : -1));
            tr_item(a.in[7] + (size_t)l * 2048 * N_IN, N_IN, (bf16_t*)(wb + WO_IN), 2048, kb * 64, s0, n0, scr, lane); continue; }
        r -= 19200;
        if (r < 512) { const int kb = r >> 6, nb = r & 63; tr_item(a.in[14] + (size_t)l * 512 * 2048, 2048, (bf16_t*)(wb + WO_A), 512, kb * 64, nb * 32, nb * 32, scr, lane); continue; }
        r -= 512;
        if (r < 4096) { const int kb = r >> 6, nb = r & 63; tr_item(a.in[15] + (size_t)l * 4096 * 2048, 2048, (bf16_t*)(wb + WO_S), 4096, kb * 64, nb * 32, nb * 32, scr, lane); continue; }
        r -= 4096;
        if (r < 2048) { const int kb = r >> 6, nb = r & 63; tr_item(a.in[16] + (size_t)l * 2048 * 2048, 2048, (bf16_t*)(wb + WO_O), 2048, kb * 64, nb * 32, nb * 32, scr, lane); continue; }
        r -= 2048;
        if (r < 11264) { const int kb = r / 352, nb = r % 352, n0 = nb * 32, t = n0 >> 8, j = n0 & 255;
            const int s0 = j < 128 ? 128 * t + j : D_FF + 128 * t + (j - 128);
            tr_item(a.in[17] + (size_t)l * 2048 * 2 * D_FF, 2 * D_FF, (bf16_t*)(wb + WO_FI), 2048, kb * 64, s0, n0, scr, lane); continue; }
        r -= 11264;
        { const int kb = r >> 6, nb = r & 63; tr_item(a.in[18] + (size_t)l * D_FF * 2048, 2048, (bf16_t*)(wb + WO_FO), D_FF, kb * 64, nb * 32, nb * 32, scr, lane); }
    }
    if (nlayers == 1) {
        for (int it = 32 * NGW + gw; it < IPL32; it += NGW) { float v[16]; const SideItem sd = side_decode(a, 1, it, lane); side_issue(sd, v); side_drain(sd, v); }
    }
}

template <bool FINAL>
__device__ __forceinline__ void phase_norm(const float* x, const float* w, const float* sc, const float* sh, bf16_t* H, float* outf, int lane, int gw, int NGW) {
    for (int blk = gw; blk < M_TOK / 8; blk += NGW) {
        const int m0 = blk * 8, b = m0 >> 12;
        f32x4 A[8], B[8];
#pragma unroll
        for (int j = 0; j < 8; ++j) { const int col = 4 * (lane + 64 * j); A[j] = *(const f32x4*)(w + col);
            if (!FINAL) { const f32x4 scv = *(const f32x4*)(sc + (size_t)b * 12288 + col); A[j] = A[j] * (1.0f + scv); B[j] = *(const f32x4*)(sh + (size_t)b * 12288 + col); } }
        f32x4 v[8], nx[8];
        { const f32x4* xr = (const f32x4*)(x + (size_t)m0 * 2048) + lane;
#pragma unroll
            for (int j = 0; j < 8; ++j) nx[j] = xr[64 * j]; }
#pragma unroll 1
        for (int r = 0; r < 8; ++r) { const int m = m0 + r;
#pragma unroll
            for (int j = 0; j < 8; ++j) v[j] = nx[j];
            if (r + 1 < 8) { const f32x4* xr = (const f32x4*)(x + (size_t)(m + 1) * 2048) + lane;
#pragma unroll
                for (int j = 0; j < 8; ++j) nx[j] = xr[64 * j]; }
            float ss = 0.f;
#pragma unroll
            for (int j = 0; j < 8; ++j) ss += (v[j].x * v[j].x + v[j].y * v[j].y) + (v[j].z * v[j].z + v[j].w * v[j].w);
            ss = wave_sum(ss);
            const float rstd = 1.0f / sqrtf(ss * (1.0f / 2048.0f) + 1e-6f);
#pragma unroll
            for (int j = 0; j < 8; ++j) { const int col = 4 * (lane + 64 * j);
                if (FINAL) { *(f32x4*)(outf + (size_t)m * 2048 + col) = v[j] * rstd * A[j]; }
                else { const f32x4 o = v[j] * rstd * A[j] + B[j];
                    u32x2 pk; pk.x = cvt_pk_bf16(o.x, o.y); pk.y = cvt_pk_bf16(o.z, o.w);
                    *(u32x2*)(H + (size_t)m * 2048 + col) = pk; } }
        }
    }
}

template <bool FINAL>
__device__ __forceinline__ void phase_norm_b(const bf16_t* xb, const float* w, const float* sc, const float* sh, bf16_t* H, float* outf, int lane, int gw, int NGW) {
    for (int blk = gw; blk < M_TOK / 8; blk += NGW) {
        const int m0 = blk * 8, b = m0 >> 12;
        f32x4 A0[4], A1[4], B0[4], B1[4];
#pragma unroll
        for (int j = 0; j < 4; ++j) { const int col = 8 * (lane + 64 * j); A0[j] = *(const f32x4*)(w + col); A1[j] = *(const f32x4*)(w + col + 4);
            if (!FINAL) { const float* scp = sc + (size_t)b * 12288 + col; const float* shp = sh + (size_t)b * 12288 + col;
                A0[j] = A0[j] * (1.0f + *(const f32x4*)scp); A1[j] = A1[j] * (1.0f + *(const f32x4*)(scp + 4)); B0[j] = *(const f32x4*)shp; B1[j] = *(const f32x4*)(shp + 4); } }
        u32x4 nx[4];
        { const u32x4* xr = (const u32x4*)(xb + (size_t)m0 * 2048) + lane;
#pragma unroll
            for (int j = 0; j < 4; ++j) nx[j] = xr[64 * j]; }
#pragma unroll 1
        for (int r = 0; r < 8; ++r) { const int m = m0 + r;
            f32x4 v0[4], v1[4];
#pragma unroll
            for (int j = 0; j < 4; ++j) { const u32x4 q = nx[j]; v0[j] = (f32x4){bflo(q.x), bfhi(q.x), bflo(q.y), bfhi(q.y)}; v1[j] = (f32x4){bflo(q.z), bfhi(q.z), bflo(q.w), bfhi(q.w)}; }
            if (r + 1 < 8) { const u32x4* xr = (const u32x4*)(xb + (size_t)(m + 1) * 2048) + lane;
#pragma unroll
                for (int j = 0; j < 4; ++j) nx[j] = xr[64 * j]; }
            float ss = 0.f;
#pragma unroll
            for (int j = 0; j < 4; ++j) { const f32x4 q0 = v0[j] * v0[j], q1 = v1[j] * v1[j]; ss += ((q0.x + q0.y) + (q0.z + q0.w)) + ((q1.x + q1.y) + (q1.z + q1.w)); }
            ss = wave_sum(ss);
            const float rstd = 1.0f / sqrtf(ss * (1.0f / 2048.0f) + 1e-6f);
#pragma unroll
            for (int j = 0; j < 4; ++j) { const int col = 8 * (lane + 64 * j);
                if (FINAL) { *(f32x4*)(outf + (size_t)m * 2048 + col) = v0[j] * rstd * A0[j]; *(f32x4*)(outf + (size_t)m * 2048 + col + 4) = v1[j] * rstd * A1[j]; }
                else { const f32x4 o0 = v0[j] * rstd * A0[j] + B0[j], o1 = v1[j] * rstd * A1[j] + B1[j];
                    u32x4 pk; pk.x = cvt_pk_bf16(o0.x, o0.y); pk.y = cvt_pk_bf16(o0.z, o0.w); pk.z = cvt_pk_bf16(o1.x, o1.y); pk.w = cvt_pk_bf16(o1.z, o1.w);
                    *(u32x4*)(H + (size_t)m * 2048 + col) = pk; } }
        }
    }
}

__device__ __forceinline__ void att_decode(int u, int& g, int& b, int& hh, int& d, int& r, int& n) {
    g = u >> 9; const int rem = u & 511; b = rem >> 7; hh = (rem >> 5) & 3; const int bi = rem & 31;
    d = g == 0 ? 1 : (g == 1 ? 4 : 16); const int nb = 32 / d; r = bi / nb; n = bi % nb;
}
__device__ __forceinline__ void phase_attn(bf16_t* P, float* LSE, const float* rel_bias, LAS unsigned char* lds, int bx, int G, int tid_) {
    int tid = tid_; asm volatile("" : "+v"(tid)); const int lane = tid & 63, wave = __builtin_amdgcn_readfirstlane(tid >> 6);
    constexpr int RS = 272;
    LAS unsigned char* Ks = lds; LAS unsigned char* Vs = lds + 256 * RS; LAS float* biasT = (LAS float*)(lds + 2 * 256 * RS);
    const int l15 = lane & 15, q4 = lane >> 4, qi = 16 * wave + l15;
    int u = bx; if (u >= 1536) return;
    u32x4 kr[8], vr[8]; bf16x8 Qn[4];
#define ATT_LOAD(uu) do { int g_, b_, hh_, d_, r_, n_; att_decode((uu), g_, b_, hh_, d_, r_, n_); const int colq_ = g_ * 512 + hh_ * 128; \
        _Pragma("unroll") for (int i = 0; i < 8; ++i) { const int idx = tid + 512 * i, key = idx >> 4, ch = idx & 15; const int si = (n_ - 1) * 128 + key; \
            kr[i] = (u32x4){0u, 0u, 0u, 0u}; vr[i] = (u32x4){0u, 0u, 0u, 0u}; \
            if (n_ > 0 || i >= 4) { const bf16_t* rp = P + (size_t)(b_ * SEQ + si * d_ + r_) * NPROJ + colq_ + ch * 8; kr[i] = *(const u32x4*)(rp + COL_K); vr[i] = *(const u32x4*)(rp + COL_V); } } \
        { const bf16_t* qp_ = P + (size_t)(b_ * SEQ + (n_ * 128 + qi) * d_ + r_) * NPROJ + colq_; \
          _Pragma("unroll") for (int ks = 0; ks < 4; ++ks) Qn[ks] = *(const bf16x8*)(qp_ + 32 * ks + 8 * q4); } } while (0)
    ATT_LOAD(u);
    for (;;) {
        int g, b, hh, d, r, n; att_decode(u, g, b, hh, d, r, n);
        const int colq = g * 512 + hh * 128;
#pragma unroll
        for (int i = 0; i < 8; ++i) { const int idx = tid + 512 * i, key = idx >> 4, ch = idx & 15;
            *(LAS u32x4*)(Ks + key * RS + ch * 16) = kr[i]; *(LAS u32x4*)(Vs + key * RS + ch * 16) = vr[i]; }
        if (tid < 160) { const int steps = tid - 15; float bv = -INFINITY;
            if (steps >= 0 && steps <= 128) { const int dist = steps * d; int bk;
                if (dist < 16) bk = dist; else { const int lg = 16 + (int)(logf((float)dist / 16.0f) / 4.852030263919617f * 16.0f); bk = lg < 31 ? lg : 31; }
                bv = rel_bias[bk * 12 + g * 4 + hh]; }
            biasT[tid] = bv; }
        bf16x8 Qf[4];
#pragma unroll
        for (int ks = 0; ks < 4; ++ks) Qf[ks] = Qn[ks];
        __syncthreads();
        const int un = u + G;
        if (un < 1536) ATT_LOAD(un);
        const size_t tq = (size_t)(b * SEQ + (n * 128 + qi) * d + r);
        bf16_t* qp = P + tq * NPROJ + colq;
        f32x4 S[9];
        LAS unsigned char* kbase = Ks + (16 * wave + l15) * RS + q4 * 16;
#pragma unroll
        for (int tt = 0; tt < 9; ++tt) { S[tt] = (f32x4){0.f, 0.f, 0.f, 0.f};
#pragma unroll
            for (int ks = 0; ks < 4; ++ks) { const bf16x8 Kf = *(const LAS bf16x8*)(kbase + tt * 16 * RS + ks * 64); S[tt] = mfma16(Kf, Qf[ks], S[tt]); } }
        __builtin_amdgcn_sched_barrier(0);
        const float scale = 0.08838834764831845f;
        float mx = -INFINITY;
        {
            const LAS float* bp = biasT + (143 + l15 - 4 * q4);
#pragma unroll
            for (int tt = 0; tt < 9; ++tt)
#pragma unroll
                for (int e = 0; e < 4; ++e) S[tt][e] = S[tt][e] * scale + bp[-(16 * tt + e)];
            if (n == 0) {
#pragma unroll
                for (int tt = 0; tt < 9; ++tt)
#pragma unroll
                    for (int e = 0; e < 4; ++e) { if (wave + tt < 8) S[tt][e] = -INFINITY; }
            }
#pragma unroll
            for (int tt = 0; tt < 9; ++tt)
#pragma unroll
                for (int e = 0; e < 4; ++e) mx = fmaxf(mx, S[tt][e]);
        }
        mx = xor16_max(mx); mx = xor32_max(mx);
        float sum = 0.f;
#pragma unroll
        for (int tt = 0; tt < 9; ++tt)
#pragma unroll
            for (int e = 0; e < 4; ++e) { const float p = __expf(S[tt][e] - mx); S[tt][e] = p; sum += p; }
        sum = xor16_sum(sum); sum = xor32_sum(sum);
        bf16x8 Pf[5];
#pragma unroll
        for (int kk = 0; kk < 5; ++kk) { u32x4 w; w.x = cvt_pk_bf16(S[2 * kk][0], S[2 * kk][1]); w.y = cvt_pk_bf16(S[2 * kk][2], S[2 * kk][3]);
            if (kk < 4) { w.z = cvt_pk_bf16(S[2 * kk + 1][0], S[2 * kk + 1][1]); w.w = cvt_pk_bf16(S[2 * kk + 1][2], S[2 * kk + 1][3]); } else { w.z = 0u; w.w = 0u; }
            Pf[kk] = __builtin_bit_cast(bf16x8, w); }
        const float inv = 1.0f / sum;
        LAS unsigned char* vbase = Vs + (16 * wave + 4 * q4 + (l15 >> 2)) * RS + (l15 & 3) * 8;
        bf16_t* op = qp + 4 * q4;
#pragma unroll
        for (int dt = 0; dt < 8; ++dt) { f32x4 o = {0.f, 0.f, 0.f, 0.f};
#pragma unroll
            for (int kk = 0; kk < 5; ++kk) {
                const s16x4 lo = ldtr(vbase + (32 * kk) * RS + dt * 32);
                s16x4 hi = {0, 0, 0, 0};
                if (kk < 4) hi = ldtr(vbase + (32 * kk + 16) * RS + dt * 32);
                o = mfma16(cat8(lo, hi), Pf[kk], o); }
            u32x2 pk; pk.x = cvt_pk_bf16(o[0] * inv, o[1] * inv); pk.y = cvt_pk_bf16(o[2] * inv, o[3] * inv);
            *(u32x2*)(op + 16 * dt) = pk;
            __builtin_amdgcn_sched_barrier(0); }
        if (q4 == 0) LSE[tq * 12 + g * 4 + hh] = mx + logf(sum);
        __syncthreads();
        if (un >= 1536) break;
        u = un;
    }
#undef ATT_LOAD
}

__device__ __forceinline__ SideItem side_decode(const Args& a, int l, int it, int lane) {
    SideItem s; s.src = nullptr; s.dst = nullptr; s.nsrc = 0; s.mode = 0;
    if (it >= IPL32) return s;
    unsigned char* wb = a.ws + WS_W + (size_t)l * WL_BYTES;
    const float* W; bf16_t* WT; int K, Nsrc, kb, nb, s0;
    int r = it;
    if (r < 38400) { kb = r / 600; nb = r % 600; const int n0 = nb * 32; s0 = n0 < 14848 ? n0 : (n0 < 18944 ? n0 + 64 : (n0 < 19008 ? 14848 + (n0 - 18944) : -1));
        W = a.in[7] + (size_t)l * 2048 * N_IN; Nsrc = N_IN; WT = (bf16_t*)(wb + WO_IN); K = 2048; }
    else if ((r -= 38400) < 1024) { kb = r >> 6; nb = r & 63; s0 = nb * 32; W = a.in[14] + (size_t)l * 512 * 2048; Nsrc = 2048; WT = (bf16_t*)(wb + WO_A); K = 512; }
    else if ((r -= 1024) < 8192) { kb = r >> 6; nb = r & 63; s0 = nb * 32; W = a.in[15] + (size_t)l * 4096 * 2048; Nsrc = 2048; WT = (bf16_t*)(wb + WO_S); K = 4096; }
    else if ((r -= 8192) < 4096) { kb = r >> 6; nb = r & 63; s0 = nb * 32; W = a.in[16] + (size_t)l * 2048 * 2048; Nsrc = 2048; WT = (bf16_t*)(wb + WO_O); K = 2048; }
    else if ((r -= 4096) < 22528) { kb = r / 352; nb = r % 352; const int n0 = nb * 32, t = n0 >> 8, j = n0 & 255; s0 = j < 128 ? 128 * t + j : D_FF + 128 * t + (j - 128);
        W = a.in[17] + (size_t)l * 2048 * 2 * D_FF; Nsrc = 2 * D_FF; WT = (bf16_t*)(wb + WO_FI); K = 2048; }
    else { r -= 22528; kb = r >> 6; nb = r & 63; s0 = nb * 32; W = a.in[18] + (size_t)l * D_FF * 2048; Nsrc = 2048; WT = (bf16_t*)(wb + WO_FO); K = D_FF; }
    const int n = lane & 31, kh = lane >> 5, k0 = kb * 32 + 16 * kh;
    s.dst = WT + (size_t)(nb * 32 + n) * K + k0; s.nsrc = Nsrc;
    if (s0 < 0) { s.mode = 2; } else { s.mode = 1; s.src = W + (size_t)k0 * Nsrc + s0 + n; }
    return s;
}
__device__ __forceinline__ void side_issue(const SideItem& s, float (&v)[16]) {
    if (s.mode == 1) {
#pragma unroll
        for (int j = 0; j < 16; ++j) v[j] = s.src[(size_t)j * s.nsrc]; }
}
__device__ __forceinline__ void side_drain(const SideItem& s, const float (&v)[16]) {
    if (s.mode == 0) return;
    u32x4 w0 = {0u, 0u, 0u, 0u}, w1 = {0u, 0u, 0u, 0u};
    if (s.mode == 1) { w0.x = cvt_pk_bf16(v[0], v[1]); w0.y = cvt_pk_bf16(v[2], v[3]); w0.z = cvt_pk_bf16(v[4], v[5]); w0.w = cvt_pk_bf16(v[6], v[7]);
        w1.x = cvt_pk_bf16(v[8], v[9]); w1.y = cvt_pk_bf16(v[10], v[11]); w1.z = cvt_pk_bf16(v[12], v[13]); w1.w = cvt_pk_bf16(v[14], v[15]); }
    *(u32x4*)s.dst = w0; *(u32x4*)(s.dst + 8) = w1;
}

__device__ __forceinline__ void phase_convbc(const bf16_t* P, bf16_t* HBC, const float* conv_w, const float* conv_b, int tid, int bx, int G) {
    const int chunk = tid & 255, rh = tid >> 8, col = 4096 + chunk * 8;
    float cw[4][8], cbias[8];
#pragma unroll
    for (int e = 0; e < 8; ++e) { cbias[e] = conv_b[col + e];
#pragma unroll
        for (int j = 0; j < 4; ++j) cw[j][e] = conv_w[j * 6144 + col + e]; }
    for (int it = bx; it < M_TOK / 32; it += G) {
        const int r0 = it * 32 + rh * 16; const bool halo = (r0 & (SEQ - 1)) != 0;
        const bf16_t* src = P + (size_t)r0 * NPROJ + COL_XBC + col;
        u32x4 raw[19];
#pragma unroll
        for (int i = 0; i < 19; ++i) { raw[i] = (u32x4){0u, 0u, 0u, 0u}; if (i >= 3 || halo) raw[i] = *(const u32x4*)(src + (ptrdiff_t)(i - 3) * NPROJ); }
#pragma unroll
        for (int rr = 0; rr < 16; ++rr) { float o[8];
#pragma unroll
            for (int e = 0; e < 8; ++e) o[e] = cbias[e];
#pragma unroll
            for (int j = 0; j < 4; ++j) { const u32x4 rv = raw[rr + j];
                o[0] += bflo(rv.x) * cw[j][0]; o[1] += bfhi(rv.x) * cw[j][1]; o[2] += bflo(rv.y) * cw[j][2]; o[3] += bfhi(rv.y) * cw[j][3];
                o[4] += bflo(rv.z) * cw[j][4]; o[5] += bfhi(rv.z) * cw[j][5]; o[6] += bflo(rv.w) * cw[j][6]; o[7] += bfhi(rv.w) * cw[j][7]; }
#pragma unroll
            for (int e = 0; e < 8; ++e) o[e] = siluf_(o[e]);
            u32x4 w; w.x = cvt_pk_bf16(o[0], o[1]); w.y = cvt_pk_bf16(o[2], o[3]); w.z = cvt_pk_bf16(o[4], o[5]); w.w = cvt_pk_bf16(o[6], o[7]);
            *(u32x4*)(HBC + (size_t)(r0 + rr) * 2048 + chunk * 8) = w; }
    }
}

template <int VAR, bool SIDE>
__device__ __forceinline__ void ssd_unit(bf16_t* P, const bf16_t* HBC, const float* DT, const float* conv_w, const float* conv_b, float dtb, float Aneg, float Dk,
                                         LAS unsigned char* lds, int b, int hd, int tid_, int lane_, int wave_, const Args& sa, int sgw, int sngw) {
    int tid = tid_; asm volatile("" : "+v"(tid)); const int lane = tid & 63, wave = __builtin_amdgcn_readfirstlane(tid >> 6);
    constexpr int XS = 144, BS = 272;
    LAS unsigned char* Xs = lds; LAS unsigned char* Xw = lds + 18432; LAS unsigned char* Bm = lds + 36864; LAS unsigned char* Cm = lds + 71680; LAS unsigned char* Hs = lds + 106496;
    LAS float* scal = (LAS float*)(lds + 123904);
    const int g = hd >> 3, l15 = lane & 15, q4 = lane >> 4;
    const int xch = tid & 7, xr0 = (tid >> 3) * 2;
    const int xcol = hd * 64 + xch * 8;
    const int bcch = tid & 31, bcrow = tid >> 5;
    const int bccol = bcch < 16 ? g * 128 + bcch * 8 : 1024 + g * 128 + (bcch - 16) * 8;
    LAS unsigned char* bcdst = (bcch < 16 ? Bm + bcch * 16 : Cm + (bcch - 16) * 16) + bcrow * BS;
    LAS float* cwt = (LAS float*)(lds + 126976);
    if (tid < 320) { const int j = tid >> 6, cc = tid & 63; cwt[tid] = j < 4 ? conv_w[j * 6144 + hd * 64 + cc] : conv_b[hd * 64 + cc]; }
    { u32x4 zq = {0u, 0u, 0u, 0u}; asm volatile("" : "+v"(zq));
      for (int i = tid; i < 17408 / 16; i += 512) *(LAS u32x4*)(Hs + i * 16) = zq; }
    f32x4 hacc[4];
#pragma unroll
    for (int pt = 0; pt < 4; ++pt) hacc[pt] = (f32x4){0.f, 0.f, 0.f, 0.f};
    u32x4 xraw[5], bcraw[8]; float dr0 = 0.f, dr1 = 0.f;
#define SSD_LOADS(c_) do { const int tok0_ = b * SEQ + (c_) * 128; \
        _Pragma("unroll") for (int i = 0; i < 5; ++i) { xraw[i] = (u32x4){0u, 0u, 0u, 0u}; \
            if (i >= 3 || (c_) > 0 || xr0 + i >= 3) xraw[i] = *(const u32x4*)(P + (size_t)(tok0_ + xr0 - 3 + i) * NPROJ + COL_XBC + xcol); } \
        if (wave == 0) { dr0 = DT[(size_t)(tok0_ + lane) * 64 + hd]; dr1 = DT[(size_t)(tok0_ + 64 + lane) * 64 + hd]; } } while (0)
#define SSD_LOADS_BC(c_) do { const int tok0_ = b * SEQ + (c_) * 128; \
        _Pragma("unroll") for (int i = 0; i < 8; ++i) bcraw[i] = *(const u32x4*)(HBC + (size_t)(tok0_ + bcrow + 16 * i) * 2048 + bccol); } while (0)
#define SSD_SCAN(par_) do { LAS float* dtv_ = scal + (par_) * 128; LAS float* acum_ = scal + 256 + (par_) * 128; LAS float* wl_ = scal + 512 + (par_) * 128; \
        const float x0 = dr0 + dtb, x1 = dr1 + dtb; \
        const float dt0 = x0 > 20.f ? x0 : log1pf(expf(x0)), dt1 = x1 > 20.f ? x1 : log1pf(expf(x1)); \
        const float s0 = wave_incl_scan(dt0 * Aneg, lane); const float tot0 = lane63(s0); \
        const float s1 = wave_incl_scan(dt1 * Aneg, lane) + tot0; const float tot = lane63(s1); \
        dtv_[lane] = dt0; dtv_[64 + lane] = dt1; acum_[lane] = s0 * 1.4426950408889634f; acum_[64 + lane] = s1 * 1.4426950408889634f;     \
        wl_[lane] = dt0 * __expf(tot - s0); wl_[64 + lane] = dt1 * __expf(tot - s1); } while (0)
    SideItem sd0; float sv0[16]; sd0.src = nullptr; sd0.dst = nullptr; sd0.nsrc = 0; sd0.mode = 0;
#pragma unroll
    for (int j = 0; j < 16; ++j) sv0[j] = 0.f;
    SSD_LOADS(0); SSD_LOADS_BC(0);
    if (wave == 0) SSD_SCAN(0);
    __syncthreads();
    for (int c = 0; c < 32; ++c) {
        const int par = c & 1;
        LAS float* dtv = scal + par * 128; LAS float* acum = scal + 256 + par * 128; LAS float* wl = scal + 512 + par * 128;
        const int tok0 = b * SEQ + c * 128;
        f32x4 o2[2][2];
        { const f32x4 ba = *(const LAS f32x4*)(cwt + 256 + xch * 8), bb = *(const LAS f32x4*)(cwt + 256 + xch * 8 + 4); o2[0][0] = ba; o2[0][1] = bb; o2[1][0] = ba; o2[1][1] = bb; }
#pragma unroll
        for (int j = 0; j < 4; ++j) { const f32x4 wa = *(const LAS f32x4*)(cwt + j * 64 + xch * 8), wb = *(const LAS f32x4*)(cwt + j * 64 + xch * 8 + 4);
#pragma unroll
            for (int rr = 0; rr < 2; ++rr) { const u32x4 rv = xraw[rr + j];
                o2[rr][0] += (f32x4){bflo(rv.x), bfhi(rv.x), bflo(rv.y), bfhi(rv.y)} * wa; o2[rr][1] += (f32x4){bflo(rv.z), bfhi(rv.z), bflo(rv.w), bfhi(rv.w)} * wb; } }
        { f32x4 t[2][2];
#pragma unroll
            for (int rr = 0; rr < 2; ++rr)
#pragma unroll
                for (int hq = 0; hq < 2; ++hq)
                    { const f32x4 ta = o2[rr][hq] * -1.4426950408889634f;
#pragma unroll
                      for (int e = 0; e < 4; ++e) t[rr][hq][e] = __builtin_amdgcn_exp2f(ta[e]); }
#pragma unroll
            for (int rr = 0; rr < 2; ++rr)
#pragma unroll
                for (int hq = 0; hq < 2; ++hq)
                    { const f32x4 tb = t[rr][hq] + 1.0f;
#pragma unroll
                      for (int e = 0; e < 4; ++e) t[rr][hq][e] = __builtin_amdgcn_rcpf(tb[e]); }
#pragma unroll
            for (int rr = 0; rr < 2; ++rr)
#pragma unroll
                for (int hq = 0; hq < 2; ++hq) o2[rr][hq] = o2[rr][hq] * t[rr][hq]; }
#pragma unroll
        for (int rr = 0; rr < 2; ++rr) { const f32x4 oa = o2[rr][0], ob = o2[rr][1];
            u32x4 w; w.x = cvt_pk_bf16(oa[0], oa[1]); w.y = cvt_pk_bf16(oa[2], oa[3]); w.z = cvt_pk_bf16(ob[0], ob[1]); w.w = cvt_pk_bf16(ob[2], ob[3]);
            *(LAS u32x4*)(Xs + (xr0 + rr) * XS + xch * 16) = w;
            const float f = wl[xr0 + rr]; const f32x4 pa = oa * f, pb = ob * f;
            w.x = cvt_pk_bf16(pa[0], pa[1]); w.y = cvt_pk_bf16(pa[2], pa[3]); w.z = cvt_pk_bf16(pb[0], pb[1]); w.w = cvt_pk_bf16(pb[2], pb[3]);
            *(LAS u32x4*)(Xw + (xr0 + rr) * XS + xch * 16) = w; }
#pragma unroll
        for (int i = 0; i < 8; ++i) *(LAS u32x4*)(bcdst + 16 * i * BS) = bcraw[i];
        if (SIDE) { side_drain(sd0, sv0); sd0.mode = 0; }
        __syncthreads();
        if (c + 1 < 32 && !(VAR & 2)) SSD_LOADS(c + 1);
        {
            const int lt = wave < 4 ? wave : 11 - wave;
            const int l = 16 * lt + l15; const float acl = acum[l];
            const size_t token = (size_t)(tok0 + l);
            bf16_t* zp = P + token * NPROJ + COL_Z + hd * 64 + 4 * q4;
            u32x2 zv[4];
#pragma unroll
            for (int pt = 0; pt < 4; ++pt) { zv[pt] = (u32x2){0x3f803f80u, 0x3f803f80u}; if (!(VAR & 1)) zv[pt] = *(const u32x2*)(zp + 16 * pt); }
            f32x4 Y[4];
#pragma unroll
            for (int pt = 0; pt < 4; ++pt) Y[pt] = (f32x4){0.f, 0.f, 0.f, 0.f};
            bf16x8 Cf[4];
            LAS unsigned char* cbase = Cm + l * BS + q4 * 16;
#pragma unroll
            for (int ks = 0; ks < 4; ++ks) Cf[ks] = *(const LAS bf16x8*)(cbase + ks * 64);
            LAS unsigned char* hbase = Hs + l15 * BS + q4 * 16;
#pragma unroll
            for (int pt = 0; pt < 4; ++pt)
#pragma unroll
                for (int ks = 0; ks < 4; ++ks) { const bf16x8 Hf = *(const LAS bf16x8*)(hbase + pt * 16 * BS + ks * 64); Y[pt] = mfma16(Hf, Cf[ks], Y[pt]); }
            const float eal = __builtin_amdgcn_exp2f(acl);
#pragma unroll
            for (int pt = 0; pt < 4; ++pt) Y[pt] *= eal;
            __builtin_amdgcn_sched_barrier(0);
            f32x4 Gt[8];
            f32x4 penv;
#pragma unroll
            for (int e = 0; e < 4; ++e) penv[e] = (4 * q4 + e <= l15) ? 0.f : 1e30f;
            LAS unsigned char* bbase = Bm + l15 * BS + q4 * 16;
#pragma unroll
            for (int st = 0; st < 8; ++st) { Gt[st] = (f32x4){0.f, 0.f, 0.f, 0.f};
                if (st <= lt) {
#pragma unroll
                    for (int ks = 0; ks < 4; ++ks) { const bf16x8 Bf = *(const LAS bf16x8*)(bbase + st * 16 * BS + ks * 64); Gt[st] = mfma16(Bf, Cf[ks], Gt[st]); }
                    const f32x4 as = *(const LAS f32x4*)(acum + 16 * st + 4 * q4), ds = *(const LAS f32x4*)(dtv + 16 * st + 4 * q4);
#pragma unroll
                    for (int e = 0; e < 1; ++e) { const float flagf = (st == lt) ? 1.0f : 0.0f;
                        const f32x4 dv = (acl - as) - penv * flagf;
                        f32x4 fv; fv[0] = __builtin_amdgcn_exp2f(dv[0]); fv[1] = __builtin_amdgcn_exp2f(dv[1]); fv[2] = __builtin_amdgcn_exp2f(dv[2]); fv[3] = __builtin_amdgcn_exp2f(dv[3]);
                        Gt[st] = Gt[st] * (fv * ds); }
                } }
            LAS unsigned char* xbase = Xs + (4 * q4 + (l15 >> 2)) * XS + (l15 & 3) * 8;
#pragma unroll
            for (int kk = 0; kk < 4; ++kk) {
                if (2 * kk <= lt) {
                    u32x4 w; w.x = cvt_pk_bf16(Gt[2 * kk][0], Gt[2 * kk][1]); w.y = cvt_pk_bf16(Gt[2 * kk][2], Gt[2 * kk][3]);
                    w.z = cvt_pk_bf16(Gt[2 * kk + 1][0], Gt[2 * kk + 1][1]); w.w = cvt_pk_bf16(Gt[2 * kk + 1][2], Gt[2 * kk + 1][3]);
                    const bf16x8 Pf = __builtin_bit_cast(bf16x8, w);
#pragma unroll
                    for (int pt = 0; pt < 4; ++pt) {
                        const s16x4 xlo = ldtr(xbase + (32 * kk) * XS + pt * 32);
                        const s16x4 xhi = ldtr(xbase + (32 * kk + 16) * XS + pt * 32);
                        Y[pt] = mfma16(cat8(xlo, xhi), Pf, Y[pt]); }
                } }
            __builtin_amdgcn_sched_barrier(0);
            if (c + 1 < 32 && !(VAR & 2)) SSD_LOADS_BC(c + 1);
            if (SIDE) { sd0 = side_decode(sa, 1, sgw + sngw * c, lane); side_issue(sd0, sv0); }
#pragma unroll
            for (int pt = 0; pt < 4; ++pt) { const int p0 = 16 * pt + 4 * q4;
                const u32x2 xv = *(const LAS u32x2*)(Xs + l * XS + p0 * 2);
                const f32x4 xf = {bflo(xv.x), bfhi(xv.x), bflo(xv.y), bfhi(xv.y)}, zf = {bflo(zv[pt].x), bfhi(zv[pt].x), bflo(zv[pt].y), bfhi(zv[pt].y)};
                const f32x4 yv = (Y[pt] + Dk * xf) * zf;
                u32x2 pk; pk.x = cvt_pk_bf16(yv[0], yv[1]); pk.y = cvt_pk_bf16(yv[2], yv[3]); if (!(VAR & 1)) *(u32x2*)(zp + 16 * pt) = pk; else asm volatile("" :: "v"(pk.x), "v"(pk.y)); }
            __builtin_amdgcn_sched_barrier(0);
            const float et = __builtin_amdgcn_exp2f(acum[127]);
#pragma unroll
            for (int pt = 0; pt < 4; ++pt) hacc[pt] *= et;
            LAS unsigned char* btbase = Bm + (4 * q4 + (l15 >> 2)) * BS + (16 * wave + 4 * (l15 & 3)) * 2;
            LAS unsigned char* xwbase = Xw + (4 * q4 + (l15 >> 2)) * XS + (l15 & 3) * 8;
#pragma unroll
            for (int kk = 0; kk < 4; ++kk) {
                const s16x4 blo = ldtr(btbase + (32 * kk) * BS);
                const s16x4 bhi = ldtr(btbase + (32 * kk + 16) * BS);
                const bf16x8 Bf = cat8(blo, bhi);
#pragma unroll
                for (int pt = 0; pt < 4; ++pt) {
                    const s16x4 xlo = ldtr(xwbase + (32 * kk) * XS + pt * 32);
                    const s16x4 xhi = ldtr(xwbase + (32 * kk + 16) * XS + pt * 32);
                    hacc[pt] = mfma16(Bf, cat8(xlo, xhi), hacc[pt]); }
            }
        }
        if (wave == 0 && c + 1 < 32) SSD_SCAN(par ^ 1);
        __syncthreads();
#pragma unroll
        for (int pt = 0; pt < 4; ++pt) { u32x2 pk; pk.x = cvt_pk_bf16(hacc[pt][0], hacc[pt][1]); pk.y = cvt_pk_bf16(hacc[pt][2], hacc[pt][3]);
            *(LAS u32x2*)(Hs + (16 * pt + l15) * BS + (16 * wave + 4 * q4) * 2) = pk; }
    }
#undef SSD_LOADS
#undef SSD_LOADS_BC
#undef SSD_SCAN
    if (SIDE) { side_drain(sd0, sv0); }
    __syncthreads();
}

__device__ __forceinline__ void phase_attn_merge(bf16_t* P, const float* LSE, int lane, int gw, int NGW) {
    const int hh = lane >> 4, dd = (lane & 15) * 8;
#pragma unroll 2
    for (int m = gw; m < M_TOK; m += NGW) {
        bf16_t* op = P + (size_t)m * NPROJ + hh * 128 + dd;
        const float l0 = LSE[(size_t)m * 12 + hh], l1 = LSE[(size_t)m * 12 + 4 + hh], l2 = LSE[(size_t)m * 12 + 8 + hh];
        const u32x4 o0 = *(const u32x4*)op, o1 = *(const u32x4*)(op + 512), o2 = *(const u32x4*)(op + 1024);
        const float mx = fmaxf(l0, fmaxf(l1, l2)); float w0 = __expf(l0 - mx), w1 = __expf(l1 - mx), w2 = __expf(l2 - mx);
        const float inv = 1.0f / (w0 + w1 + w2); w0 *= inv; w1 *= inv; w2 *= inv;
        u32x4 w;
        w.x = cvt_pk_bf16(w0 * bflo(o0.x) + w1 * bflo(o1.x) + w2 * bflo(o2.x), w0 * bfhi(o0.x) + w1 * bfhi(o1.x) + w2 * bfhi(o2.x));
        w.y = cvt_pk_bf16(w0 * bflo(o0.y) + w1 * bflo(o1.y) + w2 * bflo(o2.y), w0 * bfhi(o0.y) + w1 * bfhi(o1.y) + w2 * bfhi(o2.y));
        w.z = cvt_pk_bf16(w0 * bflo(o0.z) + w1 * bflo(o1.z) + w2 * bflo(o2.z), w0 * bfhi(o0.z) + w1 * bfhi(o1.z) + w2 * bfhi(o2.z));
        w.w = cvt_pk_bf16(w0 * bflo(o0.w) + w1 * bflo(o1.w) + w2 * bflo(o2.w), w0 * bfhi(o0.w) + w1 * bfhi(o1.w) + w2 * bfhi(o2.w));
        *(u32x4*)op = w;
    }
}
__device__ __forceinline__ void phase_merge(bf16_t* P, const float* LSE, const float* nw, int lane, int gw, int NGW) {
    f32x4 wa[8], wb[8];
#pragma unroll
    for (int gg = 0; gg < 8; ++gg) { wa[gg] = *(const f32x4*)(nw + gg * 512 + lane * 8); wb[gg] = *(const f32x4*)(nw + gg * 512 + lane * 8 + 4); }
    for (int m = gw; m < M_TOK; m += NGW) {
        bf16_t* rp = P + (size_t)m * NPROJ;
        u32x4 yv[8];
#pragma unroll
        for (int gg = 0; gg < 8; ++gg) yv[gg] = *(const u32x4*)(rp + COL_Z + gg * 512 + lane * 8);
        float ss[8];
#pragma unroll
        for (int gg = 0; gg < 8; ++gg) { const u32x4 v = yv[gg];
            ss[gg] = (bflo(v.x) * bflo(v.x) + bfhi(v.x) * bfhi(v.x)) + (bflo(v.y) * bflo(v.y) + bfhi(v.y) * bfhi(v.y)) + (bflo(v.z) * bflo(v.z) + bfhi(v.z) * bfhi(v.z)) + (bflo(v.w) * bflo(v.w) + bfhi(v.w) * bfhi(v.w)); }
#pragma unroll
        for (int gg = 0; gg < 8; ++gg) ss[gg] = wave_sum(ss[gg]);
#pragma unroll
        for (int gg = 0; gg < 8; ++gg) { const u32x4 v = yv[gg];
            const float rs = 1.0f / sqrtf(ss[gg] * (1.0f / 512.0f) + 1e-6f);
            u32x4 w; w.x = cvt_pk_bf16(bflo(v.x) * rs * wa[gg].x, bfhi(v.x) * rs * wa[gg].y); w.y = cvt_pk_bf16(bflo(v.y) * rs * wa[gg].z, bfhi(v.y) * rs * wa[gg].w);
            w.z = cvt_pk_bf16(bflo(v.z) * rs * wb[gg].x, bfhi(v.z) * rs * wb[gg].y); w.w = cvt_pk_bf16(bflo(v.w) * rs * wb[gg].z, bfhi(v.w) * rs * wb[gg].w);
            *(u32x4*)(rp + COL_Z + gg * 512 + lane * 8) = w; }
    }
}

#define GAS __attribute__((address_space(1)))
#define XB_TMO      128
#define XB_XCNT(j)  (256  + 64 * (j))
#define XB_XSUB(j)  (1280 + 64 * (j))
#define XB_XGEN(j)  (2304 + 64 * (j))
#define XB_TOP      3328
#define XB_TOPGEN   3392
#define XCD_BAR_WORDS 3456
#define XB_SPIN_CAP (1u << 18)

__device__ __forceinline__ unsigned xb_ld(unsigned* p)              { return __hip_atomic_load(p, __ATOMIC_RELAXED, __HIP_MEMORY_SCOPE_AGENT); }
__device__ __forceinline__ unsigned xb_add(unsigned* p, unsigned v) { return __hip_atomic_fetch_add(p, v, __ATOMIC_RELAXED, __HIP_MEMORY_SCOPE_AGENT); }
__device__ __forceinline__ unsigned xb_xcc_id() { return (unsigned)__builtin_amdgcn_s_getreg((3 << 11) | 20) & 0xFu; }
#define XB_SPIN(cond, bar) do { unsigned _sp = 0; while (cond) { __builtin_amdgcn_s_sleep(1); \
    if ((++_sp & 255u) == 0u) { if (xb_ld(&(bar)[XB_TMO])) break; if (_sp > XB_SPIN_CAP) { atomicAdd(&(bar)[XB_TMO], 1u); break; } } } } while (0)

struct XcdBarrier {
    unsigned* bar; unsigned x; int w0;
    volatile LAS unsigned* st;
};

__device__ __forceinline__ XcdBarrier xcd_barrier_post(unsigned* bar, volatile LAS unsigned* st, int tid0_, int wv_) {
    XcdBarrier b; b.bar = bar; b.x = xb_xcc_id(); b.st = st; b.w0 = wv_;
    if (tid0_ == 0) (void)xb_add(&bar[XB_XCNT(b.x)], 1u);
    return b;
}
__device__ __forceinline__ void xcd_barrier_complete(unsigned* bar, unsigned x, unsigned& nloc, unsigned& nx) {
    const unsigned G = gridDim.x * gridDim.y * gridDim.z;
    unsigned sum, cnt, mine, sp = 0u;
    for (;;) {
        sum = 0u; cnt = 0u; mine = 0u;
#pragma unroll
        for (unsigned j = 0; j < 16; ++j) { const unsigned c = xb_ld(&bar[XB_XCNT(j)]); sum += c; cnt += (c > 0u) ? 1u : 0u; mine = (j == x) ? c : mine; }
        if (sum == G) break;
        __builtin_amdgcn_s_sleep(1);
        if ((++sp & 255u) == 0u) { if (xb_ld(&bar[XB_TMO])) break; if (sp > XB_SPIN_CAP) { atomicAdd(&bar[XB_TMO], 1u); break; } }
    }
    nloc = mine > 0u ? mine : 1u; nx = cnt > 0u ? cnt : 1u;
}

__device__ __forceinline__ void xcd_barrier(const XcdBarrier& b) {
    asm volatile("s_waitcnt vmcnt(0)" ::: "memory");
    __syncthreads();
    if (b.w0 == 0 && pg8::lane_id_mbcnt() == 0) {
        unsigned* bar = b.bar; asm volatile("" : "+s"(bar));
        __builtin_amdgcn_s_waitcnt(0);
        unsigned nloc = b.st[0], nx = b.st[1];
        if (nloc == 0u) { xcd_barrier_complete(bar, b.x, nloc, nx); b.st[0] = nloc; b.st[1] = nx; }
        const unsigned old = xb_add(&bar[XB_XSUB(b.x)], 1u);
        const unsigned gen = old / nloc;
        if (old + 1u == (gen + 1u) * nloc) {
            __builtin_amdgcn_fence(__ATOMIC_RELEASE, "agent");
            asm volatile("s_waitcnt vmcnt(0)" ::: "memory");
            const unsigned og = xb_add(&bar[XB_TOP], 1u);
            const unsigned tg = og / nx;
            if (og + 1u == (tg + 1u) * nx) xb_add(&bar[XB_TOPGEN], 1u);
            else XB_SPIN(xb_ld(&bar[XB_TOPGEN]) == tg, bar);
            __builtin_amdgcn_fence(__ATOMIC_ACQUIRE, "agent");
            xb_add(&bar[XB_XGEN(b.x)], 1u);
            asm volatile("s_waitcnt vmcnt(0)" ::: "memory");
        } else {
            XB_SPIN(xb_ld(&bar[XB_XGEN(b.x)]) == gen, bar);
            __builtin_amdgcn_fence(__ATOMIC_ACQUIRE, "agent");
            asm volatile("s_waitcnt vmcnt(0)" ::: "memory");
        }
    }
    __syncthreads();
}

#ifndef PROBE_MODE
#define PROBE_MODE 0
#endif
#ifndef PROBE_VAR
#define PROBE_VAR 0
#endif
#ifndef MK_SINGLE
#define MK_SINGLE 1
#endif
__global__ void __launch_bounds__(512, 2) fwd_kernel(Args a) {
    extern __shared__ __attribute__((aligned(16))) unsigned char lds_raw[];
    LAS unsigned char* lds = (LAS unsigned char*)lds_raw;
    cg::grid_group grid = cg::this_grid();
    const int bx = blockIdx.x, G = gridDim.x, NGW = G * 8;
    const int tid0 = threadIdx.x;
    const int wv_s = __builtin_amdgcn_readfirstlane(tid0 >> 6);
    const int lo = a.ph_lo, hi = a.ph_hi;
    volatile LAS unsigned* MISC = (volatile LAS unsigned*)(lds + LDS_BYTES - 64);
    if (tid0 < 16) MISC[tid0] = 0u;
    __syncthreads();
    const XcdBarrier xbar = xcd_barrier_post((unsigned*)(a.ws + WS_CTL), MISC, tid0, wv_s);
#define PH_IDS int tid = wv_s * 64 + pg8::lane_id_mbcnt(); asm volatile("" : "+v"(tid)); const int lane = tid & 63, wave = __builtin_amdgcn_readfirstlane(tid >> 6), gw = bx * 8 + wave; (void)lane; (void)gw
    float* out = a.out;
#define PH_PTRS unsigned char* ws = a.ws; asm volatile("" : "+s"(ws)); float* MOD = (float*)(ws + WS_MOD); float* LSE = (float*)(ws + WS_LSE); float* DT = (float*)(ws + WS_DT); \
    bf16_t* H = (bf16_t*)(ws + WS_H); bf16_t* P = (bf16_t*)(ws + WS_PROJ); bf16_t* XB = (bf16_t*)(ws + WS_XB); (void)XB; const float* mod = MOD + (size_t)l * 4 * 12288; unsigned char* wb = ws + WS_W + (size_t)l * WL_BYTES; \
    (void)LSE; (void)DT; (void)H; (void)P; (void)mod; (void)wb
#define IN(k) (lo <= (k) && (k) < hi)
#define SEAM(k) do { if (IN(k) && IN((k) + 1)) xcd_barrier(xbar); } while (0)
    if (lo < -1000) grid.sync();
    const bool side = false;
    if (IN(0)) { PH_IDS; phase_prep(a, lds, tid, lane, wave, bx, G, side ? 1 : 2); }
    SEAM(0);
#if PROBE_MODE == 5
    if (IN(0) && IN(1)) { { PH_IDS; phase_prep(a, lds, tid, lane, wave, bx, G, 2); } xcd_barrier(xbar); }
#endif
#pragma unroll 1
    for (int l = 0; l < 2; ++l) {
        const int pb = 1 + 10 * l;
        if (IN(pb + 0)) { PH_PTRS; PH_IDS; if (l == 0) phase_norm<false>(a.in[0], a.in[3] + l * 2048, mod + 2048, mod, H, nullptr, lane, gw, NGW); else phase_norm_b<false>(XB, a.in[3] + l * 2048, mod + 2048, mod, H, nullptr, lane, gw, NGW); }
        SEAM(pb + 0);
        if (IN(pb + 1)) { PH_PTRS; pg8::Gemm g{H, (const bf16_t*)(wb + WO_IN), M_TOK, NPROJ, 2048, 2048}; pg8::StaticOrder S; S.init(M_TOK, NPROJ, G, bx);
            pg8::EpiProj E{P, DT}; pg8::gemm_phase<pg8::EpiProj, pg8::StaticOrder, true, true>(lds, g, S, E, wv_s); }
        SEAM(pb + 1);
        if (IN(pb + 2)) { PH_PTRS; PH_IDS;
            phase_attn(P, LSE, a.in[2], lds, bx, G, tid);
            phase_convbc(P, H, a.in[8] + (size_t)l * 4 * 6144, a.in[9] + (size_t)l * 6144, tid, bx, G);
        }
        SEAM(pb + 2);
        if (IN(pb + 3)) { PH_PTRS; PH_IDS;
            for (int u = bx; u < 256; u += G) {
                const int xcd = u & 7, slot = u >> 3, gb = xcd * 4 + (slot >> 3), b = gb >> 3, hd = (gb & 7) * 8 + (slot & 7);
                if (l == 0 && side) ssd_unit<0, true>(P, H, DT, a.in[8] + (size_t)l * 4 * 6144, a.in[9] + (size_t)l * 6144, a.in[10][l * 64 + hd], -expf(a.in[11][l * 64 + hd]), a.in[12][l * 64 + hd], lds, b, hd, tid, lane, wave, a, gw, NGW);
                else ssd_unit<0, false>(P, H, DT, a.in[8] + (size_t)l * 4 * 6144, a.in[9] + (size_t)l * 6144, a.in[10][l * 64 + hd], -expf(a.in[11][l * 64 + hd]), a.in[12][l * 64 + hd], lds, b, hd, tid, lane, wave, a, gw, NGW); }
            phase_attn_merge(P, LSE, lane, gw, NGW);
        }
        SEAM(pb + 3);
        if (IN(pb + 4)) { PH_PTRS; PH_IDS; phase_merge(P, LSE, a.in[13] + (size_t)l * 4096, lane, gw, NGW); }
        SEAM(pb + 4);
        if (IN(pb + 5)) { PH_PTRS;
            { pg8::Gemm g{P + COL_Q, (const bf16_t*)(wb + WO_A), M_TOK, 2048, 512, NPROJ}; pg8::StaticOrder S; S.init(M_TOK, 2048, G, bx);
              pg8::EpiGate<0> E{H, 2048, P + COL_GA, NPROJ}; pg8::gemm_phase<pg8::EpiGate<0>, pg8::StaticOrder, true, true>(lds, g, S, E, wv_s); }
            { pg8::Gemm g{P + COL_Z, (const bf16_t*)(wb + WO_S), M_TOK, 2048, 4096, NPROJ}; pg8::StaticOrder S; S.init(M_TOK, 2048, G, bx);
              pg8::EpiGate<1> E{H, 2048, P + COL_GS, NPROJ}; pg8::gemm_phase<pg8::EpiGate<1>, pg8::StaticOrder, true, true>(lds, g, S, E, wv_s); }
        }
        SEAM(pb + 5);
#if PROBE_MODE > 0
        if (IN(pb + 5) && IN(pb + 6)) { PH_IDS;
#if PROBE_MODE == 1
            phase_attn(P, LSE, a.in[2], lds, bx, G, tid);
#elif PROBE_MODE == 2
            for (int u = bx; u < 256; u += G) {
                const int xcd = u & 7, slot = u >> 3, gb = xcd * 4 + (slot >> 3), b = gb >> 3, hd = (gb & 7) * 8 + (slot & 7);
                ssd_unit<PROBE_VAR, false>(P, H, DT, a.in[8] + (size_t)l * 4 * 6144, a.in[9] + (size_t)l * 6144, a.in[10][l * 64 + hd], -expf(a.in[11][l * 64 + hd]), a.in[12][l * 64 + hd], lds, b, hd, tid, lane, wave, a, gw, NGW); }
#elif PROBE_MODE == 3
            phase_merge(P, LSE, a.in[13] + (size_t)l * 4096, lane, gw, NGW);
#elif PROBE_MODE == 4
            phase_convbc(P, P + (size_t)200000000, a.in[8] + (size_t)l * 4 * 6144, a.in[9] + (size_t)l * 6144, tid, bx, G);
#endif
            grid.sync(); }
#endif
        if (IN(pb + 6)) { PH_PTRS; pg8::Gemm g{H, (const bf16_t*)(wb + WO_O), M_TOK, 2048, 2048, 2048}; pg8::StaticOrder S; S.init(M_TOK, 2048, G, bx);
            pg8::EpiRes2 E{l == 0 ? a.in[0] : nullptr, XB, XB, mod + 4096, 12288}; pg8::gemm_phase<pg8::EpiRes2, pg8::StaticOrder, true, true>(lds, g, S, E, wv_s); }
        SEAM(pb + 6);
        if (IN(pb + 7)) { PH_PTRS; PH_IDS; phase_norm_b<false>(XB, a.in[4] + l * 2048, mod + 8192, mod + 6144, H, nullptr, lane, gw, NGW); }
        SEAM(pb + 7);
        if (IN(pb + 8)) { PH_PTRS; pg8::Gemm g{H, (const bf16_t*)(wb + WO_FI), M_TOK, 2 * D_FF, 2048, 2048}; pg8::StaticOrder S; S.init(M_TOK, 2 * D_FF, G, bx);
            pg8::EpiSwiglu E{P, D_FF}; pg8::gemm_phase<pg8::EpiSwiglu, pg8::StaticOrder, true, true>(lds, g, S, E, wv_s); }
        SEAM(pb + 8);
        if (IN(pb + 9)) { PH_PTRS; pg8::Gemm g{P, (const bf16_t*)(wb + WO_FO), M_TOK, 2048, D_FF, D_FF}; pg8::StaticOrder S; S.init(M_TOK, 2048, G, bx);
            pg8::EpiRes2 E{nullptr, XB, XB, mod + 10240, 12288}; pg8::gemm_phase<pg8::EpiRes2, pg8::StaticOrder, true, true>(lds, g, S, E, wv_s); }
        SEAM(pb + 9);
    }
#if PROBE_MODE == 7
    if (IN(20) && IN(21)) { for (int i = 0; i < 20; ++i) grid.sync(); }
#endif
    if (IN(21)) { PH_IDS; const bf16_t* XBf = (const bf16_t*)(a.ws + WS_XB); phase_norm_b<true>(XBf, a.in[19], nullptr, nullptr, nullptr, out, lane, gw, NGW); }
#undef IN
#undef SEAM
}

extern "C" void kernel_launch(void* const* d_in, const int* in_sizes, int n_in, void* d_out, int out_size, void* d_ws, size_t ws_size, hipStream_t stream) {
    static int grid = 0;
    if (grid == 0) {
        if (n_in != 20 || out_size != M_TOK * D_MODEL || ws_size < WS_END + MiB) { fprintf(stderr, "kernel_launch: unexpected shapes (n_in %d out %d ws %zu need %zu)\n", n_in, out_size, ws_size, (size_t)WS_END); grid = -1; return; }
        int dev = 0, cus = 0, per_cu = 0;
        (void)hipGetDevice(&dev); (void)hipDeviceGetAttribute(&cus, hipDeviceAttributeMultiprocessorCount, dev);
        if (hipFuncSetAttribute((const void*)fwd_kernel, hipFuncAttributeMaxDynamicSharedMemorySize, LDS_BYTES) != hipSuccess) { fprintf(stderr, "kernel_launch: hipFuncSetAttribute failed\n"); grid = -1; return; }
        if (hipOccupancyMaxActiveBlocksPerMultiprocessor(&per_cu, (const void*)fwd_kernel, 512, LDS_BYTES) != hipSuccess || per_cu < 1) { fprintf(stderr, "kernel_launch: occupancy query gave %d\n", per_cu); per_cu = 1; }
        (void)hipGetLastError();
        grid = cus * 1;
        if (grid <= 0) grid = 256;
    }
    if (grid < 0) return;
    (void)hipMemsetAsync((char*)d_ws + WS_CTL, 0, 16384, stream);
    Args a{};
    for (int i = 0; i < 20; ++i) a.in[i] = (const float*)d_in[i];
    a.out = (float*)d_out; a.ws = (unsigned char*)d_ws;
    void* args[] = {&a};
#if MK_SINGLE
    a.ph_lo = 0; a.ph_hi = NPHASE;
    hipError_t e = hipLaunchCooperativeKernel((const void*)fwd_kernel, dim3(grid), dim3(512), args, LDS_BYTES, stream);
    if (e != hipSuccess) fprintf(stderr, "cooperative launch failed: %s (grid %d)\n", hipGetErrorString(e), grid);
#else
    for (int ph = 0; ph < NPHASE; ++ph) { a.ph_lo = ph; a.ph_hi = ph + 1;
        hipError_t e = hipLaunchCooperativeKernel((const void*)fwd_kernel, dim3(grid), dim3(512), args, LDS_BYTES, stream);
        if (e != hipSuccess) { fprintf(stderr, "cooperative launch %d failed: %s (grid %d)\n", ph, hipGetErrorString(e), grid); break; } }
#endif
}
```

```cpp
#include <hip/hip_runtime.h>
#include <hip/hip_cooperative_groups.h>
#include <cstdio>
#include <cstdint>
#include <cmath>
namespace cg = cooperative_groups;
namespace pg8 {
#define PG8_LAS __attribute__((address_space(3)))
typedef unsigned short bf16_t;
typedef short bf16x8 __attribute__((ext_vector_type(8)));
typedef float f32x4 __attribute__((ext_vector_type(4)));
typedef unsigned u32x4 __attribute__((ext_vector_type(4)));
__device__ __forceinline__ int lane_id_mbcnt() { int l; asm volatile("v_mbcnt_lo_u32_b32 %0, -1, 0\n\tv_mbcnt_hi_u32_b32 %0, -1, %0" : "=v"(l)); return l; }
constexpr int BM = 256, BK = 64, HALF = 128, HTB = HALF * BK * 2  , STAGE_BYTES = 8 * HTB, NXCD = 8, WGM = 8;

__host__ __device__ __forceinline__ int lds_byte(int r, int c) { const int st = (r >> 4) * 2 + (c >> 5), rr = r & 15, cc = c & 31, ob = rr * 64 + cc * 2; return st * 1024 + (ob ^ (((ob >> 9) & 1) << 5)); }
__host__ __device__ __forceinline__ void stage_rc(int b, int& R, int& C) { const int st = b / 1024, sb = b % 1024, swz = sb ^ (((sb >> 9) & 1) << 5); R = (st >> 1) * 16 + swz / 64; C = (st & 1) * 32 + (swz % 64) / 2; }
__host__ __device__ __forceinline__ int perm32(int rho) { const int n = rho >> 4, i = rho & 15; return 8 * (i >> 2) + 4 * n + (i & 3); }

struct Unit { int pm, pn; };
struct Gemm { const bf16_t* A; const bf16_t* Bt; int M, N, K, lda; };

struct StaticOrder {
    int nM, nN, nwg, G, c;
    __host__ __device__ void init(int M, int N, int G_, int c_) { nM = M / BM; nN = N / BM; nwg = nM * nN; G = G_; c = c_; }
    __host__ __device__ bool next(int i, Unit& u) const {
        const long L = (long)i * G + c; if (L >= nwg) return false;
        int wgid = (int)L; { const int q = nwg / NXCD, r = nwg % NXCD, xcd = wgid % NXCD, off = wgid / NXCD; wgid = (xcd < r ? xcd * (q + 1) : r * (q + 1) + (xcd - r) * q) + off; }
        const int nig = WGM * nN, gid = wgid / nig, fm = gid * WGM, gsz = (nM - fm) < WGM ? (nM - fm) : WGM;
        u.pm = fm + ((wgid % nig) % gsz); u.pn = (wgid % nig) / gsz; return true;
    }
    __device__ __forceinline__ void a_ready(const Unit&) const {}
    __device__ __forceinline__ void done(const Unit&) const {}
};

__device__ __forceinline__ unsigned cvt_pk_bf16(float lo, float hi) { unsigned r; asm volatile("v_cvt_pk_bf16_f32 %0, %1, %2" : "=v"(r) : "v"(lo), "v"(hi)); return r; }
__device__ __forceinline__ float bflo(unsigned u) { return __uint_as_float(u << 16); }
__device__ __forceinline__ float bfhi(unsigned u) { return __uint_as_float(u & 0xffff0000u); }
__device__ __forceinline__ float sigmoidf_(float x) { return __builtin_amdgcn_rcpf(1.f + __expf(-x)); }
__device__ __forceinline__ float siluf_(float x) { return x * __builtin_amdgcn_rcpf(1.f + __expf(-x)); }

constexpr int NPROJ = 19200;
struct EpiProj {
    static constexpr bool PERM = true, AFTER_DRAIN = false;
    bf16_t* O; float* DT;
    __device__ __forceinline__ void operator()(const f32x4 (&acc)[2][2][4][2], const Unit& u, int wr, int wc, int fr, int fq) const {
        const int row0 = u.pm * BM + wr * 64 + fr;
        if (u.pn == 74) {
            if (wc < 2) {
#pragma unroll
                for (int ai = 0; ai < 2; ++ai)
#pragma unroll
                    for (int m = 0; m < 4; ++m) { float* p = DT + (size_t)(row0 + ai * HALF + m * 16) * 64 + wc * 32 + 8 * fq;
                        *(f32x4*)p = acc[ai][0][m][0]; *(f32x4*)(p + 4) = acc[ai][0][m][1]; }
            }
            return;
        }
        const bool sg = u.pn >= 58, zs = u.pn >= 18 && u.pn < 34;
        const int col0 = u.pn * BM + wc * 32 + 8 * fq;
#pragma unroll
        for (int ai = 0; ai < 2; ++ai)
#pragma unroll
            for (int m = 0; m < 4; ++m) { bf16_t* rowp = O + (size_t)(row0 + ai * HALF + m * 16) * NPROJ + col0;
#pragma unroll
                for (int bj = 0; bj < 2; ++bj) { f32x4 v0 = acc[ai][bj][m][0], v1 = acc[ai][bj][m][1];
                    if (sg || zs) { f32x4 t0, t1;
#pragma unroll
                        for (int j = 0; j < 4; ++j) { t0[j] = __expf(-v0[j]); t1[j] = __expf(-v1[j]); }
#pragma unroll
                        for (int j = 0; j < 4; ++j) { t0[j] = __builtin_amdgcn_rcpf(1.f + t0[j]); t1[j] = __builtin_amdgcn_rcpf(1.f + t1[j]); }
                        if (sg) { v0 = t0; v1 = t1; } else { v0 = v0 * t0; v1 = v1 * t1; } }
                    u32x4 w; w.x = cvt_pk_bf16(v0[0], v0[1]); w.y = cvt_pk_bf16(v0[2], v0[3]); w.z = cvt_pk_bf16(v1[0], v1[1]); w.w = cvt_pk_bf16(v1[2], v1[3]);
                    *(u32x4*)(rowp + bj * HALF) = w; } }
    }
};
template <int MODE> struct EpiGate {
    static constexpr bool PERM = true, AFTER_DRAIN = false;
    bf16_t* O; int ldc; const bf16_t* G; int ldg;
    __device__ __forceinline__ void operator()(const f32x4 (&acc)[2][2][4][2], const Unit& u, int wr, int wc, int fr, int fq) const {
        const int row0 = u.pm * BM + wr * 64 + fr; const int col0 = u.pn * BM + wc * 32 + 8 * fq;
#pragma unroll
        for (int ai = 0; ai < 2; ++ai)
#pragma unroll
            for (int m = 0; m < 4; ++m) { const size_t row = (size_t)(row0 + ai * HALF + m * 16);
#pragma unroll
                for (int bj = 0; bj < 2; ++bj) { const int col = col0 + bj * HALF;
                    const u32x4 gv = *(const u32x4*)(G + row * ldg + col);
                    f32x4 v0 = acc[ai][bj][m][0], v1 = acc[ai][bj][m][1];
                    v0[0] *= bflo(gv.x); v0[1] *= bfhi(gv.x); v0[2] *= bflo(gv.y); v0[3] *= bfhi(gv.y);
                    v1[0] *= bflo(gv.z); v1[1] *= bfhi(gv.z); v1[2] *= bflo(gv.w); v1[3] *= bfhi(gv.w);
                    bf16_t* op = O + row * ldc + col;
                    if (MODE == 1) { const u32x4 ov = *(const u32x4*)op;
                        v0[0] += bflo(ov.x); v0[1] += bfhi(ov.x); v0[2] += bflo(ov.y); v0[3] += bfhi(ov.y);
                        v1[0] += bflo(ov.z); v1[1] += bfhi(ov.z); v1[2] += bflo(ov.w); v1[3] += bfhi(ov.w); }
                    u32x4 w; w.x = cvt_pk_bf16(v0[0], v0[1]); w.y = cvt_pk_bf16(v0[2], v0[3]); w.z = cvt_pk_bf16(v1[0], v1[1]); w.w = cvt_pk_bf16(v1[2], v1[3]);
                    *(u32x4*)op = w; } }
    }
};
struct EpiRes {
    static constexpr bool PERM = false, AFTER_DRAIN = false;
    const float* xin; float* out; const float* gate; int gstride;
    __device__ __forceinline__ void operator()(const f32x4 (&acc)[2][2][4][2], const Unit& u, int wr, int wc, int fr, int fq) const {
        const int row0 = u.pm * BM + wr * 64 + fr; const int col0 = u.pn * BM + wc * 32 + 4 * fq;
        const float* gp = gate + (size_t)(u.pm >> 4) * gstride + col0;
        f32x4 gv[2][2];
#pragma unroll
        for (int bj = 0; bj < 2; ++bj)
#pragma unroll
            for (int n = 0; n < 2; ++n) gv[bj][n] = *(const f32x4*)(gp + bj * HALF + n * 16);
#pragma unroll
        for (int ai = 0; ai < 2; ++ai)
#pragma unroll
            for (int m = 0; m < 4; ++m) { const size_t off = (size_t)(row0 + ai * HALF + m * 16) * 2048 + col0;
#pragma unroll
                for (int bj = 0; bj < 2; ++bj)
#pragma unroll
                    for (int n = 0; n < 2; ++n) { const f32x4 xv = *(const f32x4*)(xin + off + bj * HALF + n * 16);
                        *(f32x4*)(out + off + bj * HALF + n * 16) = xv + gv[bj][n] * acc[ai][bj][m][n]; } }
    }
};
struct EpiRes2 {
    static constexpr bool PERM = true, AFTER_DRAIN = false;
    const float* xin_f; const bf16_t* xin_b; bf16_t* out; const float* gate; int gstride;
    __device__ __forceinline__ void operator()(const f32x4 (&acc)[2][2][4][2], const Unit& u, int wr, int wc, int fr, int fq) const {
        const int row0 = u.pm * BM + wr * 64 + fr; const int col0 = u.pn * BM + wc * 32 + 8 * fq;
        const float* gp = gate + (size_t)(u.pm >> 4) * gstride + col0;
        f32x4 g0[2], g1[2];
#pragma unroll
        for (int bj = 0; bj < 2; ++bj) { g0[bj] = *(const f32x4*)(gp + bj * HALF); g1[bj] = *(const f32x4*)(gp + bj * HALF + 4); }
#pragma unroll
        for (int ai = 0; ai < 2; ++ai)
#pragma unroll
            for (int m = 0; m < 4; ++m) { const size_t off = (size_t)(row0 + ai * HALF + m * 16) * 2048 + col0;
#pragma unroll
                for (int bj = 0; bj < 2; ++bj) { f32x4 x0, x1;
                    if (xin_f) { x0 = *(const f32x4*)(xin_f + off + bj * HALF); x1 = *(const f32x4*)(xin_f + off + bj * HALF + 4); }
                    else { const u32x4 xv = *(const u32x4*)(xin_b + off + bj * HALF);
                        x0 = (f32x4){bflo(xv.x), bfhi(xv.x), bflo(xv.y), bfhi(xv.y)}; x1 = (f32x4){bflo(xv.z), bfhi(xv.z), bflo(xv.w), bfhi(xv.w)}; }
                    const f32x4 v0 = x0 + g0[bj] * acc[ai][bj][m][0], v1 = x1 + g1[bj] * acc[ai][bj][m][1];
                    u32x4 w; w.x = cvt_pk_bf16(v0[0], v0[1]); w.y = cvt_pk_bf16(v0[2], v0[3]); w.z = cvt_pk_bf16(v1[0], v1[1]); w.w = cvt_pk_bf16(v1[2], v1[3]);
                    *(u32x4*)(out + off + bj * HALF) = w; } }
    }
};
struct EpiSwiglu {
    static constexpr bool PERM = true, AFTER_DRAIN = false;
    bf16_t* O; int ldc;
    __device__ __forceinline__ void operator()(const f32x4 (&acc)[2][2][4][2], const Unit& u, int wr, int wc, int fr, int fq) const {
        const int row0 = u.pm * BM + wr * 64 + fr; const int col0 = u.pn * HALF + wc * 32 + 8 * fq;
#pragma unroll
        for (int ai = 0; ai < 2; ++ai)
#pragma unroll
            for (int m = 0; m < 4; ++m) { bf16_t* op = O + (size_t)(row0 + ai * HALF + m * 16) * ldc + col0;
                f32x4 v0, v1;
#pragma unroll
                for (int j = 0; j < 4; ++j) { v0[j] = siluf_(acc[ai][0][m][0][j]) * acc[ai][1][m][0][j]; v1[j] = siluf_(acc[ai][0][m][1][j]) * acc[ai][1][m][1][j]; }
                u32x4 w; w.x = cvt_pk_bf16(v0[0], v0[1]); w.y = cvt_pk_bf16(v0[2], v0[3]); w.z = cvt_pk_bf16(v1[0], v1[1]); w.w = cvt_pk_bf16(v1[2], v1[3]);
                *(u32x4*)op = w; }
    }
};

template <class Epi, class Sched, bool ALIGN_EPI = false, bool SP2 = false>
__device__ __forceinline__ void gemm_phase(PG8_LAS unsigned char* lds, const Gemm g, const Sched& S, const Epi& E, int wave_s) {
    int tid = wave_s * 64 + lane_id_mbcnt(); asm volatile("" : "+v"(tid));        const int wid = __builtin_amdgcn_readfirstlane(tid >> 6), lane = tid & 63, wr = wid >> 2, wc = wid & 3, fr = lane & 15, fq = lane >> 4;
    const int K = g.K, nt = K / BK;
    unsigned voffA[2], voffB[2];
#pragma unroll
    for (int i = 0; i < 2; ++i) { int R, C; stage_rc(tid * 16 + i * 8192, R, C); const int Rb = Epi::PERM ? ((R & ~31) + perm32(R & 31)) : R;
        voffA[i] = (unsigned)(R * g.lda + C) * 2u; voffB[i] = (unsigned)(Rb * K + C) * 2u; }
    const size_t kstep = (size_t)(BK * 2);
    const size_t hstepA = (size_t)HALF * g.lda * 2, hstepB = (size_t)HALF * K * 2;
    const size_t tstepA = 2 * hstepA, tstepB = 2 * hstepB;
    const unsigned ldsw = (unsigned)wid * 1024u;
    const int aoff = lds_byte(wr * 64 + fr, fq * 8), boff = lds_byte(wc * 32 + fr, fq * 8);
#define PG8_SA(b, h) (((b) * 2 + (h)) * HTB)
#define PG8_SB(b, h) ((4 + (b) * 2 + (h)) * HTB)
#define PG8_STAGE(bufoff, gbase, voff) do { _Pragma("unroll") for (int _i = 0; _i < 2; ++_i) \
        __builtin_amdgcn_global_load_lds((const unsigned*)((const char*)(gbase) + (voff)[_i]), (PG8_LAS unsigned*)(lds + (bufoff) + ldsw + _i * 8192), 16, 0, 0); } while (0)
#define PG8_LDA(dst, b, h) do { _Pragma("unroll") for (int m = 0; m < 4; ++m) _Pragma("unroll") for (int k = 0; k < 2; ++k) dst[m][k] = *(const PG8_LAS bf16x8*)(lds + PG8_SA(b, h) + aoff + m * 2048 + k * 1024); } while (0)
#define PG8_LDB(dst, b, h) do { _Pragma("unroll") for (int n = 0; n < 2; ++n) _Pragma("unroll") for (int k = 0; k < 2; ++k) dst[n][k] = *(const PG8_LAS bf16x8*)(lds + PG8_SB(b, h) + boff + n * 2048 + k * 1024); } while (0)
#define PG8_MMA(ai, bj, At, Bt) do { __builtin_amdgcn_s_setprio(1); _Pragma("unroll") for (int m = 0; m < 4; ++m) _Pragma("unroll") for (int n = 0; n < 2; ++n) _Pragma("unroll") for (int k = 0; k < 2; ++k) \
        acc[ai][bj][m][n] = __builtin_amdgcn_mfma_f32_16x16x32_bf16(Bt[n][k], At[m][k], acc[ai][bj][m][n], 0, 0, 0); __builtin_amdgcn_s_setprio(0); } while (0)
#define PG8_WAIT_V(n) asm volatile("s_waitcnt vmcnt(" #n ")" ::: "memory")
#define PG8_WAIT_L(n) asm volatile("s_waitcnt lgkmcnt(" #n ")" ::: "memory")
#define PG8_BAR __builtin_amdgcn_s_barrier()
#define PG8_SCHED __builtin_amdgcn_sched_barrier(0)
    Unit cur, nxt; int ui = 0;
    if (!S.next(0, cur)) return;
    f32x4 acc[2][2][4][2];
#pragma unroll
    for (int a = 0; a < 2; ++a)
#pragma unroll
        for (int b = 0; b < 2; ++b)
#pragma unroll
            for (int m = 0; m < 4; ++m)
#pragma unroll
                for (int n = 0; n < 2; ++n) acc[a][b][m][n] = (f32x4){0.f, 0.f, 0.f, 0.f};
    bf16x8 At[4][2], B0[2][2], B1[2][2];
    const char* cA = (const char*)g.A + (size_t)cur.pm * tstepA; const char* cB = (const char*)g.Bt + (size_t)cur.pn * tstepB;
    S.a_ready(cur);
    if constexpr (SP2) {
        PG8_STAGE(PG8_SB(0, 0), cB, voffB); PG8_STAGE(PG8_SB(0, 1), cB + hstepB, voffB); PG8_STAGE(PG8_SA(0, 0), cA, voffA); PG8_STAGE(PG8_SA(0, 1), cA + hstepA, voffA);
        if (wr == 1) PG8_BAR;
        PG8_WAIT_V(2); PG8_BAR;
        PG8_STAGE(PG8_SB(1, 0), cB + kstep, voffB); PG8_STAGE(PG8_SA(1, 0), cA + kstep, voffA); PG8_STAGE(PG8_SB(1, 1), cB + hstepB + kstep, voffB);
        PG8_WAIT_V(6); PG8_BAR;
    } else {
        PG8_STAGE(PG8_SB(0, 0), cB, voffB); PG8_STAGE(PG8_SA(0, 0), cA, voffA); PG8_STAGE(PG8_SB(0, 1), cB + hstepB, voffB); PG8_STAGE(PG8_SA(0, 1), cA + hstepA, voffA);
        if (wr == 1) PG8_BAR;
        PG8_WAIT_V(4); PG8_BAR;
        PG8_STAGE(PG8_SB(1, 0), cB + kstep, voffB); PG8_STAGE(PG8_SA(1, 0), cA + kstep, voffA); PG8_STAGE(PG8_SB(1, 1), cB + hstepB + kstep, voffB);
        PG8_WAIT_V(6); PG8_BAR;
    }
    for (;;) {
        const bool has_next = S.next(ui + 1, nxt);
        const char* nA = has_next ? (const char*)g.A + (size_t)nxt.pm * tstepA : cA; const char* nB = has_next ? (const char*)g.Bt + (size_t)nxt.pn * tstepB : cB;
        for (int t = 0; t < nt; t += 2) {
            const bool last = (t == nt - 2);
            const char* a1 = cA + (size_t)(t + 1) * kstep;
            const char* a2 = last ? nA : cA + (size_t)(t + 2) * kstep; const char* b2 = last ? nB : cB + (size_t)(t + 2) * kstep;
            const char* a3 = a2 + kstep; const char* b3 = b2 + kstep;
            if (last && has_next) S.a_ready(nxt);
            if constexpr (SP2) {
            PG8_LDB(B0, 0, 0); PG8_LDB(B1, 0, 1); PG8_SCHED; PG8_LDA(At, 0, 0); PG8_STAGE(PG8_SA(1, 1), a1 + hstepA, voffA);
            PG8_WAIT_V(8); PG8_WAIT_L(0); PG8_BAR; PG8_MMA(0, 0, At, B0); PG8_MMA(0, 1, At, B1); PG8_BAR; PG8_SCHED;
            PG8_LDA(At, 0, 1); PG8_STAGE(PG8_SB(0, 0), b2, voffB); PG8_STAGE(PG8_SB(0, 1), b2 + hstepB, voffB); PG8_STAGE(PG8_SA(0, 0), a2, voffA);
            PG8_WAIT_V(8); PG8_WAIT_L(0); PG8_BAR; PG8_MMA(1, 0, At, B0); PG8_MMA(1, 1, At, B1); PG8_BAR; PG8_SCHED;
            PG8_LDB(B0, 1, 0); PG8_LDB(B1, 1, 1); PG8_SCHED; PG8_LDA(At, 1, 0); PG8_STAGE(PG8_SA(0, 1), a2 + hstepA, voffA);
            PG8_WAIT_V(8); PG8_WAIT_L(0); PG8_BAR; PG8_MMA(0, 0, At, B0); PG8_MMA(0, 1, At, B1); PG8_BAR; PG8_SCHED;
            PG8_LDA(At, 1, 1); PG8_STAGE(PG8_SB(1, 0), b3, voffB); PG8_STAGE(PG8_SB(1, 1), b3 + hstepB, voffB); PG8_STAGE(PG8_SA(1, 0), a3, voffA);
            PG8_WAIT_V(8); PG8_WAIT_L(0); PG8_BAR; PG8_MMA(1, 0, At, B0); PG8_MMA(1, 1, At, B1); PG8_BAR; PG8_SCHED;
            } else {
            PG8_LDB(B0, 0, 0); PG8_SCHED; PG8_LDA(At, 0, 0); PG8_STAGE(PG8_SA(1, 1), a1 + hstepA, voffA);
            PG8_WAIT_L(8); PG8_BAR; PG8_WAIT_L(0); PG8_MMA(0, 0, At, B0); PG8_BAR; PG8_SCHED;
            PG8_LDB(B1, 0, 1); PG8_STAGE(PG8_SB(0, 0), b2, voffB);
            PG8_BAR; PG8_WAIT_L(0); PG8_MMA(0, 1, At, B1); PG8_BAR;
            PG8_LDA(At, 0, 1); PG8_STAGE(PG8_SA(0, 0), a2, voffA);
            PG8_BAR; PG8_WAIT_L(0); PG8_MMA(1, 0, At, B0); PG8_BAR; PG8_SCHED;
            PG8_STAGE(PG8_SB(0, 1), b2 + hstepB, voffB);
            PG8_WAIT_V(6); PG8_BAR; PG8_MMA(1, 1, At, B1); PG8_BAR;
            PG8_LDB(B0, 1, 0); PG8_SCHED; PG8_LDA(At, 1, 0); PG8_STAGE(PG8_SA(0, 1), a2 + hstepA, voffA);
            PG8_WAIT_L(8); PG8_BAR; PG8_WAIT_L(0); PG8_MMA(0, 0, At, B0); PG8_BAR; PG8_SCHED;
            PG8_LDB(B1, 1, 1); PG8_STAGE(PG8_SB(1, 0), b3, voffB);
            PG8_BAR; PG8_WAIT_L(0); PG8_MMA(0, 1, At, B1); PG8_BAR;
            PG8_LDA(At, 1, 1); PG8_STAGE(PG8_SA(1, 0), a3, voffA);
            PG8_BAR; PG8_WAIT_L(0); PG8_MMA(1, 0, At, B0); PG8_BAR; PG8_SCHED;
            PG8_STAGE(PG8_SB(1, 1), b3 + hstepB, voffB);
            PG8_WAIT_V(6); PG8_BAR; PG8_MMA(1, 1, At, B1); PG8_BAR;
            }
        }
        if constexpr (ALIGN_EPI) { if (wr == 0) PG8_BAR; }
        if constexpr (!Epi::AFTER_DRAIN) { E(acc, cur, wr, wc, fr, fq); S.done(cur); }
        if (!has_next) break;
#pragma unroll
        for (int a = 0; a < 2; ++a)
#pragma unroll
            for (int b = 0; b < 2; ++b)
#pragma unroll
                for (int m = 0; m < 4; ++m)
#pragma unroll
                    for (int n = 0; n < 2; ++n) acc[a][b][m][n] = (f32x4){0.f, 0.f, 0.f, 0.f};
        cur = nxt; cA = nA; cB = nB; ++ui;
        if constexpr (ALIGN_EPI) { if (wr == 1) PG8_BAR; }
    }
    PG8_WAIT_V(0);
    if constexpr (!ALIGN_EPI) { if (wr == 0) PG8_BAR; }
    PG8_BAR;
    if constexpr (Epi::AFTER_DRAIN) { E.fused(acc, cur, wr, wc, fr, fq, lds, wid, lane); S.done(cur); }
#undef PG8_SA
#undef PG8_SB
#undef PG8_STAGE
#undef PG8_LDA
#undef PG8_LDB
#undef PG8_MMA
#undef PG8_WAIT_V
#undef PG8_WAIT_L
#undef PG8_BAR
#undef PG8_SCHED
}
}
#define LAS __attribute__((address_space(3)))
typedef unsigned short bf16_t;
typedef short bf16x8 __attribute__((ext_vector_type(8)));
typedef short s16x4 __attribute__((ext_vector_type(4)));
typedef float f32x4 __attribute__((ext_vector_type(4)));
typedef unsigned u32x4 __attribute__((ext_vector_type(4)));
typedef unsigned u32x2 __attribute__((ext_vector_type(2)));
using pg8::cvt_pk_bf16; using pg8::bflo; using pg8::bfhi; using pg8::siluf_;

constexpr int D_MODEL = 2048, SEQ = 4096, M_TOK = 16384;
constexpr int NPROJ = pg8::NPROJ;
constexpr int N_IN = 19008, D_FF = 5632;
constexpr int COL_Q = 0, COL_K = 1536, COL_V = 3072, COL_Z = 4608, COL_XBC = 8704, COL_GA = 14848, COL_GS = 16896;
constexpr int NPHASE = 22;

constexpr size_t MiB = 1u << 20;
constexpr size_t WS_CTL = 0, CTL_ZERO_BYTES = 1 * MiB;
constexpr size_t WS_MOD = 65536;
constexpr size_t WS_LSE = 1 * MiB;
constexpr size_t WS_DT = 2 * MiB;
constexpr size_t WS_W = 8 * MiB;
constexpr size_t WO_IN = 0, WO_A = 78643200, WO_S = 80740352, WO_O = 97517568, WO_FI = 105906176, WO_FO = 152043520, WL_BYTES = 175112192;
constexpr size_t WS_H = WS_W + 2 * WL_BYTES;
constexpr size_t WS_PROJ = WS_H + (size_t)M_TOK * 2048 * 2;
constexpr size_t WS_XB = WS_PROJ + (size_t)M_TOK * NPROJ * 2;
constexpr size_t WS_END = WS_XB + (size_t)M_TOK * 2048 * 2;
constexpr int LDS_BYTES = 147456;

struct Args { const float* in[20]; float* out; unsigned char* ws; int ph_lo, ph_hi; };

template <int CTRL> __device__ __forceinline__ float dpp_f(float v) { return __int_as_float(__builtin_amdgcn_update_dpp(0, __float_as_int(v), CTRL, 0xf, 0xf, false)); }
__device__ __forceinline__ float xor16_sum(float v) { const auto r = __builtin_amdgcn_permlane16_swap(__float_as_uint(v), __float_as_uint(v), false, false); return __uint_as_float(r[0]) + __uint_as_float(r[1]); }
__device__ __forceinline__ float xor32_sum(float v) { const auto r = __builtin_amdgcn_permlane32_swap(__float_as_uint(v), __float_as_uint(v), false, false); return __uint_as_float(r[0]) + __uint_as_float(r[1]); }
__device__ __forceinline__ float xor16_max(float v) { const auto r = __builtin_amdgcn_permlane16_swap(__float_as_uint(v), __float_as_uint(v), false, false); return fmaxf(__uint_as_float(r[0]), __uint_as_float(r[1])); }
__device__ __forceinline__ float xor32_max(float v) { const auto r = __builtin_amdgcn_permlane32_swap(__float_as_uint(v), __float_as_uint(v), false, false); return fmaxf(__uint_as_float(r[0]), __uint_as_float(r[1])); }
__device__ __forceinline__ float wave_sum(float v) {
    v += dpp_f<0x128>(v); v += dpp_f<0x124>(v); v += dpp_f<0x122>(v); v += dpp_f<0x121>(v);
    v = xor16_sum(v); v = xor32_sum(v);
    return v;
}
__device__ __forceinline__ float wave_incl_scan(float v, int lane) {
#pragma unroll
    for (int o = 1; o < 64; o <<= 1) { const float t = __int_as_float(__builtin_amdgcn_ds_bpermute(((lane - o) & 63) << 2, __float_as_int(v))); if (lane >= o) v += t; }
    return v;
}
__device__ __forceinline__ float lane63(float v) { return __int_as_float(__builtin_amdgcn_readlane(__float_as_int(v), 63)); }
typedef short v4i16_t __attribute__((ext_vector_type(4)));
__device__ __forceinline__ s16x4 ldtr(LAS unsigned char* p) { return __builtin_bit_cast(s16x4, __builtin_amdgcn_ds_read_tr16_b64_v4i16((LAS v4i16_t*)p)); }
__device__ __forceinline__ bf16x8 cat8(s16x4 lo, s16x4 hi) { return (bf16x8){lo[0], lo[1], lo[2], lo[3], hi[0], hi[1], hi[2], hi[3]}; }
__device__ __forceinline__ f32x4 mfma16(bf16x8 a, bf16x8 b, f32x4 c) { return __builtin_amdgcn_mfma_f32_16x16x32_bf16(a, b, c, 0, 0, 0); }
#define LDS_WAIT() asm volatile("s_waitcnt lgkmcnt(0)" ::: "memory")

__device__ __forceinline__ void tr_item(const float* W, int Nsrc, bf16_t* WT, int K, int k0, int s0, int n0, LAS float* scr, int lane) {
    const int c = lane & 7;
    if (s0 < 0) {
#pragma unroll
        for (int j = 0; j < 4; ++j) { const int n = (lane >> 3) + 8 * j; *(u32x4*)(WT + (size_t)(n0 + n) * K + k0 + 8 * c) = (u32x4){0u, 0u, 0u, 0u}; }
        return;
    }
    { const float* wp = W + (size_t)(k0 + (lane >> 5)) * Nsrc + s0 + (lane & 31); float v[32];
#pragma unroll
        for (int i = 0; i < 32; ++i) v[i] = __builtin_nontemporal_load(wp + (size_t)(2 * i) * Nsrc);
#pragma unroll
        for (int i = 0; i < 32; ++i) scr[(2 * i + (lane >> 5)) * 33 + (lane & 31)] = v[i]; }
    LDS_WAIT();
#pragma unroll
    for (int j = 0; j < 4; ++j) { const int n = (lane >> 3) + 8 * j; const LAS float* s = scr + (8 * c) * 33 + n;
        u32x4 o; o.x = cvt_pk_bf16(s[0 * 33], s[1 * 33]); o.y = cvt_pk_bf16(s[2 * 33], s[3 * 33]); o.z = cvt_pk_bf16(s[4 * 33], s[5 * 33]); o.w = cvt_pk_bf16(s[6 * 33], s[7 * 33]);
        *(u32x4*)(WT + (size_t)(n0 + n) * K + k0 + 8 * c) = o; }
    LDS_WAIT();
}

struct SideItem { const float* src; bf16_t* dst; int nsrc; int mode; };
constexpr int IPL32 = 38400 + 1024 + 8192 + 4096 + 22528 + 11264;
__device__ __forceinline__ SideItem side_decode(const Args& a, int l, int it, int lane);
__device__ __forceinline__ void side_issue(const SideItem& s, float (&v)[16]);
__device__ __forceinline__ void side_drain(const SideItem& s, const float (&v)[16]);
__device__ __forceinline__ void phase_prep(const Args& a, LAS unsigned char* lds, int tid, int lane, int wave, int bx, int G, int nlayers) {
    float* MOD = (float*)(a.ws + WS_MOD);
    const float* cin = a.in[1]; const float* w_mod = a.in[5]; const float* b_mod = a.in[6];
    LAS f32x4* red = (LAS f32x4*)lds;
    for (int it = bx; it < 256; it += G) {
        const int l = it >> 7, c96 = it & 127;
        const int par = lane >= 24 ? 1 : 0, cl = lane - 24 * par; const bool act = lane < 48;
        const float* Wm = w_mod + (size_t)l * 2048 * 12288 + c96 * 96 + (act ? cl : 0) * 4;
        const int k0 = wave * 256 + par;
        f32x4 acc0 = {0.f, 0.f, 0.f, 0.f}, acc1 = acc0, acc2 = acc0, acc3 = acc0;
#pragma unroll 8
        for (int kk = 0; kk < 128; ++kk) { const int k = k0 + 2 * kk; const f32x4 wv = __builtin_nontemporal_load((const f32x4*)(Wm + (size_t)k * 12288));
            acc0 += siluf_(cin[k]) * wv; acc1 += siluf_(cin[2048 + k]) * wv; acc2 += siluf_(cin[4096 + k]) * wv; acc3 += siluf_(cin[6144 + k]) * wv; }
        if (act) { LAS f32x4* rp = red + ((wave * 2 + par) * 4) * 24 + cl; rp[0] = acc0; rp[24] = acc1; rp[48] = acc2; rp[72] = acc3; }
        __syncthreads();
        if (tid < 384) { const int b = tid / 96, ci = tid % 96; float s = b_mod[l * 12288 + c96 * 96 + ci];
#pragma unroll
            for (int w = 0; w < 16; ++w) s += ((const LAS float*)lds)[((w * 4 + b) * 24 + (ci >> 2)) * 4 + (ci & 3)];
            MOD[(size_t)(l * 4 + b) * 12288 + c96 * 96 + ci] = s; }
        __syncthreads();
    }
    LAS float* scr = (LAS float*)(lds + wave * 8704);
    const int gw = bx * 8 + wave, NGW = G * 8;
    constexpr int IPL = 19200 + 512 + 4096 + 2048 + 11264 + 5632;
    for (int it = gw; it < nlayers * IPL; it += NGW) {
        const int l = it / IPL; int r = it % IPL;
        unsigned char* wb = a.ws + WS_W + (size_t)l * WL_BYTES;
        if (r < 19200) { const int kb = r / 600, nb = r % 600, n0 = nb * 32;
            const int s0 = n0 < 14848 ? n0 : (n0 < 18944 ? n0 + 64 : (n0 < 19008 ? 14848 + (n0 - 18944) : -1));
            tr_item(a.in[7] + (size_t)l * 2048 * N_IN, N_IN, (bf16_t*)(wb + WO_IN), 2048, kb * 64, s0, n0, scr, lane); continue; }
        r -= 19200;
        if (r < 512) { const int kb = r >> 6, nb = r & 63; tr_item(a.in[14] + (size_t)l * 512 * 2048, 2048, (bf16_t*)(wb + WO_A), 512, kb * 64, nb * 32, nb * 32, scr, lane); continue; }
        r -= 512;
        if (r < 4096) { const int kb = r >> 6, nb = r & 63; tr_item(a.in[15] + (size_t)l * 4096 * 2048, 2048, (bf16_t*)(wb + WO_S), 4096, kb * 64, nb * 32, nb * 32, scr, lane); continue; }
        r -= 4096;
        if (r < 2048) { const int kb = r >> 6, nb = r & 63; tr_item(a.in[16] + (size_t)l * 2048 * 2048, 2048, (bf16_t*)(wb + WO_O), 2048, kb * 64, nb * 32, nb * 32, scr, lane); continue; }
        r -= 2048;
        if (r < 11264) { const int kb = r / 352, nb = r % 352, n0 = nb * 32, t = n0 >> 8, j = n0 & 255;
            const int s0 = j < 128 ? 128 * t + j : D_FF + 128 * t + (j - 128);
            tr_item(a.in[17] + (size_t)l * 2048 * 2 * D_FF, 2 * D_FF, (bf16_t*)(wb + WO_FI), 2048, kb * 64, s0, n0, scr, lane); continue; }
        r -= 11264;
        { const int kb = r >> 6, nb = r & 63; tr_item(a.in[18] + (size_t)l * D_FF * 2048, 2048, (bf16_t*)(wb + WO_FO), D_FF, kb * 64, nb * 32, nb * 32, scr, lane); }
    }
    if (nlayers == 1) {
        for (int it = 32 * NGW + gw; it < IPL32; it += NGW) { float v[16]; const SideItem sd = side_decode(a, 1, it, lane); side_issue(sd, v); side_drain(sd, v); }
    }
}

template <bool FINAL>
__device__ __forceinline__ void phase_norm(const float* x, const float* w, const float* sc, const float* sh, bf16_t* H, float* outf, int lane, int gw, int NGW) {
    for (int blk = gw; blk < M_TOK / 8; blk += NGW) {
        const int m0 = blk * 8, b = m0 >> 12;
        f32x4 A[8], B[8];
#pragma unroll
        for (int j = 0; j < 8; ++j) { const int col = 4 * (lane + 64 * j); A[j] = *(const f32x4*)(w + col);
            if (!FINAL) { const f32x4 scv = *(const f32x4*)(sc + (size_t)b * 12288 + col); A[j] = A[j] * (1.0f + scv); B[j] = *(const f32x4*)(sh + (size_t)b * 12288 + col); } }
        f32x4 v[8], nx[8];
        { const f32x4* xr = (const f32x4*)(x + (size_t)m0 * 2048) + lane;
#pragma unroll
            for (int j = 0; j < 8; ++j) nx[j] = xr[64 * j]; }
#pragma unroll 1
        for (int r = 0; r < 8; ++r) { const int m = m0 + r;
#pragma unroll
            for (int j = 0; j < 8; ++j) v[j] = nx[j];
            if (r + 1 < 8) { const f32x4* xr = (const f32x4*)(x + (size_t)(m + 1) * 2048) + lane;
#pragma unroll
                for (int j = 0; j < 8; ++j) nx[j] = xr[64 * j]; }
            float ss = 0.f;
#pragma unroll
            for (int j = 0; j < 8; ++j) ss += (v[j].x * v[j].x + v[j].y * v[j].y) + (v[j].z * v[j].z + v[j].w * v[j].w);
            ss = wave_sum(ss);
            const float rstd = 1.0f / sqrtf(ss * (1.0f / 2048.0f) + 1e-6f);
#pragma unroll
            for (int j = 0; j < 8; ++j) { const int col = 4 * (lane + 64 * j);
                if (FINAL) { *(f32x4*)(outf + (size_t)m * 2048 + col) = v[j] * rstd * A[j]; }
                else { const f32x4 o = v[j] * rstd * A[j] + B[j];
                    u32x2 pk; pk.x = cvt_pk_bf16(o.x, o.y); pk.y = cvt_pk_bf16(o.z, o.w);
                    *(u32x2*)(H + (size_t)m * 2048 + col) = pk; } }
        }
    }
}

template <bool FINAL>
__device__ __forceinline__ void phase_norm_b(const bf16_t* xb, const float* w, const float* sc, const float* sh, bf16_t* H, float* outf, int lane, int gw, int NGW) {
    for (int blk = gw; blk < M_TOK / 8; blk += NGW) {
        const int m0 = blk * 8, b = m0 >> 12;
        f32x4 A0[4], A1[4], B0[4], B1[4];
#pragma unroll
        for (int j = 0; j < 4; ++j) { const int col = 8 * (lane + 64 * j); A0[j] = *(const f32x4*)(w + col); A1[j] = *(const f32x4*)(w + col + 4);
            if (!FINAL) { const float* scp = sc + (size_t)b * 12288 + col; const float* shp = sh + (size_t)b * 12288 + col;
                A0[j] = A0[j] * (1.0f + *(const f32x4*)scp); A1[j] = A1[j] * (1.0f + *(const f32x4*)(scp + 4)); B0[j] = *(const f32x4*)shp; B1[j] = *(const f32x4*)(shp + 4); } }
        u32x4 nx[4];
        { const u32x4* xr = (const u32x4*)(xb + (size_t)m0 * 2048) + lane;
#pragma unroll
            for (int j = 0; j < 4; ++j) nx[j] = xr[64 * j]; }
#pragma unroll 1
        for (int r = 0; r < 8; ++r) { const int m = m0 + r;
            f32x4 v0[4], v1[4];
#pragma unroll
            for (int j = 0; j < 4; ++j) { const u32x4 q = nx[j]; v0[j] = (f32x4){bflo(q.x), bfhi(q.x), bflo(q.y), bfhi(q.y)}; v1[j] = (f32x4){bflo(q.z), bfhi(q.z), bflo(q.w), bfhi(q.w)}; }
            if (r + 1 < 8) { const u32x4* xr = (const u32x4*)(xb + (size_t)(m + 1) * 2048) + lane;
#pragma unroll
                for (int j = 0; j < 4; ++j) nx[j] = xr[64 * j]; }
            float ss = 0.f;
#pragma unroll
            for (int j = 0; j < 4; ++j) { const f32x4 q0 = v0[j] * v0[j], q1 = v1[j] * v1[j]; ss += ((q0.x + q0.y) + (q0.z + q0.w)) + ((q1.x + q1.y) + (q1.z + q1.w)); }
            ss = wave_sum(ss);
            const float rstd = 1.0f / sqrtf(ss * (1.0f / 2048.0f) + 1e-6f);
#pragma unroll
            for (int j = 0; j < 4; ++j) { const int col = 8 * (lane + 64 * j);
                if (FINAL) { *(f32x4*)(outf + (size_t)m * 2048 + col) = v0[j] * rstd * A0[j]; *(f32x4*)(outf + (size_t)m * 2048 + col + 4) = v1[j] * rstd * A1[j]; }
                else { const f32x4 o0 = v0[j] * rstd * A0[j] + B0[j], o1 = v1[j] * rstd * A1[j] + B1[j];
                    u32x4 pk; pk.x = cvt_pk_bf16(o0.x, o0.y); pk.y = cvt_pk_bf16(o0.z, o0.w); pk.z = cvt_pk_bf16(o1.x, o1.y); pk.w = cvt_pk_bf16(o1.z, o1.w);
                    *(u32x4*)(H + (size_t)m * 2048 + col) = pk; } }
        }
    }
}

__device__ __forceinline__ void att_decode(int u, int& g, int& b, int& hh, int& d, int& r, int& n) {
    g = u >> 9; const int rem = u & 511; b = rem >> 7; hh = (rem >> 5) & 3; const int bi = rem & 31;
    d = g == 0 ? 1 : (g == 1 ? 4 : 16); const int nb = 32 / d; r = bi / nb; n = bi % nb;
}
__device__ __forceinline__ void phase_attn(bf16_t* P, float* LSE, const float* rel_bias, LAS unsigned char* lds, int bx, int G, int tid_) {
    int tid = tid_; asm volatile("" : "+v"(tid)); const int lane = tid & 63, wave = __builtin_amdgcn_readfirstlane(tid >> 6);
    constexpr int RS = 272;
    LAS unsigned char* Ks = lds; LAS unsigned char* Vs = lds + 256 * RS; LAS float* biasT = (LAS float*)(lds + 2 * 256 * RS);
    const int l15 = lane & 15, q4 = lane >> 4, qi = 16 * wave + l15;
    int u = bx; if (u >= 1536) return;
    u32x4 kr[8], vr[8]; bf16x8 Qn[4];
#define ATT_LOAD(uu) do { int g_, b_, hh_, d_, r_, n_; att_decode((uu), g_, b_, hh_, d_, r_, n_); const int colq_ = g_ * 512 + hh_ * 128; \
        _Pragma("unroll") for (int i = 0; i < 8; ++i) { const int idx = tid + 512 * i, key = idx >> 4, ch = idx & 15; const int si = (n_ - 1) * 128 + key; \
            kr[i] = (u32x4){0u, 0u, 0u, 0u}; vr[i] = (u32x4){0u, 0u, 0u, 0u}; \
            if (n_ > 0 || i >= 4) { const bf16_t* rp = P + (size_t)(b_ * SEQ + si * d_ + r_) * NPROJ + colq_ + ch * 8; kr[i] = *(const u32x4*)(rp + COL_K); vr[i] = *(const u32x4*)(rp + COL_V); } } \
        { const bf16_t* qp_ = P + (size_t)(b_ * SEQ + (n_ * 128 + qi) * d_ + r_) * NPROJ + colq_; \
          _Pragma("unroll") for (int ks = 0; ks < 4; ++ks) Qn[ks] = *(const bf16x8*)(qp_ + 32 * ks + 8 * q4); } } while (0)
    ATT_LOAD(u);
    for (;;) {
        int g, b, hh, d, r, n; att_decode(u, g, b, hh, d, r, n);
        const int colq = g * 512 + hh * 128;
#pragma unroll
        for (int i = 0; i < 8; ++i) { const int idx = tid + 512 * i, key = idx >> 4, ch = idx & 15;
            *(LAS u32x4*)(Ks + key * RS + ch * 16) = kr[i]; *(LAS u32x4*)(Vs + key * RS + ch * 16) = vr[i]; }
        if (tid < 160) { const int steps = tid - 15; float bv = -INFINITY;
            if (steps >= 0 && steps <= 128) { const int dist = steps * d; int bk;
                if (dist < 16) bk = dist; else { const int lg = 16 + (int)(logf((float)dist / 16.0f) / 4.852030263919617f * 16.0f); bk = lg < 31 ? lg : 31; }
                bv = rel_bias[bk * 12 + g * 4 + hh]; }
            biasT[tid] = bv; }
        bf16x8 Qf[4];
#pragma unroll
        for (int ks = 0; ks < 4; ++ks) Qf[ks] = Qn[ks];
        __syncthreads();
        const int un = u + G;
        if (un < 1536) ATT_LOAD(un);
        const size_t tq = (size_t)(b * SEQ + (n * 128 + qi) * d + r);
        bf16_t* qp = P + tq * NPROJ + colq;
        f32x4 S[9];
        LAS unsigned char* kbase = Ks + (16 * wave + l15) * RS + q4 * 16;
#pragma unroll
        for (int tt = 0; tt < 9; ++tt) { S[tt] = (f32x4){0.f, 0.f, 0.f, 0.f};
#pragma unroll
            for (int ks = 0; ks < 4; ++ks) { const bf16x8 Kf = *(const LAS bf16x8*)(kbase + tt * 16 * RS + ks * 64); S[tt] = mfma16(Kf, Qf[ks], S[tt]); } }
        __builtin_amdgcn_sched_barrier(0);
        const float scale = 0.08838834764831845f;
        float mx = -INFINITY;
        {
            const LAS float* bp = biasT + (143 + l15 - 4 * q4);
#pragma unroll
            for (int tt = 0; tt < 9; ++tt)
#pragma unroll
                for (int e = 0; e < 4; ++e) S[tt][e] = S[tt][e] * scale + bp[-(16 * tt + e)];
            if (n == 0) {
#pragma unroll
                for (int tt = 0; tt < 9; ++tt)
#pragma unroll
                    for (int e = 0; e < 4; ++e) { if (wave + tt < 8) S[tt][e] = -INFINITY; }
            }
#pragma unroll
            for (int tt = 0; tt < 9; ++tt)
#pragma unroll
                for (int e = 0; e < 4; ++e) mx = fmaxf(mx, S[tt][e]);
        }
        mx = xor16_max(mx); mx = xor32_max(mx);
        float sum = 0.f;
#pragma unroll
        for (int tt = 0; tt < 9; ++tt)
#pragma unroll
            for (int e = 0; e < 4; ++e) { const float p = __expf(S[tt][e] - mx); S[tt][e] = p; sum += p; }
        sum = xor16_sum(sum); sum = xor32_sum(sum);
        bf16x8 Pf[5];
#pragma unroll
        for (int kk = 0; kk < 5; ++kk) { u32x4 w; w.x = cvt_pk_bf16(S[2 * kk][0], S[2 * kk][1]); w.y = cvt_pk_bf16(S[2 * kk][2], S[2 * kk][3]);
            if (kk < 4) { w.z = cvt_pk_bf16(S[2 * kk + 1][0], S[2 * kk + 1][1]); w.w = cvt_pk_bf16(S[2 * kk + 1][2], S[2 * kk + 1][3]); } else { w.z = 0u; w.w = 0u; }
            Pf[kk] = __builtin_bit_cast(bf16x8, w); }
        const float inv = 1.0f / sum;
        LAS unsigned char* vbase = Vs + (16 * wave + 4 * q4 + (l15 >> 2)) * RS + (l15 & 3) * 8;
        bf16_t* op = qp + 4 * q4;
#pragma unroll
        for (int dt = 0; dt < 8; ++dt) { f32x4 o = {0.f, 0.f, 0.f, 0.f};
#pragma unroll
            for (int kk = 0; kk < 5; ++kk) {
                const s16x4 lo = ldtr(vbase + (32 * kk) * RS + dt * 32);
                s16x4 hi = {0, 0, 0, 0};
                if (kk < 4) hi = ldtr(vbase + (32 * kk + 16) * RS + dt * 32);
                o = mfma16(cat8(lo, hi), Pf[kk], o); }
            u32x2 pk; pk.x = cvt_pk_bf16(o[0] * inv, o[1] * inv); pk.y = cvt_pk_bf16(o[2] * inv, o[3] * inv);
            *(u32x2*)(op + 16 * dt) = pk;
            __builtin_amdgcn_sched_barrier(0); }
        if (q4 == 0) LSE[tq * 12 + g * 4 + hh] = mx + logf(sum);
        __syncthreads();
        if (un >= 1536) break;
        u = un;
    }
#undef ATT_LOAD
}

__device__ __forceinline__ SideItem side_decode(const Args& a, int l, int it, int lane) {
    SideItem s; s.src = nullptr; s.dst = nullptr; s.nsrc = 0; s.mode = 0;
    if (it >= IPL32) return s;
    unsigned char* wb = a.ws + WS_W + (size_t)l * WL_BYTES;
    const float* W; bf16_t* WT; int K, Nsrc, kb, nb, s0;
    int r = it;
    if (r < 38400) { kb = r / 600; nb = r % 600; const int n0 = nb * 32; s0 = n0 < 14848 ? n0 : (n0 < 18944 ? n0 + 64 : (n0 < 19008 ? 14848 + (n0 - 18944) : -1));
        W = a.in[7] + (size_t)l * 2048 * N_IN; Nsrc = N_IN; WT = (bf16_t*)(wb + WO_IN); K = 2048; }
    else if ((r -= 38400) < 1024) { kb = r >> 6; nb = r & 63; s0 = nb * 32; W = a.in[14] + (size_t)l * 512 * 2048; Nsrc = 2048; WT = (bf16_t*)(wb + WO_A); K = 512; }
    else if ((r -= 1024) < 8192) { kb = r >> 6; nb = r & 63; s0 = nb * 32; W = a.in[15] + (size_t)l * 4096 * 2048; Nsrc = 2048; WT = (bf16_t*)(wb + WO_S); K = 4096; }
    else if ((r -= 8192) < 4096) { kb = r >> 6; nb = r & 63; s0 = nb * 32; W = a.in[16] + (size_t)l * 2048 * 2048; Nsrc = 2048; WT = (bf16_t*)(wb + WO_O); K = 2048; }
    else if ((r -= 4096) < 22528) { kb = r / 352; nb = r % 352; const int n0 = nb * 32, t = n0 >> 8, j = n0 & 255; s0 = j < 128 ? 128 * t + j : D_FF + 128 * t + (j - 128);
        W = a.in[17] + (size_t)l * 2048 * 2 * D_FF; Nsrc = 2 * D_FF; WT = (bf16_t*)(wb + WO_FI); K = 2048; }
    else { r -= 22528; kb = r >> 6; nb = r & 63; s0 = nb * 32; W = a.in[18] + (size_t)l * D_FF * 2048; Nsrc = 2048; WT = (bf16_t*)(wb + WO_FO); K = D_FF; }
    const int n = lane & 31, kh = lane >> 5, k0 = kb * 32 + 16 * kh;
    s.dst = WT + (size_t)(nb * 32 + n) * K + k0; s.nsrc = Nsrc;
    if (s0 < 0) { s.mode = 2; } else { s.mode = 1; s.src = W + (size_t)k0 * Nsrc + s0 + n; }
    return s;
}
__device__ __forceinline__ void side_issue(const SideItem& s, float (&v)[16]) {
    if (s.mode == 1) {
#pragma unroll
        for (int j = 0; j < 16; ++j) v[j] = s.src[(size_t)j * s.nsrc]; }
}
__device__ __forceinline__ void side_drain(const SideItem& s, const float (&v)[16]) {
    if (s.mode == 0) return;
    u32x4 w0 = {0u, 0u, 0u, 0u}, w1 = {0u, 0u, 0u, 0u};
    if (s.mode == 1) { w0.x = cvt_pk_bf16(v[0], v[1]); w0.y = cvt_pk_bf16(v[2], v[3]); w0.z = cvt_pk_bf16(v[4], v[5]); w0.w = cvt_pk_bf16(v[6], v[7]);
        w1.x = cvt_pk_bf16(v[8], v[9]); w1.y = cvt_pk_bf16(v[10], v[11]); w1.z = cvt_pk_bf16(v[12], v[13]); w1.w = cvt_pk_bf16(v[14], v[15]); }
    *(u32x4*)s.dst = w0; *(u32x4*)(s.dst + 8) = w1;
}

__device__ __forceinline__ void phase_convbc(const bf16_t* P, bf16_t* HBC, const float* conv_w, const float* conv_b, int tid, int bx, int G) {
    const int chunk = tid & 255, rh = tid >> 8, col = 4096 + chunk * 8;
    float cw[4][8], cbias[8];
#pragma unroll
    for (int e = 0; e < 8; ++e) { cbias[e] = conv_b[col + e];
#pragma unroll
        for (int j = 0; j < 4; ++j) cw[j][e] = conv_w[j * 6144 + col + e]; }
    for (int it = bx; it < M_TOK / 32; it += G) {
        const int r0 = it * 32 + rh * 16; const bool halo = (r0 & (SEQ - 1)) != 0;
        const bf16_t* src = P + (size_t)r0 * NPROJ + COL_XBC + col;
        u32x4 raw[19];
#pragma unroll
        for (int i = 0; i < 19; ++i) { raw[i] = (u32x4){0u, 0u, 0u, 0u}; if (i >= 3 || halo) raw[i] = *(const u32x4*)(src + (ptrdiff_t)(i - 3) * NPROJ); }
#pragma unroll
        for (int rr = 0; rr < 16; ++rr) { float o[8];
#pragma unroll
            for (int e = 0; e < 8; ++e) o[e] = cbias[e];
#pragma unroll
            for (int j = 0; j < 4; ++j) { const u32x4 rv = raw[rr + j];
                o[0] += bflo(rv.x) * cw[j][0]; o[1] += bfhi(rv.x) * cw[j][1]; o[2] += bflo(rv.y) * cw[j][2]; o[3] += bfhi(rv.y) * cw[j][3];
                o[4] += bflo(rv.z) * cw[j][4]; o[5] += bfhi(rv.z) * cw[j][5]; o[6] += bflo(rv.w) * cw[j][6]; o[7] += bfhi(rv.w) * cw[j][7]; }
#pragma unroll
            for (int e = 0; e < 8; ++e) o[e] = siluf_(o[e]);
            u32x4 w; w.x = cvt_pk_bf16(o[0], o[1]); w.y = cvt_pk_bf16(o[2], o[3]); w.z = cvt_pk_bf16(o[4], o[5]); w.w = cvt_pk_bf16(o[6], o[7]);
            *(u32x4*)(HBC + (size_t)(r0 + rr) * 2048 + chunk * 8) = w; }
    }
}

template <int VAR, bool SIDE>
__device__ __forceinline__ void ssd_unit(bf16_t* P, const bf16_t* HBC, const float* DT, const float* conv_w, const float* conv_b, float dtb, float Aneg, float Dk,
                                         LAS unsigned char* lds, int b, int hd, int tid_, int lane_, int wave_, const Args& sa, int sgw, int sngw) {
    int tid = tid_; asm volatile("" : "+v"(tid)); const int lane = tid & 63, wave = __builtin_amdgcn_readfirstlane(tid >> 6);
    constexpr int XS = 144, BS = 272;
    LAS unsigned char* Xs = lds; LAS unsigned char* Xw = lds + 18432; LAS unsigned char* Bm = lds + 36864; LAS unsigned char* Cm = lds + 71680; LAS unsigned char* Hs = lds + 106496;
    LAS float* scal = (LAS float*)(lds + 123904);
    const int g = hd >> 3, l15 = lane & 15, q4 = lane >> 4;
    const int xch = tid & 7, xr0 = (tid >> 3) * 2;
    const int xcol = hd * 64 + xch * 8;
    const int bcch = tid & 31, bcrow = tid >> 5;
    const int bccol = bcch < 16 ? g * 128 + bcch * 8 : 1024 + g * 128 + (bcch - 16) * 8;
    LAS unsigned char* bcdst = (bcch < 16 ? Bm + bcch * 16 : Cm + (bcch - 16) * 16) + bcrow * BS;
    LAS float* cwt = (LAS float*)(lds + 126976);
    if (tid < 320) { const int j = tid >> 6, cc = tid & 63; cwt[tid] = j < 4 ? conv_w[j * 6144 + hd * 64 + cc] : conv_b[hd * 64 + cc]; }
    { u32x4 zq = {0u, 0u, 0u, 0u}; asm volatile("" : "+v"(zq));
      for (int i = tid; i < 17408 / 16; i += 512) *(LAS u32x4*)(Hs + i * 16) = zq; }
    f32x4 hacc[4];
#pragma unroll
    for (int pt = 0; pt < 4; ++pt) hacc[pt] = (f32x4){0.f, 0.f, 0.f, 0.f};
    u32x4 xraw[5], bcraw[8]; float dr0 = 0.f, dr1 = 0.f;
#define SSD_LOADS(c_) do { const int tok0_ = b * SEQ + (c_) * 128; \
        _Pragma("unroll") for (int i = 0; i < 5; ++i) { xraw[i] = (u32x4){0u, 0u, 0u, 0u}; \
            if (i >= 3 || (c_) > 0 || xr0 + i >= 3) xraw[i] = *(const u32x4*)(P + (size_t)(tok0_ + xr0 - 3 + i) * NPROJ + COL_XBC + xcol); } \
        if (wave == 0) { dr0 = DT[(size_t)(tok0_ + lane) * 64 + hd]; dr1 = DT[(size_t)(tok0_ + 64 + lane) * 64 + hd]; } } while (0)
#define SSD_LOADS_BC(c_) do { const int tok0_ = b * SEQ + (c_) * 128; \
        _Pragma("unroll") for (int i = 0; i < 8; ++i) bcraw[i] = *(const u32x4*)(HBC + (size_t)(tok0_ + bcrow + 16 * i) * 2048 + bccol); } while (0)
#define SSD_SCAN(par_) do { LAS float* dtv_ = scal + (par_) * 128; LAS float* acum_ = scal + 256 + (par_) * 128; LAS float* wl_ = scal + 512 + (par_) * 128; \
        const float x0 = dr0 + dtb, x1 = dr1 + dtb; \
        const float dt0 = x0 > 20.f ? x0 : log1pf(expf(x0)), dt1 = x1 > 20.f ? x1 : log1pf(expf(x1)); \
        const float s0 = wave_incl_scan(dt0 * Aneg, lane); const float tot0 = lane63(s0); \
        const float s1 = wave_incl_scan(dt1 * Aneg, lane) + tot0; const float tot = lane63(s1); \
        dtv_[lane] = dt0; dtv_[64 + lane] = dt1; acum_[lane] = s0 * 1.4426950408889634f; acum_[64 + lane] = s1 * 1.4426950408889634f;     \
        wl_[lane] = dt0 * __expf(tot - s0); wl_[64 + lane] = dt1 * __expf(tot - s1); } while (0)
    SideItem sd0; float sv0[16]; sd0.src = nullptr; sd0.dst = nullptr; sd0.nsrc = 0; sd0.mode = 0;
#pragma unroll
    for (int j = 0; j < 16; ++j) sv0[j] = 0.f;
    SSD_LOADS(0); SSD_LOADS_BC(0);
    if (wave == 0) SSD_SCAN(0);
    __syncthreads();
    for (int c = 0; c < 32; ++c) {
        const int par = c & 1;
        LAS float* dtv = scal + par * 128; LAS float* acum = scal + 256 + par * 128; LAS float* wl = scal + 512 + par * 128;
        const int tok0 = b * SEQ + c * 128;
        f32x4 o2[2][2];
        { const f32x4 ba = *(const LAS f32x4*)(cwt + 256 + xch * 8), bb = *(const LAS f32x4*)(cwt + 256 + xch * 8 + 4); o2[0][0] = ba; o2[0][1] = bb; o2[1][0] = ba; o2[1][1] = bb; }
#pragma unroll
        for (int j = 0; j < 4; ++j) { const f32x4 wa = *(const LAS f32x4*)(cwt + j * 64 + xch * 8), wb = *(const LAS f32x4*)(cwt + j * 64 + xch * 8 + 4);
#pragma unroll
            for (int rr = 0; rr < 2; ++rr) { const u32x4 rv = xraw[rr + j];
                o2[rr][0] += (f32x4){bflo(rv.x), bfhi(rv.x), bflo(rv.y), bfhi(rv.y)} * wa; o2[rr][1] += (f32x4){bflo(rv.z), bfhi(rv.z), bflo(rv.w), bfhi(rv.w)} * wb; } }
        { f32x4 t[2][2];
#pragma unroll
            for (int rr = 0; rr < 2; ++rr)
#pragma unroll
                for (int hq = 0; hq < 2; ++hq)
                    { const f32x4 ta = o2[rr][hq] * -1.4426950408889634f;
#pragma unroll
                      for (int e = 0; e < 4; ++e) t[rr][hq][e] = __builtin_amdgcn_exp2f(ta[e]); }
#pragma unroll
            for (int rr = 0; rr < 2; ++rr)
#pragma unroll
                for (int hq = 0; hq < 2; ++hq)
                    { const f32x4 tb = t[rr][hq] + 1.0f;
#pragma unroll
                      for (int e = 0; e < 4; ++e) t[rr][hq][e] = __builtin_amdgcn_rcpf(tb[e]); }
#pragma unroll
            for (int rr = 0; rr < 2; ++rr)
#pragma unroll
                for (int hq = 0; hq < 2; ++hq) o2[rr][hq] = o2[rr][hq] * t[rr][hq]; }
#pragma unroll
        for (int rr = 0; rr < 2; ++rr) { const f32x4 oa = o2[rr][0], ob = o2[rr][1];
            u32x4 w; w.x = cvt_pk_bf16(oa[0], oa[1]); w.y = cvt_pk_bf16(oa[2], oa[3]); w.z = cvt_pk_bf16(ob[0], ob[1]); w.w = cvt_pk_bf16(ob[2], ob[3]);
            *(LAS u32x4*)(Xs + (xr0 + rr) * XS + xch * 16) = w;
            const float f = wl[xr0 + rr]; const f32x4 pa = oa * f, pb = ob * f;
            w.x = cvt_pk_bf16(pa[0], pa[1]); w.y = cvt_pk_bf16(pa[2], pa[3]); w.z = cvt_pk_bf16(pb[0], pb[1]); w.w = cvt_pk_bf16(pb[2], pb[3]);
            *(LAS u32x4*)(Xw + (xr0 + rr) * XS + xch * 16) = w; }
#pragma unroll
        for (int i = 0; i < 8; ++i) *(LAS u32x4*)(bcdst + 16 * i * BS) = bcraw[i];
        if (SIDE) { side_drain(sd0, sv0); sd0.mode = 0; }
        __syncthreads();
        if (c + 1 < 32 && !(VAR & 2)) SSD_LOADS(c + 1);
        {
            const int lt = wave < 4 ? wave : 11 - wave;
            const int l = 16 * lt + l15; const float acl = acum[l];
            const size_t token = (size_t)(tok0 + l);
            bf16_t* zp = P + token * NPROJ + COL_Z + hd * 64 + 4 * q4;
            u32x2 zv[4];
#pragma unroll
            for (int pt = 0; pt < 4; ++pt) { zv[pt] = (u32x2){0x3f803f80u, 0x3f803f80u}; if (!(VAR & 1)) zv[pt] = *(const u32x2*)(zp + 16 * pt); }
            f32x4 Y[4];
#pragma unroll
            for (int pt = 0; pt < 4; ++pt) Y[pt] = (f32x4){0.f, 0.f, 0.f, 0.f};
            bf16x8 Cf[4];
            LAS unsigned char* cbase = Cm + l * BS + q4 * 16;
#pragma unroll
            for (int ks = 0; ks < 4; ++ks) Cf[ks] = *(const LAS bf16x8*)(cbase + ks * 64);
            LAS unsigned char* hbase = Hs + l15 * BS + q4 * 16;
#pragma unroll
            for (int pt = 0; pt < 4; ++pt)
#pragma unroll
                for (int ks = 0; ks < 4; ++ks) { const bf16x8 Hf = *(const LAS bf16x8*)(hbase + pt * 16 * BS + ks * 64); Y[pt] = mfma16(Hf, Cf[ks], Y[pt]); }
            const float eal = __builtin_amdgcn_exp2f(acl);
#pragma unroll
            for (int pt = 0; pt < 4; ++pt) Y[pt] *= eal;
            __builtin_amdgcn_sched_barrier(0);
            f32x4 Gt[8];
            f32x4 penv;
#pragma unroll
            for (int e = 0; e < 4; ++e) penv[e] = (4 * q4 + e <= l15) ? 0.f : 1e30f;
            LAS unsigned char* bbase = Bm + l15 * BS + q4 * 16;
#pragma unroll
            for (int st = 0; st < 8; ++st) { Gt[st] = (f32x4){0.f, 0.f, 0.f, 0.f};
                if (st <= lt) {
#pragma unroll
                    for (int ks = 0; ks < 4; ++ks) { const bf16x8 Bf = *(const LAS bf16x8*)(bbase + st * 16 * BS + ks * 64); Gt[st] = mfma16(Bf, Cf[ks], Gt[st]); }
                    const f32x4 as = *(const LAS f32x4*)(acum + 16 * st + 4 * q4), ds = *(const LAS f32x4*)(dtv + 16 * st + 4 * q4);
#pragma unroll
                    for (int e = 0; e < 1; ++e) { const float flagf = (st == lt) ? 1.0f : 0.0f;
                        const f32x4 dv = (acl - as) - penv * flagf;
                        f32x4 fv; fv[0] = __builtin_amdgcn_exp2f(dv[0]); fv[1] = __builtin_amdgcn_exp2f(dv[1]); fv[2] = __builtin_amdgcn_exp2f(dv[2]); fv[3] = __builtin_amdgcn_exp2f(dv[3]);
                        Gt[st] = Gt[st] * (fv * ds); }
                } }
            LAS unsigned char* xbase = Xs + (4 * q4 + (l15 >> 2)) * XS + (l15 & 3) * 8;
#pragma unroll
            for (int kk = 0; kk < 4; ++kk) {
                if (2 * kk <= lt) {
                    u32x4 w; w.x = cvt_pk_bf16(Gt[2 * kk][0], Gt[2 * kk][1]); w.y = cvt_pk_bf16(Gt[2 * kk][2], Gt[2 * kk][3]);
                    w.z = cvt_pk_bf16(Gt[2 * kk + 1][0], Gt[2 * kk + 1][1]); w.w = cvt_pk_bf16(Gt[2 * kk + 1][2], Gt[2 * kk + 1][3]);
                    const bf16x8 Pf = __builtin_bit_cast(bf16x8, w);
#pragma unroll
                    for (int pt = 0; pt < 4; ++pt) {
                        const s16x4 xlo = ldtr(xbase + (32 * kk) * XS + pt * 32);
                        const s16x4 xhi = ldtr(xbase + (32 * kk + 16) * XS + pt * 32);
                        Y[pt] = mfma16(cat8(xlo, xhi), Pf, Y[pt]); }
                } }
            __builtin_amdgcn_sched_barrier(0);
            if (c + 1 < 32 && !(VAR & 2)) SSD_LOADS_BC(c + 1);
            if (SIDE) { sd0 = side_decode(sa, 1, sgw + sngw * c, lane); side_issue(sd0, sv0); }
#pragma unroll
            for (int pt = 0; pt < 4; ++pt) { const int p0 = 16 * pt + 4 * q4;
                const u32x2 xv = *(const LAS u32x2*)(Xs + l * XS + p0 * 2);
                const f32x4 xf = {bflo(xv.x), bfhi(xv.x), bflo(xv.y), bfhi(xv.y)}, zf = {bflo(zv[pt].x), bfhi(zv[pt].x), bflo(zv[pt].y), bfhi(zv[pt].y)};
                const f32x4 yv = (Y[pt] + Dk * xf) * zf;
                u32x2 pk; pk.x = cvt_pk_bf16(yv[0], yv[1]); pk.y = cvt_pk_bf16(yv[2], yv[3]); if (!(VAR & 1)) *(u32x2*)(zp + 16 * pt) = pk; else asm volatile("" :: "v"(pk.x), "v"(pk.y)); }
            __builtin_amdgcn_sched_barrier(0);
            const float et = __builtin_amdgcn_exp2f(acum[127]);
#pragma unroll
            for (int pt = 0; pt < 4; ++pt) hacc[pt] *= et;
            LAS unsigned char* btbase = Bm + (4 * q4 + (l15 >> 2)) * BS + (16 * wave + 4 * (l15 & 3)) * 2;
            LAS unsigned char* xwbase = Xw + (4 * q4 + (l15 >> 2)) * XS + (l15 & 3) * 8;
#pragma unroll
            for (int kk = 0; kk < 4; ++kk) {
                const s16x4 blo = ldtr(btbase + (32 * kk) * BS);
                const s16x4 bhi = ldtr(btbase + (32 * kk + 16) * BS);
                const bf16x8 Bf = cat8(blo, bhi);
#pragma unroll
                for (int pt = 0; pt < 4; ++pt) {
                    const s16x4 xlo = ldtr(xwbase + (32 * kk) * XS + pt * 32);
                    const s16x4 xhi = ldtr(xwbase + (32 * kk + 16) * XS + pt * 32);
                    hacc[pt] = mfma16(Bf, cat8(xlo, xhi), hacc[pt]); }
            }
        }
        if (wave == 0 && c + 1 < 32) SSD_SCAN(par ^ 1);
        __syncthreads();
#pragma unroll
        for (int pt = 0; pt < 4; ++pt) { u32x2 pk; pk.x = cvt_pk_bf16(hacc[pt][0], hacc[pt][1]); pk.y = cvt_pk_bf16(hacc[pt][2], hacc[pt][3]);
            *(LAS u32x2*)(Hs + (16 * pt + l15) * BS + (16 * wave + 4 * q4) * 2) = pk; }
    }
#undef SSD_LOADS
#undef SSD_LOADS_BC
#undef SSD_SCAN
    if (SIDE) { side_drain(sd0, sv0); }
    __syncthreads();
}

__device__ __forceinline__ void phase_attn_merge(bf16_t* P, const float* LSE, int lane, int gw, int NGW) {
    const int hh = lane >> 4, dd = (lane & 15) * 8;
#pragma unroll 2
    for (int m = gw; m < M_TOK; m += NGW) {
        bf16_t* op = P + (size_t)m * NPROJ + hh * 128 + dd;
        const float l0 = LSE[(size_t)m * 12 + hh], l1 = LSE[(size_t)m * 12 + 4 + hh], l2 = LSE[(size_t)m * 12 + 8 + hh];
        const u32x4 o0 = *(const u32x4*)op, o1 = *(const u32x4*)(op + 512), o2 = *(const u32x4*)(op + 1024);
        const float mx = fmaxf(l0, fmaxf(l1, l2)); float w0 = __expf(l0 - mx), w1 = __expf(l1 - mx), w2 = __expf(l2 - mx);
        const float inv = 1.0f / (w0 + w1 + w2); w0 *= inv; w1 *= inv; w2 *= inv;
        u32x4 w;
        w.x = cvt_pk_bf16(w0 * bflo(o0.x) + w1 * bflo(o1.x) + w2 * bflo(o2.x), w0 * bfhi(o0.x) + w1 * bfhi(o1.x) + w2 * bfhi(o2.x));
        w.y = cvt_pk_bf16(w0 * bflo(o0.y) + w1 * bflo(o1.y) + w2 * bflo(o2.y), w0 * bfhi(o0.y) + w1 * bfhi(o1.y) + w2 * bfhi(o2.y));
        w.z = cvt_pk_bf16(w0 * bflo(o0.z) + w1 * bflo(o1.z) + w2 * bflo(o2.z), w0 * bfhi(o0.z) + w1 * bfhi(o1.z) + w2 * bfhi(o2.z));
        w.w = cvt_pk_bf16(w0 * bflo(o0.w) + w1 * bflo(o1.w) + w2 * bflo(o2.w), w0 * bfhi(o0.w) + w1 * bfhi(o1.w) + w2 * bfhi(o2.w));
        *(u32x4*)op = w;
    }
}
__device__ __forceinline__ void phase_merge(bf16_t* P, const float* LSE, const float* nw, int lane, int gw, int NGW) {
    f32x4 wa[8], wb[8];
#pragma unroll
    for (int gg = 0; gg < 8; ++gg) { wa[gg] = *(const f32x4*)(nw + gg * 512 + lane * 8); wb[gg] = *(const f32x4*)(nw + gg * 512 + lane * 8 + 4); }
    for (int m = gw; m < M_TOK; m += NGW) {
        bf16_t* rp = P + (size_t)m * NPROJ;
        u32x4 yv[8];
#pragma unroll
        for (int gg = 0; gg < 8; ++gg) yv[gg] = *(const u32x4*)(rp + COL_Z + gg * 512 + lane * 8);
        float ss[8];
#pragma unroll
        for (int gg = 0; gg < 8; ++gg) { const u32x4 v = yv[gg];
            ss[gg] = (bflo(v.x) * bflo(v.x) + bfhi(v.x) * bfhi(v.x)) + (bflo(v.y) * bflo(v.y) + bfhi(v.y) * bfhi(v.y)) + (bflo(v.z) * bflo(v.z) + bfhi(v.z) * bfhi(v.z)) + (bflo(v.w) * bflo(v.w) + bfhi(v.w) * bfhi(v.w)); }
#pragma unroll
        for (int gg = 0; gg < 8; ++gg) ss[gg] = wave_sum(ss[gg]);
#pragma unroll
        for (int gg = 0; gg < 8; ++gg) { const u32x4 v = yv[gg];
            const float rs = 1.0f / sqrtf(ss[gg] * (1.0f / 512.0f) + 1e-6f);
            u32x4 w; w.x = cvt_pk_bf16(bflo(v.x) * rs * wa[gg].x, bfhi(v.x) * rs * wa[gg].y); w.y = cvt_pk_bf16(bflo(v.y) * rs * wa[gg].z, bfhi(v.y) * rs * wa[gg].w);
            w.z = cvt_pk_bf16(bflo(v.z) * rs * wb[gg].x, bfhi(v.z) * rs * wb[gg].y); w.w = cvt_pk_bf16(bflo(v.w) * rs * wb[gg].z, bfhi(v.w) * rs * wb[gg].w);
            *(u32x4*)(rp + COL_Z + gg * 512 + lane * 8) = w; }
    }
}

#define GAS __attribute__((address_space(1)))
#define XB_TMO      128
#define XB_XCNT(j)  (256  + 64 * (j))
#define XB_XSUB(j)  (1280 + 64 * (j))
#define XB_XGEN(j)  (2304 + 64 * (j))
#define XB_TOP      3328
#define XB_TOPGEN   3392
#define XCD_BAR_WORDS 3456
#define XB_SPIN_CAP (1u << 18)

__device__ __forceinline__ unsigned xb_ld(unsigned* p)              { return __hip_atomic_load(p, __ATOMIC_RELAXED, __HIP_MEMORY_SCOPE_AGENT); }
__device__ __forceinline__ unsigned xb_add(unsigned* p, unsigned v) { return __hip_atomic_fetch_add(p, v, __ATOMIC_RELAXED, __HIP_MEMORY_SCOPE_AGENT); }
__device__ __forceinline__ unsigned xb_xcc_id() { return (unsigned)__builtin_amdgcn_s_getreg((3 << 11) | 20) & 0xFu; }
#define XB_SPIN(cond, bar) do { unsigned _sp = 0; while (cond) { __builtin_amdgcn_s_sleep(1); \
    if ((++_sp & 255u) == 0u) { if (xb_ld(&(bar)[XB_TMO])) break; if (_sp > XB_SPIN_CAP) { atomicAdd(&(bar)[XB_TMO], 1u); break; } } } } while (0)

struct XcdBarrier {
    unsigned* bar; unsigned x; int w0;
    volatile LAS unsigned* st;
};

__device__ __forceinline__ XcdBarrier xcd_barrier_post(unsigned* bar, volatile LAS unsigned* st, int tid0_, int wv_) {
    XcdBarrier b; b.bar = bar; b.x = xb_xcc_id(); b.st = st; b.w0 = wv_;
    if (tid0_ == 0) (void)xb_add(&bar[XB_XCNT(b.x)], 1u);
    return b;
}
__device__ __forceinline__ void xcd_barrier_complete(unsigned* bar, unsigned x, unsigned& nloc, unsigned& nx) {
    const unsigned G = gridDim.x * gridDim.y * gridDim.z;
    unsigned sum, cnt, mine, sp = 0u;
    for (;;) {
        sum = 0u; cnt = 0u; mine = 0u;
#pragma unroll
        for (unsigned j = 0; j < 16; ++j) { const unsigned c = xb_ld(&bar[XB_XCNT(j)]); sum += c; cnt += (c > 0u) ? 1u : 0u; mine = (j == x) ? c : mine; }
        if (sum == G) break;
        __builtin_amdgcn_s_sleep(1);
        if ((++sp & 255u) == 0u) { if (xb_ld(&bar[XB_TMO])) break; if (sp > XB_SPIN_CAP) { atomicAdd(&bar[XB_TMO], 1u); break; } }
    }
    nloc = mine > 0u ? mine : 1u; nx = cnt > 0u ? cnt : 1u;
}

__device__ __forceinline__ void xcd_barrier(const XcdBarrier& b) {
    asm volatile("s_waitcnt vmcnt(0)" ::: "memory");
    __syncthreads();
    if (b.w0 == 0 && pg8::lane_id_mbcnt() == 0) {
        unsigned* bar = b.bar; asm volatile("" : "+s"(bar));
        __builtin_amdgcn_s_waitcnt(0);
        unsigned nloc = b.st[0], nx = b.st[1];
        if (nloc == 0u) { xcd_barrier_complete(bar, b.x, nloc, nx); b.st[0] = nloc; b.st[1] = nx; }
        const unsigned old = xb_add(&bar[XB_XSUB(b.x)], 1u);
        const unsigned gen = old / nloc;
        if (old + 1u == (gen + 1u) * nloc) {
            __builtin_amdgcn_fence(__ATOMIC_RELEASE, "agent");
            asm volatile("s_waitcnt vmcnt(0)" ::: "memory");
            const unsigned og = xb_add(&bar[XB_TOP], 1u);
            const unsigned tg = og / nx;
            if (og + 1u == (tg + 1u) * nx) xb_add(&bar[XB_TOPGEN], 1u);
            else XB_SPIN(xb_ld(&bar[XB_TOPGEN]) == tg, bar);
            __builtin_amdgcn_fence(__ATOMIC_ACQUIRE, "agent");
            xb_add(&bar[XB_XGEN(b.x)], 1u);
            asm volatile("s_waitcnt vmcnt(0)" ::: "memory");
        } else {
            XB_SPIN(xb_ld(&bar[XB_XGEN(b.x)]) == gen, bar);
            __builtin_amdgcn_fence(__ATOMIC_ACQUIRE, "agent");
            asm volatile("s_waitcnt vmcnt(0)" ::: "memory");
        }
    }
    __syncthreads();
}

#ifndef PROBE_MODE
#define PROBE_MODE 0
#endif
#ifndef PROBE_VAR
#define PROBE_VAR 0
#endif
#ifndef MK_SINGLE
#define MK_SINGLE 1
#endif
__global__ void __launch_bounds__(512, 2) fwd_kernel(Args a) {
    extern __shared__ __attribute__((aligned(16))) unsigned char lds_raw[];
    LAS unsigned char* lds = (LAS unsigned char*)lds_raw;
    cg::grid_group grid = cg::this_grid();
    const int bx = blockIdx.x, G = gridDim.x, NGW = G * 8;
    const int tid0 = threadIdx.x;
    const int wv_s = __builtin_amdgcn_readfirstlane(tid0 >> 6);
    const int lo = a.ph_lo, hi = a.ph_hi;
    volatile LAS unsigned* MISC = (volatile LAS unsigned*)(lds + LDS_BYTES - 64);
    if (tid0 < 16) MISC[tid0] = 0u;
    __syncthreads();
    const XcdBarrier xbar = xcd_barrier_post((unsigned*)(a.ws + WS_CTL), MISC, tid0, wv_s);
#define PH_IDS int tid = wv_s * 64 + pg8::lane_id_mbcnt(); asm volatile("" : "+v"(tid)); const int lane = tid & 63, wave = __builtin_amdgcn_readfirstlane(tid >> 6), gw = bx * 8 + wave; (void)lane; (void)gw
    float* out = a.out;
#define PH_PTRS unsigned char* ws = a.ws; asm volatile("" : "+s"(ws)); float* MOD = (float*)(ws + WS_MOD); float* LSE = (float*)(ws + WS_LSE); float* DT = (float*)(ws + WS_DT); \
    bf16_t* H = (bf16_t*)(ws + WS_H); bf16_t* P = (bf16_t*)(ws + WS_PROJ); bf16_t* XB = (bf16_t*)(ws + WS_XB); (void)XB; const float* mod = MOD + (size_t)l * 4 * 12288; unsigned char* wb = ws + WS_W + (size_t)l * WL_BYTES; \
    (void)LSE; (void)DT; (void)H; (void)P; (void)mod; (void)wb
#define IN(k) (lo <= (k) && (k) < hi)
#define SEAM(k) do { if (IN(k) && IN((k) + 1)) xcd_barrier(xbar); } while (0)
    if (lo < -1000) grid.sync();
    const bool side = false;
    if (IN(0)) { PH_IDS; phase_prep(a, lds, tid, lane, wave, bx, G, side ? 1 : 2); }
    SEAM(0);
#if PROBE_MODE == 5
    if (IN(0) && IN(1)) { { PH_IDS; phase_prep(a, lds, tid, lane, wave, bx, G, 2); } xcd_barrier(xbar); }
#endif
#pragma unroll 1
    for (int l = 0; l < 2; ++l) {
        const int pb = 1 + 10 * l;
        if (IN(pb + 0)) { PH_PTRS; PH_IDS; if (l == 0) phase_norm<false>(a.in[0], a.in[3] + l * 2048, mod + 2048, mod, H, nullptr, lane, gw, NGW); else phase_norm_b<false>(XB, a.in[3] + l * 2048, mod + 2048, mod, H, nullptr, lane, gw, NGW); }
        SEAM(pb + 0);
        if (IN(pb + 1)) { PH_PTRS; pg8::Gemm g{H, (const bf16_t*)(wb + WO_IN), M_TOK, NPROJ, 2048, 2048}; pg8::StaticOrder S; S.init(M_TOK, NPROJ, G, bx);
            pg8::EpiProj E{P, DT}; pg8::gemm_phase<pg8::EpiProj, pg8::StaticOrder, true, true>(lds, g, S, E, wv_s); }
        SEAM(pb + 1);
        if (IN(pb + 2)) { PH_PTRS; PH_IDS;
            phase_attn(P, LSE, a.in[2], lds, bx, G, tid);
            phase_convbc(P, H, a.in[8] + (size_t)l * 4 * 6144, a.in[9] + (size_t)l * 6144, tid, bx, G);
        }
        SEAM(pb + 2);
        if (IN(pb + 3)) { PH_PTRS; PH_IDS;
            for (int u = bx; u < 256; u += G) {
                const int xcd = u & 7, slot = u >> 3, gb = xcd * 4 + (slot >> 3), b = gb >> 3, hd = (gb & 7) * 8 + (slot & 7);
                if (l == 0 && side) ssd_unit<0, true>(P, H, DT, a.in[8] + (size_t)l * 4 * 6144, a.in[9] + (size_t)l * 6144, a.in[10][l * 64 + hd], -expf(a.in[11][l * 64 + hd]), a.in[12][l * 64 + hd], lds, b, hd, tid, lane, wave, a, gw, NGW);
                else ssd_unit<0, false>(P, H, DT, a.in[8] + (size_t)l * 4 * 6144, a.in[9] + (size_t)l * 6144, a.in[10][l * 64 + hd], -expf(a.in[11][l * 64 + hd]), a.in[12][l * 64 + hd], lds, b, hd, tid, lane, wave, a, gw, NGW); }
            phase_attn_merge(P, LSE, lane, gw, NGW);
        }
        SEAM(pb + 3);
        if (IN(pb + 4)) { PH_PTRS; PH_IDS; phase_merge(P, LSE, a.in[13] + (size_t)l * 4096, lane, gw, NGW); }
        SEAM(pb + 4);
        if (IN(pb + 5)) { PH_PTRS;
            { pg8::Gemm g{P + COL_Q, (const bf16_t*)(wb + WO_A), M_TOK, 2048, 512, NPROJ}; pg8::StaticOrder S; S.init(M_TOK, 2048, G, bx);
              pg8::EpiGate<0> E{H, 2048, P + COL_GA, NPROJ}; pg8::gemm_phase<pg8::EpiGate<0>, pg8::StaticOrder, true, true>(lds, g, S, E, wv_s); }
            { pg8::Gemm g{P + COL_Z, (const bf16_t*)(wb + WO_S), M_TOK, 2048, 4096, NPROJ}; pg8::StaticOrder S; S.init(M_TOK, 2048, G, bx);
              pg8::EpiGate<1> E{H, 2048, P + COL_GS, NPROJ}; pg8::gemm_phase<pg8::EpiGate<1>, pg8::StaticOrder, true, true>(lds, g, S, E, wv_s); }
        }
        SEAM(pb + 5);
#if PROBE_MODE > 0
        if (IN(pb + 5) && IN(pb + 6)) { PH_IDS;
#if PROBE_MODE == 1
            phase_attn(P, LSE, a.in[2], lds, bx, G, tid);
#elif PROBE_MODE == 2
            for (int u = bx; u < 256; u += G) {
                const int xcd = u & 7, slot = u >> 3, gb = xcd * 4 + (slot >> 3), b = gb >> 3, hd = (gb & 7) * 8 + (slot & 7);
                ssd_unit<PROBE_VAR, false>(P, H, DT, a.in[8] + (size_t)l * 4 * 6144, a.in[9] + (size_t)l * 6144, a.in[10][l * 64 + hd], -expf(a.in[11][l * 64 + hd]), a.in[12][l * 64 + hd], lds, b, hd, tid, lane, wave, a, gw, NGW); }
#elif PROBE_MODE == 3
            phase_merge(P, LSE, a.in[13] + (size_t)l * 4096, lane, gw, NGW);
#elif PROBE_MODE == 4
            phase_convbc(P, P + (size_t)200000000, a.in[8] + (size_t)l * 4 * 6144, a.in[9] + (size_t)l * 6144, tid, bx, G);
#endif
            grid.sync(); }
#endif
        if (IN(pb + 6)) { PH_PTRS; pg8::Gemm g{H, (const bf16_t*)(wb + WO_O), M_TOK, 2048, 2048, 2048}; pg8::StaticOrder S; S.init(M_TOK, 2048, G, bx);
            pg8::EpiRes2 E{l == 0 ? a.in[0] : nullptr, XB, XB, mod + 4096, 12288}; pg8::gemm_phase<pg8::EpiRes2, pg8::StaticOrder, true, true>(lds, g, S, E, wv_s); }
        SEAM(pb + 6);
        if (IN(pb + 7)) { PH_PTRS; PH_IDS; phase_norm_b<false>(XB, a.in[4] + l * 2048, mod + 8192, mod + 6144, H, nullptr, lane, gw, NGW); }
        SEAM(pb + 7);
        if (IN(pb + 8)) { PH_PTRS; pg8::Gemm g{H, (const bf16_t*)(wb + WO_FI), M_TOK, 2 * D_FF, 2048, 2048}; pg8::StaticOrder S; S.init(M_TOK, 2 * D_FF, G, bx);
            pg8::EpiSwiglu E{P, D_FF}; pg8::gemm_phase<pg8::EpiSwiglu, pg8::StaticOrder, true, true>(lds, g, S, E, wv_s); }
        SEAM(pb + 8);
        if (IN(pb + 9)) { PH_PTRS; pg8::Gemm g{P, (const bf16_t*)(wb + WO_FO), M_TOK, 2048, D_FF, D_FF}; pg8::StaticOrder S; S.init(M_TOK, 2048, G, bx);
            pg8::EpiRes2 E{nullptr, XB, XB, mod + 10240, 12288}; pg8::gemm_phase<pg8::EpiRes2, pg8::StaticOrder, true, true>(lds, g, S, E, wv_s); }
        SEAM(pb + 9);
    }
#if PROBE_MODE == 7
    if (IN(20) && IN(21)) { for (int i = 0; i < 20; ++i) grid.sync(); }
#endif
    if (IN(21)) { PH_IDS; const bf16_t* XBf = (const bf16_t*)(a.ws + WS_XB); phase_norm_b<true>(XBf, a.in[19], nullptr, nullptr, nullptr, out, lane, gw, NGW); }
#undef IN
#undef SEAM
}

extern "C" void kernel_launch(void* const* d_in, const int* in_sizes, int n_in, void* d_out, int out_size, void* d_ws, size_t ws_size, hipStream_t stream) {
    static int grid = 0;
    if (grid == 0) {
        if (n_in != 20 || out_size != M_TOK * D_MODEL || ws_size < WS_END + MiB) { fprintf(stderr, "kernel_launch: unexpected shapes (n_in %d out %d ws %zu need %zu)\n", n_in, out_size, ws_size, (size_t)WS_END); grid = -1; return; }
        int dev = 0, cus = 0, per_cu = 0;
        (void)hipGetDevice(&dev); (void)hipDeviceGetAttribute(&cus, hipDeviceAttributeMultiprocessorCount, dev);
        if (hipFuncSetAttribute((const void*)fwd_kernel, hipFuncAttributeMaxDynamicSharedMemorySize, LDS_BYTES) != hipSuccess) { fprintf(stderr, "kernel_launch: hipFuncSetAttribute failed\n"); grid = -1; return; }
        if (hipOccupancyMaxActiveBlocksPerMultiprocessor(&per_cu, (const void*)fwd_kernel, 512, LDS_BYTES) != hipSuccess || per_cu < 1) { fprintf(stderr, "kernel_launch: occupancy query gave %d\n", per_cu); per_cu = 1; }
        (void)hipGetLastError();
        grid = cus * 1;
        if (grid <= 0) grid = 256;
    }
    if (grid < 0) return;
    (void)hipMemsetAsync((char*)d_ws + WS_CTL, 0, 16384, stream);
    Args a{};
    for (int i = 0; i < 20; ++i) a.in[i] = (const float*)d_in[i];
    a.out = (float*)d_out; a.ws = (unsigned char*)d_ws;
    void* args[] = {&a};
#if MK_SINGLE
    a.ph_lo = 0; a.ph_hi = NPHASE;
    hipError_t e = hipLaunchCooperativeKernel((const void*)fwd_kernel, dim3(grid), dim3(512), args, LDS_BYTES, stream);
    if (e != hipSuccess) fprintf(stderr, "cooperative launch failed: %s (grid %d)\n", hipGetErrorString(e), grid);
#else
    for (int ph = 0; ph < NPHASE; ++ph) { a.ph_lo = ph; a.ph_hi = ph + 1;
        hipError_t e = hipLaunchCooperativeKernel((const void*)fwd_kernel, dim3(grid), dim3(512), args, LDS_BYTES, stream);
        if (e != hipSuccess) { fprintf(stderr, "cooperative launch %d failed: %s (grid %d)\n", ph, hipGetErrorString(e), grid); break; } }
#endif
}
```

```cpp
#include <hip/hip_runtime.h>
#include <hip/hip_cooperative_groups.h>
#include <cstdio>
#include <cstdint>
#include <cmath>
namespace cg = cooperative_groups;
namespace pg8 {
#define PG8_LAS __attribute__((address_space(3)))
typedef unsigned short bf16_t;
typedef short bf16x8 __attribute__((ext_vector_type(8)));
typedef float f32x4 __attribute__((ext_vector_type(4)));
typedef unsigned u32x4 __attribute__((ext_vector_type(4)));
__device__ __forceinline__ int lane_id_mbcnt() { int l; asm volatile("v_mbcnt_lo_u32_b32 %0, -1, 0\n\tv_mbcnt_hi_u32_b32 %0, -1, %0" : "=v"(l)); return l; }
constexpr int BM = 256, BK = 64, HALF = 128, HTB = HALF * BK * 2  , STAGE_BYTES = 8 * HTB, NXCD = 8, WGM = 8;

__host__ __device__ __forceinline__ int lds_byte(int r, int c) { const int st = (r >> 4) * 2 + (c >> 5), rr = r & 15, cc = c & 31, ob = rr * 64 + cc * 2; return st * 1024 + (ob ^ (((ob >> 9) & 1) << 5)); }
__host__ __device__ __forceinline__ void stage_rc(int b, int& R, int& C) { const int st = b / 1024, sb = b % 1024, swz = sb ^ (((sb >> 9) & 1) << 5); R = (st >> 1) * 16 + swz / 64; C = (st & 1) * 32 + (swz % 64) / 2; }
__host__ __device__ __forceinline__ int perm32(int rho) { const int n = rho >> 4, i = rho & 15; return 8 * (i >> 2) + 4 * n + (i & 3); }

struct Unit { int pm, pn; };
struct Gemm { const bf16_t* A; const bf16_t* Bt; int M, N, K, lda; };

struct StaticOrder {
    int nM, nN, nwg, G, c;
    __host__ __device__ void init(int M, int N, int G_, int c_) { nM = M / BM; nN = N / BM; nwg = nM * nN; G = G_; c = c_; }
    __host__ __device__ bool next(int i, Unit& u) const {
        const long L = (long)i * G + c; if (L >= nwg) return false;
        int wgid = (int)L; { const int q = nwg / NXCD, r = nwg % NXCD, xcd = wgid % NXCD, off = wgid / NXCD; wgid = (xcd < r ? xcd * (q + 1) : r * (q + 1) + (xcd - r) * q) + off; }
        const int nig = WGM * nN, gid = wgid / nig, fm = gid * WGM, gsz = (nM - fm) < WGM ? (nM - fm) : WGM;
        u.pm = fm + ((wgid % nig) % gsz); u.pn = (wgid % nig) / gsz; return true;
    }
    __device__ __forceinline__ void a_ready(const Unit&) const {}
    __device__ __forceinline__ void done(const Unit&) const {}
};

__device__ __forceinline__ unsigned cvt_pk_bf16(float lo, float hi) { unsigned r; asm volatile("v_cvt_pk_bf16_f32 %0, %1, %2" : "=v"(r) : "v"(lo), "v"(hi)); return r; }
__device__ __forceinline__ float bflo(unsigned u) { return __uint_as_float(u << 16); }
__device__ __forceinline__ float bfhi(unsigned u) { return __uint_as_float(u & 0xffff0000u); }
__device__ __forceinline__ float sigmoidf_(float x) { return __builtin_amdgcn_rcpf(1.f + __expf(-x)); }
__device__ __forceinline__ float siluf_(float x) { return x * __builtin_amdgcn_rcpf(1.f + __expf(-x)); }

constexpr int NPROJ = 19200;
struct EpiProj {
    static constexpr bool PERM = true, AFTER_DRAIN = false;
    bf16_t* O; float* DT;
    __device__ __forceinline__ void operator()(const f32x4 (&acc)[2][2][4][2], const Unit& u, int wr, int wc, int fr, int fq) const {
        const int row0 = u.pm * BM + wr * 64 + fr;
        if (u.pn == 74) {
            if (wc < 2) {
#pragma unroll
                for (int ai = 0; ai < 2; ++ai)
#pragma unroll
                    for (int m = 0; m < 4; ++m) { float* p = DT + (size_t)(row0 + ai * HALF + m * 16) * 64 + wc * 32 + 8 * fq;
                        *(f32x4*)p = acc[ai][0][m][0]; *(f32x4*)(p + 4) = acc[ai][0][m][1]; }
            }
            return;
        }
        const bool sg = u.pn >= 58, zs = u.pn >= 18 && u.pn < 34;
        const int col0 = u.pn * BM + wc * 32 + 8 * fq;
#pragma unroll
        for (int ai = 0; ai < 2; ++ai)
#pragma unroll
            for (int m = 0; m < 4; ++m) { bf16_t* rowp = O + (size_t)(row0 + ai * HALF + m * 16) * NPROJ + col0;
#pragma unroll
                for (int bj = 0; bj < 2; ++bj) { f32x4 v0 = acc[ai][bj][m][0], v1 = acc[ai][bj][m][1];
                    if (sg || zs) { f32x4 t0, t1;
#pragma unroll
                        for (int j = 0; j < 4; ++j) { t0[j] = __expf(-v0[j]); t1[j] = __expf(-v1[j]); }
#pragma unroll
                        for (int j = 0; j < 4; ++j) { t0[j] = __builtin_amdgcn_rcpf(1.f + t0[j]); t1[j] = __builtin_amdgcn_rcpf(1.f + t1[j]); }
                        if (sg) { v0 = t0; v1 = t1; } else { v0 = v0 * t0; v1 = v1 * t1; } }
                    u32x4 w; w.x = cvt_pk_bf16(v0[0], v0[1]); w.y = cvt_pk_bf16(v0[2], v0[3]); w.z = cvt_pk_bf16(v1[0], v1[1]); w.w = cvt_pk_bf16(v1[2], v1[3]);
                    *(u32x4*)(rowp + bj * HALF) = w; } }
    }
};
template <int MODE> struct EpiGate {
    static constexpr bool PERM = true, AFTER_DRAIN = false;
    bf16_t* O; int ldc; const bf16_t* G; int ldg;
    __device__ __forceinline__ void operator()(const f32x4 (&acc)[2][2][4][2], const Unit& u, int wr, int wc, int fr, int fq) const {
        const int row0 = u.pm * BM + wr * 64 + fr; const int col0 = u.pn * BM + wc * 32 + 8 * fq;
#pragma unroll
        for (int ai = 0; ai < 2; ++ai)
#pragma unroll
            for (int m = 0; m < 4; ++m) { const size_t row = (size_t)(row0 + ai * HALF + m * 16);
#pragma unroll
                for (int bj = 0; bj < 2; ++bj) { const int col = col0 + bj * HALF;
                    const u32x4 gv = *(const u32x4*)(G + row * ldg + col);
                    f32x4 v0 = acc[ai][bj][m][0], v1 = acc[ai][bj][m][1];
                    v0[0] *= bflo(gv.x); v0[1] *= bfhi(gv.x); v0[2] *= bflo(gv.y); v0[3] *= bfhi(gv.y);
                    v1[0] *= bflo(gv.z); v1[1] *= bfhi(gv.z); v1[2] *= bflo(gv.w); v1[3] *= bfhi(gv.w);
                    bf16_t* op = O + row * ldc + col;
                    if (MODE == 1) { const u32x4 ov = *(const u32x4*)op;
                        v0[0] += bflo(ov.x); v0[1] += bfhi(ov.x); v0[2] += bflo(ov.y); v0[3] += bfhi(ov.y);
                        v1[0] += bflo(ov.z); v1[1] += bfhi(ov.z); v1[2] += bflo(ov.w); v1[3] += bfhi(ov.w); }
                    u32x4 w; w.x = cvt_pk_bf16(v0[0], v0[1]); w.y = cvt_pk_bf16(v0[2], v0[3]); w.z = cvt_pk_bf16(v1[0], v1[1]); w.w = cvt_pk_bf16(v1[2], v1[3]);
                    *(u32x4*)op = w; } }
    }
};
struct EpiRes {
    static constexpr bool PERM = false, AFTER_DRAIN = false;
    const float* xin; float* out; const float* gate; int gstride;
    __device__ __forceinline__ void operator()(const f32x4 (&acc)[2][2][4][2], const Unit& u, int wr, int wc, int fr, int fq) const {
        const int row0 = u.pm * BM + wr * 64 + fr; const int col0 = u.pn * BM + wc * 32 + 4 * fq;
        const float* gp = gate + (size_t)(u.pm >> 4) * gstride + col0;
        f32x4 gv[2][2];
#pragma unroll
        for (int bj = 0; bj < 2; ++bj)
#pragma unroll
            for (int n = 0; n < 2; ++n) gv[bj][n] = *(const f32x4*)(gp + bj * HALF + n * 16);
#pragma unroll
        for (int ai = 0; ai < 2; ++ai)
#pragma unroll
            for (int m = 0; m < 4; ++m) { const size_t off = (size_t)(row0 + ai * HALF + m * 16) * 2048 + col0;
#pragma unroll
                for (int bj = 0; bj < 2; ++bj)
#pragma unroll
                    for (int n = 0; n < 2; ++n) { const f32x4 xv = *(const f32x4*)(xin + off + bj * HALF + n * 16);
                        *(f32x4*)(out + off + bj * HALF + n * 16) = xv + gv[bj][n] * acc[ai][bj][m][n]; } }
    }
};
struct EpiRes2 {
    static constexpr bool PERM = true, AFTER_DRAIN = false;
    const float* xin_f; const bf16_t* xin_b; bf16_t* out; const float* gate; int gstride;
    __device__ __forceinline__ void operator()(const f32x4 (&acc)[2][2][4][2], const Unit& u, int wr, int wc, int fr, int fq) const {
        const int row0 = u.pm * BM + wr * 64 + fr; const int col0 = u.pn * BM + wc * 32 + 8 * fq;
        const float* gp = gate + (size_t)(u.pm >> 4) * gstride + col0;
        f32x4 g0[2], g1[2];
#pragma unroll
        for (int bj = 0; bj < 2; ++bj) { g0[bj] = *(const f32x4*)(gp + bj * HALF); g1[bj] = *(const f32x4*)(gp + bj * HALF + 4); }
#pragma unroll
        for (int ai = 0; ai < 2; ++ai)
#pragma unroll
            for (int m = 0; m < 4; ++m) { const size_t off = (size_t)(row0 + ai * HALF + m * 16) * 2048 + col0;
#pragma unroll
                for (int bj = 0; bj < 2; ++bj) { f32x4 x0, x1;
                    if (xin_f) { x0 = *(const f32x4*)(xin_f + off + bj * HALF); x1 = *(const f32x4*)(xin_f + off + bj * HALF + 4); }
                    else { const u32x4 xv = *(const u32x4*)(xin_b + off + bj * HALF);
                        x0 = (f32x4){bflo(xv.x), bfhi(xv.x), bflo(xv.y), bfhi(xv.y)}; x1 = (f32x4){bflo(xv.z), bfhi(xv.z), bflo(xv.w), bfhi(xv.w)}; }
                    const f32x4 v0 = x0 + g0[bj] * acc[ai][bj][m][0], v1 = x1 + g1[bj] * acc[ai][bj][m][1];
                    u32x4 w; w.x = cvt_pk_bf16(v0[0], v0[1]); w.y = cvt_pk_bf16(v0[2], v0[3]); w.z = cvt_pk_bf16(v1[0], v1[1]); w.w = cvt_pk_bf16(v1[2], v1[3]);
                    *(u32x4*)(out + off + bj * HALF) = w; } }
    }
};
struct EpiSwiglu {
    static constexpr bool PERM = true, AFTER_DRAIN = false;
    bf16_t* O; int ldc;
    __device__ __forceinline__ void operator()(const f32x4 (&acc)[2][2][4][2], const Unit& u, int wr, int wc, int fr, int fq) const {
        const int row0 = u.pm * BM + wr * 64 + fr; const int col0 = u.pn * HALF + wc * 32 + 8 * fq;
#pragma unroll
        for (int ai = 0; ai < 2; ++ai)
#pragma unroll
            for (int m = 0; m < 4; ++m) { bf16_t* op = O + (size_t)(row0 + ai * HALF + m * 16) * ldc + col0;
                f32x4 v0, v1;
#pragma unroll
                for (int j = 0; j < 4; ++j) { v0[j] = siluf_(acc[ai][0][m][0][j]) * acc[ai][1][m][0][j]; v1[j] = siluf_(acc[ai][0][m][1][j]) * acc[ai][1][m][1][j]; }
                u32x4 w; w.x = cvt_pk_bf16(v0[0], v0[1]); w.y = cvt_pk_bf16(v0[2], v0[3]); w.z = cvt_pk_bf16(v1[0], v1[1]); w.w = cvt_pk_bf16(v1[2], v1[3]);
                *(u32x4*)op = w; }
    }
};

template <class Epi, class Sched, bool ALIGN_EPI = false, bool SP2 = false>
__device__ __forceinline__ void gemm_phase(PG8_LAS unsigned char* lds, const Gemm g, const Sched& S, const Epi& E, int wave_s) {
    int tid = wave_s * 64 + lane_id_mbcnt(); asm volatile("" : "+v"(tid));        const int wid = __builtin_amdgcn_readfirstlane(tid >> 6), lane = tid & 63, wr = wid >> 2, wc = wid & 3, fr = lane & 15, fq = lane >> 4;
    const int K = g.K, nt = K / BK;
    unsigned voffA[2], voffB[2];
#pragma unroll
    for (int i = 0; i < 2; ++i) { int R, C; stage_rc(tid * 16 + i * 8192, R, C); const int Rb = Epi::PERM ? ((R & ~31) + perm32(R & 31)) : R;
        voffA[i] = (unsigned)(R * g.lda + C) * 2u; voffB[i] = (unsigned)(Rb * K + C) * 2u; }
    const size_t kstep = (size_t)(BK * 2);
    const size_t hstepA = (size_t)HALF * g.lda * 2, hstepB = (size_t)HALF * K * 2;
    const size_t tstepA = 2 * hstepA, tstepB = 2 * hstepB;
    const unsigned ldsw = (unsigned)wid * 1024u;
    const int aoff = lds_byte(wr * 64 + fr, fq * 8), boff = lds_byte(wc * 32 + fr, fq * 8);
#define PG8_SA(b, h) (((b) * 2 + (h)) * HTB)
#define PG8_SB(b, h) ((4 + (b) * 2 + (h)) * HTB)
#define PG8_STAGE(bufoff, gbase, voff) do { _Pragma("unroll") for (int _i = 0; _i < 2; ++_i) \
        __builtin_amdgcn_global_load_lds((const unsigned*)((const char*)(gbase) + (voff)[_i]), (PG8_LAS unsigned*)(lds + (bufoff) + ldsw + _i * 8192), 16, 0, 0); } while (0)
#define PG8_LDA(dst, b, h) do { _Pragma("unroll") for (int m = 0; m < 4; ++m) _Pragma("unroll") for (int k = 0; k < 2; ++k) dst[m][k] = *(const PG8_LAS bf16x8*)(lds + PG8_SA(b, h) + aoff + m * 2048 + k * 1024); } while (0)
#define PG8_LDB(dst, b, h) do { _Pragma("unroll") for (int n = 0; n < 2; ++n) _Pragma("unroll") for (int k = 0; k < 2; ++k) dst[n][k] = *(const PG8_LAS bf16x8*)(lds + PG8_SB(b, h) + boff + n * 2048 + k * 1024); } while (0)
#define PG8_MMA(ai, bj, At, Bt) do { __builtin_amdgcn_s_setprio(1); _Pragma("unroll") for (int m = 0; m < 4; ++m) _Pragma("unroll") for (int n = 0; n < 2; ++n) _Pragma("unroll") for (int k = 0; k < 2; ++k) \
        acc[ai][bj][m][n] = __builtin_amdgcn_mfma_f32_16x16x32_bf16(Bt[n][k], At[m][k], acc[ai][bj][m][n], 0, 0, 0); __builtin_amdgcn_s_setprio(0); } while (0)
#define PG8_WAIT_V(n) asm volatile("s_waitcnt vmcnt(" #n ")" ::: "memory")
#define PG8_WAIT_L(n) asm volatile("s_waitcnt lgkmcnt(" #n ")" ::: "memory")
#define PG8_BAR __builtin_amdgcn_s_barrier()
#define PG8_SCHED __builtin_amdgcn_sched_barrier(0)
    Unit cur, nxt; int ui = 0;
    if (!S.next(0, cur)) return;
    f32x4 acc[2][2][4][2];
#pragma unroll
    for (int a = 0; a < 2; ++a)
#pragma unroll
        for (int b = 0; b < 2; ++b)
#pragma unroll
            for (int m = 0; m < 4; ++m)
#pragma unroll
                for (int n = 0; n < 2; ++n) acc[a][b][m][n] = (f32x4){0.f, 0.f, 0.f, 0.f};
    bf16x8 At[4][2], B0[2][2], B1[2][2];
    const char* cA = (const char*)g.A + (size_t)cur.pm * tstepA; const char* cB = (const char*)g.Bt + (size_t)cur.pn * tstepB;
    S.a_ready(cur);
    if constexpr (SP2) {
        PG8_STAGE(PG8_SB(0, 0), cB, voffB); PG8_STAGE(PG8_SB(0, 1), cB + hstepB, voffB); PG8_STAGE(PG8_SA(0, 0), cA, voffA); PG8_STAGE(PG8_SA(0, 1), cA + hstepA, voffA);
        if (wr == 1) PG8_BAR;
        PG8_WAIT_V(2); PG8_BAR;
        PG8_STAGE(PG8_SB(1, 0), cB + kstep, voffB); PG8_STAGE(PG8_SA(1, 0), cA + kstep, voffA); PG8_STAGE(PG8_SB(1, 1), cB + hstepB + kstep, voffB);
        PG8_WAIT_V(6); PG8_BAR;
    } else {
        PG8_STAGE(PG8_SB(0, 0), cB, voffB); PG8_STAGE(PG8_SA(0, 0), cA, voffA); PG8_STAGE(PG8_SB(0, 1), cB + hstepB, voffB); PG8_STAGE(PG8_SA(0, 1), cA + hstepA, voffA);
        if (wr == 1) PG8_BAR;
        PG8_WAIT_V(4); PG8_BAR;
        PG8_STAGE(PG8_SB(1, 0), cB + kstep, voffB); PG8_STAGE(PG8_SA(1, 0), cA + kstep, voffA); PG8_STAGE(PG8_SB(1, 1), cB + hstepB + kstep, voffB);
        PG8_WAIT_V(6); PG8_BAR;
    }
    for (;;) {
        const bool has_next = S.next(ui + 1, nxt);
        const char* nA = has_next ? (const char*)g.A + (size_t)nxt.pm * tstepA : cA; const char* nB = has_next ? (const char*)g.Bt + (size_t)nxt.pn * tstepB : cB;
        for (int t = 0; t < nt; t += 2) {
            const bool last = (t == nt - 2);
            const char* a1 = cA + (size_t)(t + 1) * kstep;
            const char* a2 = last ? nA : cA + (size_t)(t + 2) * kstep; const char* b2 = last ? nB : cB + (size_t)(t + 2) * kstep;
            const char* a3 = a2 + kstep; const char* b3 = b2 + kstep;
            if (last && has_next) S.a_ready(nxt);
            if constexpr (SP2) {
            PG8_LDB(B0, 0, 0); PG8_LDB(B1, 0, 1); PG8_SCHED; PG8_LDA(At, 0, 0); PG8_STAGE(PG8_SA(1, 1), a1 + hstepA, voffA);
            PG8_WAIT_V(8); PG8_WAIT_L(0); PG8_BAR; PG8_MMA(0, 0, At, B0); PG8_MMA(0, 1, At, B1); PG8_BAR; PG8_SCHED;
            PG8_LDA(At, 0, 1); PG8_STAGE(PG8_SB(0, 0), b2, voffB); PG8_STAGE(PG8_SB(0, 1), b2 + hstepB, voffB); PG8_STAGE(PG8_SA(0, 0), a2, voffA);
            PG8_WAIT_V(8); PG8_WAIT_L(0); PG8_BAR; PG8_MMA(1, 0, At, B0); PG8_MMA(1, 1, At, B1); PG8_BAR; PG8_SCHED;
            PG8_LDB(B0, 1, 0); PG8_LDB(B1, 1, 1); PG8_SCHED; PG8_LDA(At, 1, 0); PG8_STAGE(PG8_SA(0, 1), a2 + hstepA, voffA);
            PG8_WAIT_V(8); PG8_WAIT_L(0); PG8_BAR; PG8_MMA(0, 0, At, B0); PG8_MMA(0, 1, At, B1); PG8_BAR; PG8_SCHED;
            PG8_LDA(At, 1, 1); PG8_STAGE(PG8_SB(1, 0), b3, voffB); PG8_STAGE(PG8_SB(1, 1), b3 + hstepB, voffB); PG8_STAGE(PG8_SA(1, 0), a3, voffA);
            PG8_WAIT_V(8); PG8_WAIT_L(0); PG8_BAR; PG8_MMA(1, 0, At, B0); PG8_MMA(1, 1, At, B1); PG8_BAR; PG8_SCHED;
            } else {
            PG8_LDB(B0, 0, 0); PG8_SCHED; PG8_LDA(At, 0, 0); PG8_STAGE(PG8_SA(1, 1), a1 + hstepA, voffA);
            PG8_WAIT_L(8); PG8_BAR; PG8_WAIT_L(0); PG8_MMA(0, 0, At, B0); PG8_BAR; PG8_SCHED;
            PG8_LDB(B1, 0, 1); PG8_STAGE(PG8_SB(0, 0), b2, voffB);
            PG8_BAR; PG8_WAIT_L(0); PG8_MMA(0, 1, At, B1); PG8_BAR;
            PG8_LDA(At, 0, 1); PG8_STAGE(PG8_SA(0, 0), a2, voffA);
            PG8_BAR; PG8_WAIT_L(0); PG8_MMA(1, 0, At, B0); PG8_BAR; PG8_SCHED;
            PG8_STAGE(PG8_SB(0, 1), b2 + hstepB, voffB);
            PG8_WAIT_V(6); PG8_BAR; PG8_MMA(1, 1, At, B1); PG8_BAR;
            PG8_LDB(B0, 1, 0); PG8_SCHED; PG8_LDA(At, 1, 0); PG8_STAGE(PG8_SA(0, 1), a2 + hstepA, voffA);
            PG8_WAIT_L(8); PG8_BAR; PG8_WAIT_L(0); PG8_MMA(0, 0, At, B0); PG8_BAR; PG8_SCHED;
            PG8_LDB(B1, 1, 1); PG8_STAGE(PG8_SB(1, 0), b3, voffB);
            PG8_BAR; PG8_WAIT_L(0); PG8_MMA(0, 1, At, B1); PG8_BAR;
            PG8_LDA(At, 1, 1); PG8_STAGE(PG8_SA(1, 0), a3, voffA);
            PG8_BAR; PG8_WAIT_L(0); PG8_MMA(1, 0, At, B0); PG8_BAR; PG8_SCHED;
            PG8_STAGE(PG8_SB(1, 1), b3 + hstepB, voffB);
            PG8_WAIT_V(6); PG8_BAR; PG8_MMA(1, 1, At, B1); PG8_BAR;
            }
        }
        if constexpr (ALIGN_EPI) { if (wr == 0) PG8_BAR; }
        if constexpr (!Epi::AFTER_DRAIN) { E(acc, cur, wr, wc, fr, fq); S.done(cur); }
        if (!has_next) break;
#pragma unroll
        for (int a = 0; a < 2; ++a)
#pragma unroll
            for (int b = 0; b < 2; ++b)
#pragma unroll
                for (int m = 0; m < 4; ++m)
#pragma unroll
                    for (int n = 0; n < 2; ++n) acc[a][b][m][n] = (f32x4){0.f, 0.f, 0.f, 0.f};
        cur = nxt; cA = nA; cB = nB; ++ui;
        if constexpr (ALIGN_EPI) { if (wr == 1) PG8_BAR; }
    }
    PG8_WAIT_V(0);
    if constexpr (!ALIGN_EPI) { if (wr == 0) PG8_BAR; }
    PG8_BAR;
    if constexpr (Epi::AFTER_DRAIN) { E.fused(acc, cur, wr, wc, fr, fq, lds, wid, lane); S.done(cur); }
#undef PG8_SA
#undef PG8_SB
#undef PG8_STAGE
#undef PG8_LDA
#undef PG8_LDB
#undef PG8_MMA
#undef PG8_WAIT_V
#undef PG8_WAIT_L
#undef PG8_BAR
#undef PG8_SCHED
}
}
#define LAS __attribute__((address_space(3)))
typedef unsigned short bf16_t;
typedef short bf16x8 __attribute__((ext_vector_type(8)));
typedef short s16x4 __attribute__((ext_vector_type(4)));
typedef float f32x4 __attribute__((ext_vector_type(4)));
typedef unsigned u32x4 __attribute__((ext_vector_type(4)));
typedef unsigned u32x2 __attribute__((ext_vector_type(2)));
using pg8::cvt_pk_bf16; using pg8::bflo; using pg8::bfhi; using pg8::siluf_;

constexpr int D_MODEL = 2048, SEQ = 4096, M_TOK = 16384;
constexpr int NPROJ = pg8::NPROJ;
constexpr int N_IN = 19008, D_FF = 5632;
constexpr int COL_Q = 0, COL_K = 1536, COL_V = 3072, COL_Z = 4608, COL_XBC = 8704, COL_GA = 14848, COL_GS = 16896;
constexpr int NPHASE = 22;

constexpr size_t MiB = 1u << 20;
constexpr size_t WS_CTL = 0, CTL_ZERO_BYTES = 1 * MiB;
constexpr size_t WS_MOD = 65536;
constexpr size_t WS_LSE = 1 * MiB;
constexpr size_t WS_DT = 2 * MiB;
constexpr size_t WS_W = 8 * MiB;
constexpr size_t WO_IN = 0, WO_A = 78643200, WO_S = 80740352, WO_O = 97517568, WO_FI = 105906176, WO_FO = 152043520, WL_BYTES = 175112192;
constexpr size_t WS_H = WS_W + 2 * WL_BYTES;
constexpr size_t WS_PROJ = WS_H + (size_t)M_TOK * 2048 * 2;
constexpr size_t WS_XB = WS_PROJ + (size_t)M_TOK * NPROJ * 2;
constexpr size_t WS_END = WS_XB + (size_t)M_TOK * 2048 * 2;
constexpr int LDS_BYTES = 147456;

struct Args { const float* in[20]; float* out; unsigned char* ws; int ph_lo, ph_hi; };

template <int CTRL> __device__ __forceinline__ float dpp_f(float v) { return __int_as_float(__builtin_amdgcn_update_dpp(0, __float_as_int(v), CTRL, 0xf, 0xf, false)); }
__device__ __forceinline__ float xor16_sum(float v) { const auto r = __builtin_amdgcn_permlane16_swap(__float_as_uint(v), __float_as_uint(v), false, false); return __uint_as_float(r[0]) + __uint_as_float(r[1]); }
__device__ __forceinline__ float xor32_sum(float v) { const auto r = __builtin_amdgcn_permlane32_swap(__float_as_uint(v), __float_as_uint(v), false, false); return __uint_as_float(r[0]) + __uint_as_float(r[1]); }
__device__ __forceinline__ float xor16_max(float v) { const auto r = __builtin_amdgcn_permlane16_swap(__float_as_uint(v), __float_as_uint(v), false, false); return fmaxf(__uint_as_float(r[0]), __uint_as_float(r[1])); }
__device__ __forceinline__ float xor32_max(float v) { const auto r = __builtin_amdgcn_permlane32_swap(__float_as_uint(v), __float_as_uint(v), false, false); return fmaxf(__uint_as_float(r[0]), __uint_as_float(r[1])); }
__device__ __forceinline__ float wave_sum(float v) {
    v += dpp_f<0x128>(v); v += dpp_f<0x124>(v); v += dpp_f<0x122>(v); v += dpp_f<0x121>(v);
    v = xor16_sum(v); v = xor32_sum(v);
    return v;
}
__device__ __forceinline__ float wave_incl_scan(float v, int lane) {
#pragma unroll
    for (int o = 1; o < 64; o <<= 1) { const float t = __int_as_float(__builtin_amdgcn_ds_bpermute(((lane - o) & 63) << 2, __float_as_int(v))); if (lane >= o) v += t; }
    return v;
}
__device__ __forceinline__ float lane63(float v) { return __int_as_float(__builtin_amdgcn_readlane(__float_as_int(v), 63)); }
typedef short v4i16_t __attribute__((ext_vector_type(4)));
__device__ __forceinline__ s16x4 ldtr(LAS unsigned char* p) { return __builtin_bit_cast(s16x4, __builtin_amdgcn_ds_read_tr16_b64_v4i16((LAS v4i16_t*)p)); }
__device__ __forceinline__ bf16x8 cat8(s16x4 lo, s16x4 hi) { return (bf16x8){lo[0], lo[1], lo[2], lo[3], hi[0], hi[1], hi[2], hi[3]}; }
__device__ __forceinline__ f32x4 mfma16(bf16x8 a, bf16x8 b, f32x4 c) { return __builtin_amdgcn_mfma_f32_16x16x32_bf16(a, b, c, 0, 0, 0); }
#define LDS_WAIT() asm volatile("s_waitcnt lgkmcnt(0)" ::: "memory")
#define LDS_BARRIER() asm volatile("s_waitcnt lgkmcnt(0)\n\ts_barrier" ::: "memory")

__device__ __forceinline__ void tr_item(const float* W, int Nsrc, bf16_t* WT, int K, int k0, int s0, int n0, LAS float* scr, int lane) {
    const int c = lane & 7;
    if (s0 < 0) {
#pragma unroll
        for (int j = 0; j < 4; ++j) { const int n = (lane >> 3) + 8 * j; *(u32x4*)(WT + (size_t)(n0 + n) * K + k0 + 8 * c) = (u32x4){0u, 0u, 0u, 0u}; }
        return;
    }
    { const float* wp = W + (size_t)(k0 + (lane >> 5)) * Nsrc + s0 + (lane & 31); float v[32];
#pragma unroll
        for (int i = 0; i < 32; ++i) v[i] = __builtin_nontemporal_load(wp + (size_t)(2 * i) * Nsrc);
#pragma unroll
        for (int i = 0; i < 32; ++i) scr[(2 * i + (lane >> 5)) * 33 + (lane & 31)] = v[i]; }
    LDS_WAIT();
#pragma unroll
    for (int j = 0; j < 4; ++j) { const int n = (lane >> 3) + 8 * j; const LAS float* s = scr + (8 * c) * 33 + n;
        u32x4 o; o.x = cvt_pk_bf16(s[0 * 33], s[1 * 33]); o.y = cvt_pk_bf16(s[2 * 33], s[3 * 33]); o.z = cvt_pk_bf16(s[4 * 33], s[5 * 33]); o.w = cvt_pk_bf16(s[6 * 33], s[7 * 33]);
        *(u32x4*)(WT + (size_t)(n0 + n) * K + k0 + 8 * c) = o; }
    LDS_WAIT();
}

struct SideItem { const float* src; bf16_t* dst; int nsrc; int mode; };
constexpr int IPL32 = 38400 + 1024 + 8192 + 4096 + 22528 + 11264;
__device__ __forceinline__ SideItem side_decode(const Args& a, int l, int it, int lane);
__device__ __forceinline__ void side_issue(const SideItem& s, float (&v)[16]);
__device__ __forceinline__ void side_drain(const SideItem& s, const float (&v)[16]);
__device__ __forceinline__ void phase_prep(const Args& a, LAS unsigned char* lds, int tid, int lane, int wave, int bx, int G, int nlayers) {
    float* MOD = (float*)(a.ws + WS_MOD);
    const float* cin = a.in[1]; const float* w_mod = a.in[5]; const float* b_mod = a.in[6];
    LAS f32x4* red = (LAS f32x4*)lds;
    for (int it = bx; it < 256; it += G) {
        const int l = it >> 7, c96 = it & 127;
        const int par = lane >= 24 ? 1 : 0, cl = lane - 24 * par; const bool act = lane < 48;
        const float* Wm = w_mod + (size_t)l * 2048 * 12288 + c96 * 96 + (act ? cl : 0) * 4;
        const int k0 = wave * 256 + par;
        f32x4 acc0 = {0.f, 0.f, 0.f, 0.f}, acc1 = acc0, acc2 = acc0, acc3 = acc0;
#pragma unroll 8
        for (int kk = 0; kk < 128; ++kk) { const int k = k0 + 2 * kk; const f32x4 wv = __builtin_nontemporal_load((const f32x4*)(Wm + (size_t)k * 12288));
            acc0 += siluf_(cin[k]) * wv; acc1 += siluf_(cin[2048 + k]) * wv; acc2 += siluf_(cin[4096 + k]) * wv; acc3 += siluf_(cin[6144 + k]) * wv; }
        if (act) { LAS f32x4* rp = red + ((wave * 2 + par) * 4) * 24 + cl; rp[0] = acc0; rp[24] = acc1; rp[48] = acc2; rp[72] = acc3; }
        __syncthreads();
        if (tid < 384) { const int b = tid / 96, ci = tid % 96; float s = b_mod[l * 12288 + c96 * 96 + ci];
#pragma unroll
            for (int w = 0; w < 16; ++w) s += ((const LAS float*)lds)[((w * 4 + b) * 24 + (ci >> 2)) * 4 + (ci & 3)];
            MOD[(size_t)(l * 4 + b) * 12288 + c96 * 96 + ci] = s; }
        __syncthreads();
    }
    LAS float* scr = (LAS float*)(lds + wave * 8704);
    const int gw = bx * 8 + wave, NGW = G * 8;
    constexpr int IPL = 19200 + 512 + 4096 + 2048 + 11264 + 5632;
    for (int it = gw; it < nlayers * IPL; it += NGW) {
        const int l = it / IPL; int r = it % IPL;
        unsigned char* wb = a.ws + WS_W + (size_t)l * WL_BYTES;
        if (r < 19200) { const int kb = r / 600, nb = r % 600, n0 = nb * 32;
            const int s0 = n0 < 14848 ? n0 : (n0 < 18944 ? n0 + 64 : (n0 < 19008 ? 14848 + (n0 - 18944) : -1));
            tr_item(a.in[7] + (size_t)l * 2048 * N_IN, N_IN, (bf16_t*)(wb + WO_IN), 2048, kb * 64, s0, n0, scr, lane); continue; }
        r -= 19200;
        if (r < 512) { const int kb = r >> 6, nb = r & 63; tr_item(a.in[14] + (size_t)l * 512 * 2048, 2048, (bf16_t*)(wb + WO_A), 512, kb * 64, nb * 32, nb * 32, scr, lane); continue; }
        r -= 512;
        if (r < 4096) { const int kb = r >> 6, nb = r & 63; tr_item(a.in[15] + (size_t)l * 4096 * 2048, 2048, (bf16_t*)(wb + WO_S), 4096, kb * 64, nb * 32, nb * 32, scr, lane); continue; }
        r -= 4096;
        if (r < 2048) { const int kb = r >> 6, nb = r & 63; tr_item(a.in[16] + (size_t)l * 2048 * 2048, 2048, (bf16_t*)(wb + WO_O), 2048, kb * 64, nb * 32, nb * 32, scr, lane); continue; }
        r -= 2048;
        if (r < 11264) { const int kb = r / 352, nb = r % 352, n0 = nb * 32, t = n0 >> 8, j = n0 & 255;
            const int s0 = j < 128 ? 128 * t + j : D_FF + 128 * t + (j - 128);
            tr_item(a.in[17] + (size_t)l * 2048 * 2 * D_FF, 2 * D_FF, (bf16_t*)(wb + WO_FI), 2048, kb * 64, s0, n0, scr, lane); continue; }
        r -= 11264;
        { const int kb = r >> 6, nb = r & 63; tr_item(a.in[18] + (size_t)l * D_FF * 2048, 2048, (bf16_t*)(wb + WO_FO), D_FF, kb * 64, nb * 32, nb * 32, scr, lane); }
    }
    if (nlayers == 1) {
        for (int it = 32 * NGW + gw; it < IPL32; it += NGW) { float v[16]; const SideItem sd = side_decode(a, 1, it, lane); side_issue(sd, v); side_drain(sd, v); }
    }
}

template <bool FINAL>
__device__ __forceinline__ void phase_norm(const float* x, const float* w, const float* sc, const float* sh, bf16_t* H, float* outf, int lane, int gw, int NGW) {
    for (int blk = gw; blk < M_TOK / 8; blk += NGW) {
        const int m0 = blk * 8, b = m0 >> 12;
        f32x4 A[8], B[8];
#pragma unroll
        for (int j = 0; j < 8; ++j) { const int col = 4 * (lane + 64 * j); A[j] = *(const f32x4*)(w + col);
            if (!FINAL) { const f32x4 scv = *(const f32x4*)(sc + (size_t)b * 12288 + col); A[j] = A[j] * (1.0f + scv); B[j] = *(const f32x4*)(sh + (size_t)b * 12288 + col); } }
        f32x4 v[8], nx[8];
        { const f32x4* xr = (const f32x4*)(x + (size_t)m0 * 2048) + lane;
#pragma unroll
            for (int j = 0; j < 8; ++j) nx[j] = xr[64 * j]; }
#pragma unroll 1
        for (int r = 0; r < 8; ++r) { const int m = m0 + r;
#pragma unroll
            for (int j = 0; j < 8; ++j) v[j] = nx[j];
            if (r + 1 < 8) { const f32x4* xr = (const f32x4*)(x + (size_t)(m + 1) * 2048) + lane;
#pragma unroll
                for (int j = 0; j < 8; ++j) nx[j] = xr[64 * j]; }
            float ss = 0.f;
#pragma unroll
            for (int j = 0; j < 8; ++j) ss += (v[j].x * v[j].x + v[j].y * v[j].y) + (v[j].z * v[j].z + v[j].w * v[j].w);
            ss = wave_sum(ss);
            const float rstd = 1.0f / sqrtf(ss * (1.0f / 2048.0f) + 1e-6f);
#pragma unroll
            for (int j = 0; j < 8; ++j) { const int col = 4 * (lane + 64 * j);
                if (FINAL) { *(f32x4*)(outf + (size_t)m * 2048 + col) = v[j] * rstd * A[j]; }
                else { const f32x4 o = v[j] * rstd * A[j] + B[j];
                    u32x2 pk; pk.x = cvt_pk_bf16(o.x, o.y); pk.y = cvt_pk_bf16(o.z, o.w);
                    *(u32x2*)(H + (size_t)m * 2048 + col) = pk; } }
        }
    }
}

template <bool FINAL>
__device__ __forceinline__ void phase_norm_b(const bf16_t* xb, const float* w, const float* sc, const float* sh, bf16_t* H, float* outf, int lane, int gw, int NGW) {
    for (int blk = gw; blk < M_TOK / 8; blk += NGW) {
        const int m0 = blk * 8, b = m0 >> 12;
        f32x4 A0[4], A1[4], B0[4], B1[4];
#pragma unroll
        for (int j = 0; j < 4; ++j) { const int col = 8 * (lane + 64 * j); A0[j] = *(const f32x4*)(w + col); A1[j] = *(const f32x4*)(w + col + 4);
            if (!FINAL) { const float* scp = sc + (size_t)b * 12288 + col; const float* shp = sh + (size_t)b * 12288 + col;
                A0[j] = A0[j] * (1.0f + *(const f32x4*)scp); A1[j] = A1[j] * (1.0f + *(const f32x4*)(scp + 4)); B0[j] = *(const f32x4*)shp; B1[j] = *(const f32x4*)(shp + 4); } }
        u32x4 nx[4];
        { const u32x4* xr = (const u32x4*)(xb + (size_t)m0 * 2048) + lane;
#pragma unroll
            for (int j = 0; j < 4; ++j) nx[j] = xr[64 * j]; }
#pragma unroll 1
        for (int r = 0; r < 8; ++r) { const int m = m0 + r;
            f32x4 v0[4], v1[4];
#pragma unroll
            for (int j = 0; j < 4; ++j) { const u32x4 q = nx[j]; v0[j] = (f32x4){bflo(q.x), bfhi(q.x), bflo(q.y), bfhi(q.y)}; v1[j] = (f32x4){bflo(q.z), bfhi(q.z), bflo(q.w), bfhi(q.w)}; }
            if (r + 1 < 8) { const u32x4* xr = (const u32x4*)(xb + (size_t)(m + 1) * 2048) + lane;
#pragma unroll
                for (int j = 0; j < 4; ++j) nx[j] = xr[64 * j]; }
            float ss = 0.f;
#pragma unroll
            for (int j = 0; j < 4; ++j) { const f32x4 q0 = v0[j] * v0[j], q1 = v1[j] * v1[j]; ss += ((q0.x + q0.y) + (q0.z + q0.w)) + ((q1.x + q1.y) + (q1.z + q1.w)); }
            ss = wave_sum(ss);
            const float rstd = 1.0f / sqrtf(ss * (1.0f / 2048.0f) + 1e-6f);
#pragma unroll
            for (int j = 0; j < 4; ++j) { const int col = 8 * (lane + 64 * j);
                if (FINAL) { *(f32x4*)(outf + (size_t)m * 2048 + col) = v0[j] * rstd * A0[j]; *(f32x4*)(outf + (size_t)m * 2048 + col + 4) = v1[j] * rstd * A1[j]; }
                else { const f32x4 o0 = v0[j] * rstd * A0[j] + B0[j], o1 = v1[j] * rstd * A1[j] + B1[j];
                    u32x4 pk; pk.x = cvt_pk_bf16(o0.x, o0.y); pk.y = cvt_pk_bf16(o0.z, o0.w); pk.z = cvt_pk_bf16(o1.x, o1.y); pk.w = cvt_pk_bf16(o1.z, o1.w);
                    *(u32x4*)(H + (size_t)m * 2048 + col) = pk; } }
        }
    }
}

__device__ __forceinline__ void att_decode(int u, int& g, int& b, int& hh, int& d, int& r, int& n) {
    g = u >> 9; const int rem = u & 511; b = rem >> 7; hh = (rem >> 5) & 3; const int bi = rem & 31;
    d = g == 0 ? 1 : (g == 1 ? 4 : 16); const int nb = 32 / d; r = bi / nb; n = bi % nb;
}
__device__ __forceinline__ void phase_attn(bf16_t* P, float* LSE, const float* rel_bias, LAS unsigned char* lds, int bx, int G, int tid_) {
    int tid = tid_; asm volatile("" : "+v"(tid)); const int lane = tid & 63, wave = __builtin_amdgcn_readfirstlane(tid >> 6);
    constexpr int RS = 272;
    LAS unsigned char* Ks = lds; LAS unsigned char* Vs = lds + 256 * RS; LAS float* biasT = (LAS float*)(lds + 2 * 256 * RS);
    const int l15 = lane & 15, q4 = lane >> 4, qi = 16 * wave + l15;
    int u = bx; if (u >= 1536) return;
    u32x4 kr[8], vr[8]; bf16x8 Qn[4];
#define ATT_LOAD(uu) do { int g_, b_, hh_, d_, r_, n_; att_decode((uu), g_, b_, hh_, d_, r_, n_); const int colq_ = g_ * 512 + hh_ * 128; \
        _Pragma("unroll") for (int i = 0; i < 8; ++i) { const int idx = tid + 512 * i, key = idx >> 4, ch = idx & 15; const int si = (n_ - 1) * 128 + key; \
            kr[i] = (u32x4){0u, 0u, 0u, 0u}; vr[i] = (u32x4){0u, 0u, 0u, 0u}; \
            if (n_ > 0 || i >= 4) { const bf16_t* rp = P + (size_t)(b_ * SEQ + si * d_ + r_) * NPROJ + colq_ + ch * 8; kr[i] = *(const u32x4*)(rp + COL_K); vr[i] = *(const u32x4*)(rp + COL_V); } } \
        { const bf16_t* qp_ = P + (size_t)(b_ * SEQ + (n_ * 128 + qi) * d_ + r_) * NPROJ + colq_; \
          _Pragma("unroll") for (int ks = 0; ks < 4; ++ks) Qn[ks] = *(const bf16x8*)(qp_ + 32 * ks + 8 * q4); } } while (0)
    ATT_LOAD(u);
    for (;;) {
        int g, b, hh, d, r, n; att_decode(u, g, b, hh, d, r, n);
        const int colq = g * 512 + hh * 128;
#pragma unroll
        for (int i = 0; i < 8; ++i) { const int idx = tid + 512 * i, key = idx >> 4, ch = idx & 15;
            *(LAS u32x4*)(Ks + key * RS + ch * 16) = kr[i]; *(LAS u32x4*)(Vs + key * RS + ch * 16) = vr[i]; }
        if (tid < 160) { const int steps = tid - 15; float bv = -INFINITY;
            if (steps >= 0 && steps <= 128) { const int dist = steps * d; int bk;
                if (dist < 16) bk = dist; else { const int lg = 16 + (int)(logf((float)dist / 16.0f) / 4.852030263919617f * 16.0f); bk = lg < 31 ? lg : 31; }
                bv = rel_bias[bk * 12 + g * 4 + hh]; }
            biasT[tid] = bv; }
        bf16x8 Qf[4];
#pragma unroll
        for (int ks = 0; ks < 4; ++ks) Qf[ks] = Qn[ks];
        LDS_BARRIER();
        const int un = u + G;
        if (un < 1536) ATT_LOAD(un);
        const size_t tq = (size_t)(b * SEQ + (n * 128 + qi) * d + r);
        bf16_t* qp = P + tq * NPROJ + colq;
        f32x4 S[9];
        LAS unsigned char* kbase = Ks + (16 * wave + l15) * RS + q4 * 16;
#pragma unroll
        for (int tt = 0; tt < 9; ++tt) { S[tt] = (f32x4){0.f, 0.f, 0.f, 0.f};
#pragma unroll
            for (int ks = 0; ks < 4; ++ks) { const bf16x8 Kf = *(const LAS bf16x8*)(kbase + tt * 16 * RS + ks * 64); S[tt] = mfma16(Kf, Qf[ks], S[tt]); } }
        __builtin_amdgcn_sched_barrier(0);
        const float scale = 0.08838834764831845f;
        float mx = -INFINITY;
        {
            const LAS float* bp = biasT + (143 + l15 - 4 * q4);
#pragma unroll
            for (int tt = 0; tt < 9; ++tt)
#pragma unroll
                for (int e = 0; e < 4; ++e) S[tt][e] = S[tt][e] * scale + bp[-(16 * tt + e)];
            if (n == 0) {
#pragma unroll
                for (int tt = 0; tt < 9; ++tt)
#pragma unroll
                    for (int e = 0; e < 4; ++e) { if (wave + tt < 8) S[tt][e] = -INFINITY; }
            }
#pragma unroll
            for (int tt = 0; tt < 9; ++tt)
#pragma unroll
                for (int e = 0; e < 4; ++e) mx = fmaxf(mx, S[tt][e]);
        }
        mx = xor16_max(mx); mx = xor32_max(mx);
        float sum = 0.f;
#pragma unroll
        for (int tt = 0; tt < 9; ++tt)
#pragma unroll
            for (int e = 0; e < 4; ++e) { const float p = __expf(S[tt][e] - mx); S[tt][e] = p; sum += p; }
        sum = xor16_sum(sum); sum = xor32_sum(sum);
        bf16x8 Pf[5];
#pragma unroll
        for (int kk = 0; kk < 5; ++kk) { u32x4 w; w.x = cvt_pk_bf16(S[2 * kk][0], S[2 * kk][1]); w.y = cvt_pk_bf16(S[2 * kk][2], S[2 * kk][3]);
            if (kk < 4) { w.z = cvt_pk_bf16(S[2 * kk + 1][0], S[2 * kk + 1][1]); w.w = cvt_pk_bf16(S[2 * kk + 1][2], S[2 * kk + 1][3]); } else { w.z = 0u; w.w = 0u; }
            Pf[kk] = __builtin_bit_cast(bf16x8, w); }
        const float inv = 1.0f / sum;
        LAS unsigned char* vbase = Vs + (16 * wave + 4 * q4 + (l15 >> 2)) * RS + (l15 & 3) * 8;
        bf16_t* op = qp + 4 * q4;
#pragma unroll
        for (int dt = 0; dt < 8; ++dt) { f32x4 o = {0.f, 0.f, 0.f, 0.f};
#pragma unroll
            for (int kk = 0; kk < 5; ++kk) {
                const s16x4 lo = ldtr(vbase + (32 * kk) * RS + dt * 32);
                s16x4 hi = {0, 0, 0, 0};
                if (kk < 4) hi = ldtr(vbase + (32 * kk + 16) * RS + dt * 32);
                o = mfma16(cat8(lo, hi), Pf[kk], o); }
            u32x2 pk; pk.x = cvt_pk_bf16(o[0] * inv, o[1] * inv); pk.y = cvt_pk_bf16(o[2] * inv, o[3] * inv);
            *(u32x2*)(op + 16 * dt) = pk;
            __builtin_amdgcn_sched_barrier(0); }
        if (q4 == 0) LSE[tq * 12 + g * 4 + hh] = mx + logf(sum);
        LDS_BARRIER();
        if (un >= 1536) break;
        u = un;
    }
#undef ATT_LOAD
}

__device__ __forceinline__ SideItem side_decode(const Args& a, int l, int it, int lane) {
    SideItem s; s.src = nullptr; s.dst = nullptr; s.nsrc = 0; s.mode = 0;
    if (it >= IPL32) return s;
    unsigned char* wb = a.ws + WS_W + (size_t)l * WL_BYTES;
    const float* W; bf16_t* WT; int K, Nsrc, kb, nb, s0;
    int r = it;
    if (r < 38400) { kb = r / 600; nb = r % 600; const int n0 = nb * 32; s0 = n0 < 14848 ? n0 : (n0 < 18944 ? n0 + 64 : (n0 < 19008 ? 14848 + (n0 - 18944) : -1));
        W = a.in[7] + (size_t)l * 2048 * N_IN; Nsrc = N_IN; WT = (bf16_t*)(wb + WO_IN); K = 2048; }
    else if ((r -= 38400) < 1024) { kb = r >> 6; nb = r & 63; s0 = nb * 32; W = a.in[14] + (size_t)l * 512 * 2048; Nsrc = 2048; WT = (bf16_t*)(wb + WO_A); K = 512; }
    else if ((r -= 1024) < 8192) { kb = r >> 6; nb = r & 63; s0 = nb * 32; W = a.in[15] + (size_t)l * 4096 * 2048; Nsrc = 2048; WT = (bf16_t*)(wb + WO_S); K = 4096; }
    else if ((r -= 8192) < 4096) { kb = r >> 6; nb = r & 63; s0 = nb * 32; W = a.in[16] + (size_t)l * 2048 * 2048; Nsrc = 2048; WT = (bf16_t*)(wb + WO_O); K = 2048; }
    else if ((r -= 4096) < 22528) { kb = r / 352; nb = r % 352; const int n0 = nb * 32, t = n0 >> 8, j = n0 & 255; s0 = j < 128 ? 128 * t + j : D_FF + 128 * t + (j - 128);
        W = a.in[17] + (size_t)l * 2048 * 2 * D_FF; Nsrc = 2 * D_FF; WT = (bf16_t*)(wb + WO_FI); K = 2048; }
    else { r -= 22528; kb = r >> 6; nb = r & 63; s0 = nb * 32; W = a.in[18] + (size_t)l * D_FF * 2048; Nsrc = 2048; WT = (bf16_t*)(wb + WO_FO); K = D_FF; }
    const int n = lane & 31, kh = lane >> 5, k0 = kb * 32 + 16 * kh;
    s.dst = WT + (size_t)(nb * 32 + n) * K + k0; s.nsrc = Nsrc;
    if (s0 < 0) { s.mode = 2; } else { s.mode = 1; s.src = W + (size_t)k0 * Nsrc + s0 + n; }
    return s;
}
__device__ __forceinline__ void side_issue(const SideItem& s, float (&v)[16]) {
    if (s.mode == 1) {
#pragma unroll
        for (int j = 0; j < 16; ++j) v[j] = s.src[(size_t)j * s.nsrc]; }
}
__device__ __forceinline__ void side_drain(const SideItem& s, const float (&v)[16]) {
    if (s.mode == 0) return;
    u32x4 w0 = {0u, 0u, 0u, 0u}, w1 = {0u, 0u, 0u, 0u};
    if (s.mode == 1) { w0.x = cvt_pk_bf16(v[0], v[1]); w0.y = cvt_pk_bf16(v[2], v[3]); w0.z = cvt_pk_bf16(v[4], v[5]); w0.w = cvt_pk_bf16(v[6], v[7]);
        w1.x = cvt_pk_bf16(v[8], v[9]); w1.y = cvt_pk_bf16(v[10], v[11]); w1.z = cvt_pk_bf16(v[12], v[13]); w1.w = cvt_pk_bf16(v[14], v[15]); }
    *(u32x4*)s.dst = w0; *(u32x4*)(s.dst + 8) = w1;
}

__device__ __forceinline__ void phase_convbc(const bf16_t* P, bf16_t* HBC, const float* conv_w, const float* conv_b, int tid, int bx, int G) {
    const int chunk = tid & 255, rh = tid >> 8, col = 4096 + chunk * 8;
    float cw[4][8], cbias[8];
#pragma unroll
    for (int e = 0; e < 8; ++e) { cbias[e] = conv_b[col + e];
#pragma unroll
        for (int j = 0; j < 4; ++j) cw[j][e] = conv_w[j * 6144 + col + e]; }
    for (int it = bx; it < M_TOK / 32; it += G) {
        const int r0 = it * 32 + rh * 16; const bool halo = (r0 & (SEQ - 1)) != 0;
        const bf16_t* src = P + (size_t)r0 * NPROJ + COL_XBC + col;
        u32x4 raw[19];
#pragma unroll
        for (int i = 0; i < 19; ++i) { raw[i] = (u32x4){0u, 0u, 0u, 0u}; if (i >= 3 || halo) raw[i] = *(const u32x4*)(src + (ptrdiff_t)(i - 3) * NPROJ); }
#pragma unroll
        for (int rr = 0; rr < 16; ++rr) { float o[8];
#pragma unroll
            for (int e = 0; e < 8; ++e) o[e] = cbias[e];
#pragma unroll
            for (int j = 0; j < 4; ++j) { const u32x4 rv = raw[rr + j];
                o[0] += bflo(rv.x) * cw[j][0]; o[1] += bfhi(rv.x) * cw[j][1]; o[2] += bflo(rv.y) * cw[j][2]; o[3] += bfhi(rv.y) * cw[j][3];
                o[4] += bflo(rv.z) * cw[j][4]; o[5] += bfhi(rv.z) * cw[j][5]; o[6] += bflo(rv.w) * cw[j][6]; o[7] += bfhi(rv.w) * cw[j][7]; }
#pragma unroll
            for (int e = 0; e < 8; ++e) o[e] = siluf_(o[e]);
            u32x4 w; w.x = cvt_pk_bf16(o[0], o[1]); w.y = cvt_pk_bf16(o[2], o[3]); w.z = cvt_pk_bf16(o[4], o[5]); w.w = cvt_pk_bf16(o[6], o[7]);
            *(u32x4*)(HBC + (size_t)(r0 + rr) * 2048 + chunk * 8) = w; }
    }
}

template <int VAR, bool SIDE>
__device__ __forceinline__ void ssd_unit(bf16_t* P, const bf16_t* HBC, const float* DT, const float* conv_w, const float* conv_b, float dtb, float Aneg, float Dk,
                                         LAS unsigned char* lds, int b, int hd, int tid_, int lane_, int wave_, const Args& sa, int sgw, int sngw) {
    int tid = tid_; asm volatile("" : "+v"(tid)); const int lane = tid & 63, wave = __builtin_amdgcn_readfirstlane(tid >> 6);
    constexpr int XS = 144, BS = 272;
    LAS unsigned char* Xs = lds; LAS unsigned char* Xw = lds + 18432; LAS unsigned char* Bm = lds + 36864; LAS unsigned char* Cm = lds + 71680; LAS unsigned char* Hs = lds + 106496;
    LAS float* scal = (LAS float*)(lds + 123904);
    const int g = hd >> 3, l15 = lane & 15, q4 = lane >> 4;
    const int xch = tid & 7, xr0 = (tid >> 3) * 2;
    const int xcol = hd * 64 + xch * 8;
    const int bcch = tid & 31, bcrow = tid >> 5;
    const int bccol = bcch < 16 ? g * 128 + bcch * 8 : 1024 + g * 128 + (bcch - 16) * 8;
    LAS unsigned char* bcdst = (bcch < 16 ? Bm + bcch * 16 : Cm + (bcch - 16) * 16) + bcrow * BS;
    LAS float* cwt = (LAS float*)(lds + 126976);
    if (tid < 320) { const int j = tid >> 6, cc = tid & 63; cwt[tid] = j < 4 ? conv_w[j * 6144 + hd * 64 + cc] : conv_b[hd * 64 + cc]; }
    { u32x4 zq = {0u, 0u, 0u, 0u}; asm volatile("" : "+v"(zq));
      for (int i = tid; i < 17408 / 16; i += 512) *(LAS u32x4*)(Hs + i * 16) = zq; }
    f32x4 hacc[4];
#pragma unroll
    for (int pt = 0; pt < 4; ++pt) hacc[pt] = (f32x4){0.f, 0.f, 0.f, 0.f};
    u32x4 xraw[5], bcraw[8]; float dr0 = 0.f, dr1 = 0.f;
#define SSD_LOADS(c_) do { const int tok0_ = b * SEQ + (c_) * 128; \
        _Pragma("unroll") for (int i = 0; i < 5; ++i) { xraw[i] = (u32x4){0u, 0u, 0u, 0u}; \
            if (i >= 3 || (c_) > 0 || xr0 + i >= 3) xraw[i] = *(const u32x4*)(P + (size_t)(tok0_ + xr0 - 3 + i) * NPROJ + COL_XBC + xcol); } \
        if (wave == 0) { dr0 = DT[(size_t)(tok0_ + lane) * 64 + hd]; dr1 = DT[(size_t)(tok0_ + 64 + lane) * 64 + hd]; } } while (0)
#define SSD_LOADS_BC(c_) do { const int tok0_ = b * SEQ + (c_) * 128; \
        _Pragma("unroll") for (int i = 0; i < 8; ++i) bcraw[i] = *(const u32x4*)(HBC + (size_t)(tok0_ + bcrow + 16 * i) * 2048 + bccol); } while (0)
#define SSD_SCAN(par_) do { LAS float* dtv_ = scal + (par_) * 128; LAS float* acum_ = scal + 256 + (par_) * 128; LAS float* wl_ = scal + 512 + (par_) * 128; \
        const float x0 = dr0 + dtb, x1 = dr1 + dtb; \
        const float dt0 = x0 > 20.f ? x0 : log1pf(expf(x0)), dt1 = x1 > 20.f ? x1 : log1pf(expf(x1)); \
        const float s0 = wave_incl_scan(dt0 * Aneg, lane); const float tot0 = lane63(s0); \
        const float s1 = wave_incl_scan(dt1 * Aneg, lane) + tot0; const float tot = lane63(s1); \
        dtv_[lane] = dt0; dtv_[64 + lane] = dt1; acum_[lane] = s0 * 1.4426950408889634f; acum_[64 + lane] = s1 * 1.4426950408889634f;     \
        wl_[lane] = dt0 * __expf(tot - s0); wl_[64 + lane] = dt1 * __expf(tot - s1); } while (0)
    SideItem sd0; float sv0[16]; sd0.src = nullptr; sd0.dst = nullptr; sd0.nsrc = 0; sd0.mode = 0;
#pragma unroll
    for (int j = 0; j < 16; ++j) sv0[j] = 0.f;
    SSD_LOADS(0); SSD_LOADS_BC(0);
    if (wave == 0) SSD_SCAN(0);
    __syncthreads();
    for (int c = 0; c < 32; ++c) {
        const int par = c & 1;
        LAS float* dtv = scal + par * 128; LAS float* acum = scal + 256 + par * 128; LAS float* wl = scal + 512 + par * 128;
        const int tok0 = b * SEQ + c * 128;
        f32x4 o2[2][2];
        { const f32x4 ba = *(const LAS f32x4*)(cwt + 256 + xch * 8), bb = *(const LAS f32x4*)(cwt + 256 + xch * 8 + 4); o2[0][0] = ba; o2[0][1] = bb; o2[1][0] = ba; o2[1][1] = bb; }
#pragma unroll
        for (int j = 0; j < 4; ++j) { const f32x4 wa = *(const LAS f32x4*)(cwt + j * 64 + xch * 8), wb = *(const LAS f32x4*)(cwt + j * 64 + xch * 8 + 4);
#pragma unroll
            for (int rr = 0; rr < 2; ++rr) { const u32x4 rv = xraw[rr + j];
                o2[rr][0] += (f32x4){bflo(rv.x), bfhi(rv.x), bflo(rv.y), bfhi(rv.y)} * wa; o2[rr][1] += (f32x4){bflo(rv.z), bfhi(rv.z), bflo(rv.w), bfhi(rv.w)} * wb; } }
        { f32x4 t[2][2];
#pragma unroll
            for (int rr = 0; rr < 2; ++rr)
#pragma unroll
                for (int hq = 0; hq < 2; ++hq)
                    { const f32x4 ta = o2[rr][hq] * -1.4426950408889634f;
#pragma unroll
                      for (int e = 0; e < 4; ++e) t[rr][hq][e] = __builtin_amdgcn_exp2f(ta[e]); }
#pragma unroll
            for (int rr = 0; rr < 2; ++rr)
#pragma unroll
                for (int hq = 0; hq < 2; ++hq)
                    { const f32x4 tb = t[rr][hq] + 1.0f;
#pragma unroll
                      for (int e = 0; e < 4; ++e) t[rr][hq][e] = __builtin_amdgcn_rcpf(tb[e]); }
#pragma unroll
            for (int rr = 0; rr < 2; ++rr)
#pragma unroll
                for (int hq = 0; hq < 2; ++hq) o2[rr][hq] = o2[rr][hq] * t[rr][hq]; }
#pragma unroll
        for (int rr = 0; rr < 2; ++rr) { const f32x4 oa = o2[rr][0], ob = o2[rr][1];
            u32x4 w; w.x = cvt_pk_bf16(oa[0], oa[1]); w.y = cvt_pk_bf16(oa[2], oa[3]); w.z = cvt_pk_bf16(ob[0], ob[1]); w.w = cvt_pk_bf16(ob[2], ob[3]);
            *(LAS u32x4*)(Xs + (xr0 + rr) * XS + xch * 16) = w;
            const float f = wl[xr0 + rr]; const f32x4 pa = oa * f, pb = ob * f;
            w.x = cvt_pk_bf16(pa[0], pa[1]); w.y = cvt_pk_bf16(pa[2], pa[3]); w.z = cvt_pk_bf16(pb[0], pb[1]); w.w = cvt_pk_bf16(pb[2], pb[3]);
            *(LAS u32x4*)(Xw + (xr0 + rr) * XS + xch * 16) = w; }
#pragma unroll
        for (int i = 0; i < 8; ++i) *(LAS u32x4*)(bcdst + 16 * i * BS) = bcraw[i];
        if (SIDE) { side_drain(sd0, sv0); sd0.mode = 0; }
        LDS_BARRIER();
        if (c + 1 < 32 && !(VAR & 2)) SSD_LOADS(c + 1);
        {
            const int lt = wave < 4 ? wave : 11 - wave;
            const int l = 16 * lt + l15; const float acl = acum[l];
            const size_t token = (size_t)(tok0 + l);
            bf16_t* zp = P + token * NPROJ + COL_Z + hd * 64 + 4 * q4;
            u32x2 zv[4];
#pragma unroll
            for (int pt = 0; pt < 4; ++pt) { zv[pt] = (u32x2){0x3f803f80u, 0x3f803f80u}; if (!(VAR & 1)) zv[pt] = *(const u32x2*)(zp + 16 * pt); }
            f32x4 Y[4];
#pragma unroll
            for (int pt = 0; pt < 4; ++pt) Y[pt] = (f32x4){0.f, 0.f, 0.f, 0.f};
            bf16x8 Cf[4];
            LAS unsigned char* cbase = Cm + l * BS + q4 * 16;
#pragma unroll
            for (int ks = 0; ks < 4; ++ks) Cf[ks] = *(const LAS bf16x8*)(cbase + ks * 64);
            LAS unsigned char* hbase = Hs + l15 * BS + q4 * 16;
#pragma unroll
            for (int pt = 0; pt < 4; ++pt)
#pragma unroll
                for (int ks = 0; ks < 4; ++ks) { const bf16x8 Hf = *(const LAS bf16x8*)(hbase + pt * 16 * BS + ks * 64); Y[pt] = mfma16(Hf, Cf[ks], Y[pt]); }
            const float eal = __builtin_amdgcn_exp2f(acl);
#pragma unroll
            for (int pt = 0; pt < 4; ++pt) Y[pt] *= eal;
            __builtin_amdgcn_sched_barrier(0);
            f32x4 Gt[8];
            f32x4 penv;
#pragma unroll
            for (int e = 0; e < 4; ++e) penv[e] = (4 * q4 + e <= l15) ? 0.f : 1e30f;
            LAS unsigned char* bbase = Bm + l15 * BS + q4 * 16;
#pragma unroll
            for (int st = 0; st < 8; ++st) { Gt[st] = (f32x4){0.f, 0.f, 0.f, 0.f};
                if (st <= lt) {
#pragma unroll
                    for (int ks = 0; ks < 4; ++ks) { const bf16x8 Bf = *(const LAS bf16x8*)(bbase + st * 16 * BS + ks * 64); Gt[st] = mfma16(Bf, Cf[ks], Gt[st]); }
                    const f32x4 as = *(const LAS f32x4*)(acum + 16 * st + 4 * q4), ds = *(const LAS f32x4*)(dtv + 16 * st + 4 * q4);
#pragma unroll
                    for (int e = 0; e < 1; ++e) { const float flagf = (st == lt) ? 1.0f : 0.0f;
                        const f32x4 dv = (acl - as) - penv * flagf;
                        f32x4 fv; fv[0] = __builtin_amdgcn_exp2f(dv[0]); fv[1] = __builtin_amdgcn_exp2f(dv[1]); fv[2] = __builtin_amdgcn_exp2f(dv[2]); fv[3] = __builtin_amdgcn_exp2f(dv[3]);
                        Gt[st] = Gt[st] * (fv * ds); }
                } }
            LAS unsigned char* xbase = Xs + (4 * q4 + (l15 >> 2)) * XS + (l15 & 3) * 8;
#pragma unroll
            for (int kk = 0; kk < 4; ++kk) {
                if (2 * kk <= lt) {
                    u32x4 w; w.x = cvt_pk_bf16(Gt[2 * kk][0], Gt[2 * kk][1]); w.y = cvt_pk_bf16(Gt[2 * kk][2], Gt[2 * kk][3]);
                    w.z = cvt_pk_bf16(Gt[2 * kk + 1][0], Gt[2 * kk + 1][1]); w.w = cvt_pk_bf16(Gt[2 * kk + 1][2], Gt[2 * kk + 1][3]);
                    const bf16x8 Pf = __builtin_bit_cast(bf16x8, w);
#pragma unroll
                    for (int pt = 0; pt < 4; ++pt) {
                        const s16x4 xlo = ldtr(xbase + (32 * kk) * XS + pt * 32);
                        const s16x4 xhi = ldtr(xbase + (32 * kk + 16) * XS + pt * 32);
                        Y[pt] = mfma16(cat8(xlo, xhi), Pf, Y[pt]); }
                } }
            __builtin_amdgcn_sched_barrier(0);
            if (c + 1 < 32 && !(VAR & 2)) SSD_LOADS_BC(c + 1);
            if (SIDE) { sd0 = side_decode(sa, 1, sgw + sngw * c, lane); side_issue(sd0, sv0); }
#pragma unroll
            for (int pt = 0; pt < 4; ++pt) { const int p0 = 16 * pt + 4 * q4;
                const u32x2 xv = *(const LAS u32x2*)(Xs + l * XS + p0 * 2);
                const f32x4 xf = {bflo(xv.x), bfhi(xv.x), bflo(xv.y), bfhi(xv.y)}, zf = {bflo(zv[pt].x), bfhi(zv[pt].x), bflo(zv[pt].y), bfhi(zv[pt].y)};
                const f32x4 yv = (Y[pt] + Dk * xf) * zf;
                u32x2 pk; pk.x = cvt_pk_bf16(yv[0], yv[1]); pk.y = cvt_pk_bf16(yv[2], yv[3]); if (!(VAR & 1)) *(u32x2*)(zp + 16 * pt) = pk; else asm volatile("" :: "v"(pk.x), "v"(pk.y)); }
            __builtin_amdgcn_sched_barrier(0);
            const float et = __builtin_amdgcn_exp2f(acum[127]);
#pragma unroll
            for (int pt = 0; pt < 4; ++pt) hacc[pt] *= et;
            LAS unsigned char* btbase = Bm + (4 * q4 + (l15 >> 2)) * BS + (16 * wave + 4 * (l15 & 3)) * 2;
            LAS unsigned char* xwbase = Xw + (4 * q4 + (l15 >> 2)) * XS + (l15 & 3) * 8;
#pragma unroll
            for (int kk = 0; kk < 4; ++kk) {
                const s16x4 blo = ldtr(btbase + (32 * kk) * BS);
                const s16x4 bhi = ldtr(btbase + (32 * kk + 16) * BS);
                const bf16x8 Bf = cat8(blo, bhi);
#pragma unroll
                for (int pt = 0; pt < 4; ++pt) {
                    const s16x4 xlo = ldtr(xwbase + (32 * kk) * XS + pt * 32);
                    const s16x4 xhi = ldtr(xwbase + (32 * kk + 16) * XS + pt * 32);
                    hacc[pt] = mfma16(Bf, cat8(xlo, xhi), hacc[pt]); }
            }
        }
        if (wave == 0 && c + 1 < 32) SSD_SCAN(par ^ 1);
        LDS_BARRIER();
#pragma unroll
        for (int pt = 0; pt < 4; ++pt) { u32x2 pk; pk.x = cvt_pk_bf16(hacc[pt][0], hacc[pt][1]); pk.y = cvt_pk_bf16(hacc[pt][2], hacc[pt][3]);
            *(LAS u32x2*)(Hs + (16 * pt + l15) * BS + (16 * wave + 4 * q4) * 2) = pk; }
    }
#undef SSD_LOADS
#undef SSD_LOADS_BC
#undef SSD_SCAN
    if (SIDE) { side_drain(sd0, sv0); }
    __syncthreads();
}

__device__ __forceinline__ void phase_attn_merge(bf16_t* P, const float* LSE, int lane, int gw, int NGW) {
    const int hh = lane >> 4, dd = (lane & 15) * 8;
#pragma unroll 2
    for (int m = gw; m < M_TOK; m += NGW) {
        bf16_t* op = P + (size_t)m * NPROJ + hh * 128 + dd;
        const float l0 = LSE[(size_t)m * 12 + hh], l1 = LSE[(size_t)m * 12 + 4 + hh], l2 = LSE[(size_t)m * 12 + 8 + hh];
        const u32x4 o0 = *(const u32x4*)op, o1 = *(const u32x4*)(op + 512), o2 = *(const u32x4*)(op + 1024);
        const float mx = fmaxf(l0, fmaxf(l1, l2)); float w0 = __expf(l0 - mx), w1 = __expf(l1 - mx), w2 = __expf(l2 - mx);
        const float inv = 1.0f / (w0 + w1 + w2); w0 *= inv; w1 *= inv; w2 *= inv;
        u32x4 w;
        w.x = cvt_pk_bf16(w0 * bflo(o0.x) + w1 * bflo(o1.x) + w2 * bflo(o2.x), w0 * bfhi(o0.x) + w1 * bfhi(o1.x) + w2 * bfhi(o2.x));
        w.y = cvt_pk_bf16(w0 * bflo(o0.y) + w1 * bflo(o1.y) + w2 * bflo(o2.y), w0 * bfhi(o0.y) + w1 * bfhi(o1.y) + w2 * bfhi(o2.y));
        w.z = cvt_pk_bf16(w0 * bflo(o0.z) + w1 * bflo(o1.z) + w2 * bflo(o2.z), w0 * bfhi(o0.z) + w1 * bfhi(o1.z) + w2 * bfhi(o2.z));
        w.w = cvt_pk_bf16(w0 * bflo(o0.w) + w1 * bflo(o1.w) + w2 * bflo(o2.w), w0 * bfhi(o0.w) + w1 * bfhi(o1.w) + w2 * bfhi(o2.w));
        *(u32x4*)op = w;
    }
}
__device__ __forceinline__ void phase_merge(bf16_t* P, const float* LSE, const float* nw, int lane, int gw, int NGW) {
    f32x4 wa[8], wb[8];
#pragma unroll
    for (int gg = 0; gg < 8; ++gg) { wa[gg] = *(const f32x4*)(nw + gg * 512 + lane * 8); wb[gg] = *(const f32x4*)(nw + gg * 512 + lane * 8 + 4); }
    for (int m = gw; m < M_TOK; m += NGW) {
        bf16_t* rp = P + (size_t)m * NPROJ;
        u32x4 yv[8];
#pragma unroll
        for (int gg = 0; gg < 8; ++gg) yv[gg] = *(const u32x4*)(rp + COL_Z + gg * 512 + lane * 8);
        float ss[8];
#pragma unroll
        for (int gg = 0; gg < 8; ++gg) { const u32x4 v = yv[gg];
            ss[gg] = (bflo(v.x) * bflo(v.x) + bfhi(v.x) * bfhi(v.x)) + (bflo(v.y) * bflo(v.y) + bfhi(v.y) * bfhi(v.y)) + (bflo(v.z) * bflo(v.z) + bfhi(v.z) * bfhi(v.z)) + (bflo(v.w) * bflo(v.w) + bfhi(v.w) * bfhi(v.w)); }
#pragma unroll
        for (int gg = 0; gg < 8; ++gg) ss[gg] = wave_sum(ss[gg]);
#pragma unroll
        for (int gg = 0; gg < 8; ++gg) { const u32x4 v = yv[gg];
            const float rs = 1.0f / sqrtf(ss[gg] * (1.0f / 512.0f) + 1e-6f);
            u32x4 w; w.x = cvt_pk_bf16(bflo(v.x) * rs * wa[gg].x, bfhi(v.x) * rs * wa[gg].y); w.y = cvt_pk_bf16(bflo(v.y) * rs * wa[gg].z, bfhi(v.y) * rs * wa[gg].w);
            w.z = cvt_pk_bf16(bflo(v.z) * rs * wb[gg].x, bfhi(v.z) * rs * wb[gg].y); w.w = cvt_pk_bf16(bflo(v.w) * rs * wb[gg].z, bfhi(v.w) * rs * wb[gg].w);
            *(u32x4*)(rp + COL_Z + gg * 512 + lane * 8) = w; }
    }
}

#define GAS __attribute__((address_space(1)))
#define XB_TMO      128
#define XB_XCNT(j)  (256  + 64 * (j))
#define XB_XSUB(j)  (1280 + 64 * (j))
#define XB_XGEN(j)  (2304 + 64 * (j))
#define XB_TOP      3328
#define XB_TOPGEN   3392
#define XCD_BAR_WORDS 3456
#define XB_SPIN_CAP (1u << 18)

__device__ __forceinline__ unsigned xb_ld(unsigned* p)              { return __hip_atomic_load(p, __ATOMIC_RELAXED, __HIP_MEMORY_SCOPE_AGENT); }
__device__ __forceinline__ unsigned xb_add(unsigned* p, unsigned v) { return __hip_atomic_fetch_add(p, v, __ATOMIC_RELAXED, __HIP_MEMORY_SCOPE_AGENT); }
__device__ __forceinline__ unsigned xb_xcc_id() { return (unsigned)__builtin_amdgcn_s_getreg((3 << 11) | 20) & 0xFu; }
#define XB_SPIN(cond, bar) do { unsigned _sp = 0; while (cond) { __builtin_amdgcn_s_sleep(1); \
    if ((++_sp & 255u) == 0u) { if (xb_ld(&(bar)[XB_TMO])) break; if (_sp > XB_SPIN_CAP) { atomicAdd(&(bar)[XB_TMO], 1u); break; } } } } while (0)

struct XcdBarrier {
    unsigned* bar; unsigned x; int w0;
    volatile LAS unsigned* st;
};

__device__ __forceinline__ XcdBarrier xcd_barrier_post(unsigned* bar, volatile LAS unsigned* st, int tid0_, int wv_) {
    XcdBarrier b; b.bar = bar; b.x = xb_xcc_id(); b.st = st; b.w0 = wv_;
    if (tid0_ == 0) (void)xb_add(&bar[XB_XCNT(b.x)], 1u);
    return b;
}
__device__ __forceinline__ void xcd_barrier_complete(unsigned* bar, unsigned x, unsigned& nloc, unsigned& nx) {
    const unsigned G = gridDim.x * gridDim.y * gridDim.z;
    unsigned sum, cnt, mine, sp = 0u;
    for (;;) {
        sum = 0u; cnt = 0u; mine = 0u;
#pragma unroll
        for (unsigned j = 0; j < 16; ++j) { const unsigned c = xb_ld(&bar[XB_XCNT(j)]); sum += c; cnt += (c > 0u) ? 1u : 0u; mine = (j == x) ? c : mine; }
        if (sum == G) break;
        __builtin_amdgcn_s_sleep(1);
        if ((++sp & 255u) == 0u) { if (xb_ld(&bar[XB_TMO])) break; if (sp > XB_SPIN_CAP) { atomicAdd(&bar[XB_TMO], 1u); break; } }
    }
    nloc = mine > 0u ? mine : 1u; nx = cnt > 0u ? cnt : 1u;
}

__device__ __forceinline__ void xcd_barrier(const XcdBarrier& b) {
    asm volatile("s_waitcnt vmcnt(0)" ::: "memory");
    __syncthreads();
    if (b.w0 == 0 && pg8::lane_id_mbcnt() == 0) {
        unsigned* bar = b.bar; asm volatile("" : "+s"(bar));
        __builtin_amdgcn_s_waitcnt(0);
        unsigned nloc = b.st[0], nx = b.st[1];
        if (nloc == 0u) { xcd_barrier_complete(bar, b.x, nloc, nx); b.st[0] = nloc; b.st[1] = nx; }
        const unsigned old = xb_add(&bar[XB_XSUB(b.x)], 1u);
        const unsigned gen = old / nloc;
        if (old + 1u == (gen + 1u) * nloc) {
            __builtin_amdgcn_fence(__ATOMIC_RELEASE, "agent");
            asm volatile("s_waitcnt vmcnt(0)" ::: "memory");
            const unsigned og = xb_add(&bar[XB_TOP], 1u);
            const unsigned tg = og / nx;
            if (og + 1u == (tg + 1u) * nx) xb_add(&bar[XB_TOPGEN], 1u);
            else XB_SPIN(xb_ld(&bar[XB_TOPGEN]) == tg, bar);
            __builtin_amdgcn_fence(__ATOMIC_ACQUIRE, "agent");
            xb_add(&bar[XB_XGEN(b.x)], 1u);
            asm volatile("s_waitcnt vmcnt(0)" ::: "memory");
        } else {
            XB_SPIN(xb_ld(&bar[XB_XGEN(b.x)]) == gen, bar);
            __builtin_amdgcn_fence(__ATOMIC_ACQUIRE, "agent");
            asm volatile("s_waitcnt vmcnt(0)" ::: "memory");
        }
    }
    __syncthreads();
}

#ifndef PROBE_MODE
#define PROBE_MODE 0
#endif
#ifndef PROBE_VAR
#define PROBE_VAR 0
#endif
#ifndef MK_SINGLE
#define MK_SINGLE 1
#endif
__global__ void __launch_bounds__(512, 2) fwd_kernel(Args a) {
    extern __shared__ __attribute__((aligned(16))) unsigned char lds_raw[];
    LAS unsigned char* lds = (LAS unsigned char*)lds_raw;
    cg::grid_group grid = cg::this_grid();
    const int bx = blockIdx.x, G = gridDim.x, NGW = G * 8;
    const int tid0 = threadIdx.x;
    const int wv_s = __builtin_amdgcn_readfirstlane(tid0 >> 6);
    const int lo = a.ph_lo, hi = a.ph_hi;
    volatile LAS unsigned* MISC = (volatile LAS unsigned*)(lds + LDS_BYTES - 64);
    if (tid0 < 16) MISC[tid0] = 0u;
    __syncthreads();
    const XcdBarrier xbar = xcd_barrier_post((unsigned*)(a.ws + WS_CTL), MISC, tid0, wv_s);
#define PH_IDS int tid = wv_s * 64 + pg8::lane_id_mbcnt(); asm volatile("" : "+v"(tid)); const int lane = tid & 63, wave = __builtin_amdgcn_readfirstlane(tid >> 6), gw = bx * 8 + wave; (void)lane; (void)gw
    float* out = a.out;
#define PH_PTRS unsigned char* ws = a.ws; asm volatile("" : "+s"(ws)); float* MOD = (float*)(ws + WS_MOD); float* LSE = (float*)(ws + WS_LSE); float* DT = (float*)(ws + WS_DT); \
    bf16_t* H = (bf16_t*)(ws + WS_H); bf16_t* P = (bf16_t*)(ws + WS_PROJ); bf16_t* XB = (bf16_t*)(ws + WS_XB); (void)XB; const float* mod = MOD + (size_t)l * 4 * 12288; unsigned char* wb = ws + WS_W + (size_t)l * WL_BYTES; \
    (void)LSE; (void)DT; (void)H; (void)P; (void)mod; (void)wb
#define IN(k) (lo <= (k) && (k) < hi)
#define SEAM(k) do { if (IN(k) && IN((k) + 1)) xcd_barrier(xbar); } while (0)
    if (lo < -1000) grid.sync();
    const bool side = false;
    if (IN(0)) { PH_IDS; phase_prep(a, lds, tid, lane, wave, bx, G, side ? 1 : 2); }
    SEAM(0);
#if PROBE_MODE == 5
    if (IN(0) && IN(1)) { { PH_IDS; phase_prep(a, lds, tid, lane, wave, bx, G, 2); } xcd_barrier(xbar); }
#endif
#pragma unroll 1
    for (int l = 0; l < 2; ++l) {
        const int pb = 1 + 10 * l;
        if (IN(pb + 0)) { PH_PTRS; PH_IDS; if (l == 0) phase_norm<false>(a.in[0], a.in[3] + l * 2048, mod + 2048, mod, H, nullptr, lane, gw, NGW); else phase_norm_b<false>(XB, a.in[3] + l * 2048, mod + 2048, mod, H, nullptr, lane, gw, NGW); }
        SEAM(pb + 0);
        if (IN(pb + 1)) { PH_PTRS; pg8::Gemm g{H, (const bf16_t*)(wb + WO_IN), M_TOK, NPROJ, 2048, 2048}; pg8::StaticOrder S; S.init(M_TOK, NPROJ, G, bx);
            pg8::EpiProj E{P, DT}; pg8::gemm_phase<pg8::EpiProj, pg8::StaticOrder, true, true>(lds, g, S, E, wv_s); }
        SEAM(pb + 1);
        if (IN(pb + 2)) { PH_PTRS; PH_IDS;
            phase_attn(P, LSE, a.in[2], lds, bx, G, tid);
            phase_convbc(P, H, a.in[8] + (size_t)l * 4 * 6144, a.in[9] + (size_t)l * 6144, tid, bx, G);
        }
        SEAM(pb + 2);
        if (IN(pb + 3)) { PH_PTRS; PH_IDS;
            for (int u = bx; u < 256; u += G) {
                const int xcd = u & 7, slot = u >> 3, gb = xcd * 4 + (slot >> 3), b = gb >> 3, hd = (gb & 7) * 8 + (slot & 7);
                if (l == 0 && side) ssd_unit<0, true>(P, H, DT, a.in[8] + (size_t)l * 4 * 6144, a.in[9] + (size_t)l * 6144, a.in[10][l * 64 + hd], -expf(a.in[11][l * 64 + hd]), a.in[12][l * 64 + hd], lds, b, hd, tid, lane, wave, a, gw, NGW);
                else ssd_unit<0, false>(P, H, DT, a.in[8] + (size_t)l * 4 * 6144, a.in[9] + (size_t)l * 6144, a.in[10][l * 64 + hd], -expf(a.in[11][l * 64 + hd]), a.in[12][l * 64 + hd], lds, b, hd, tid, lane, wave, a, gw, NGW); }
            phase_attn_merge(P, LSE, lane, gw, NGW);
        }
        SEAM(pb + 3);
        if (IN(pb + 4)) { PH_PTRS; PH_IDS; phase_merge(P, LSE, a.in[13] + (size_t)l * 4096, lane, gw, NGW); }
        SEAM(pb + 4);
        if (IN(pb + 5)) { PH_PTRS;
            { pg8::Gemm g{P + COL_Q, (const bf16_t*)(wb + WO_A), M_TOK, 2048, 512, NPROJ}; pg8::StaticOrder S; S.init(M_TOK, 2048, G, bx);
              pg8::EpiGate<0> E{H, 2048, P + COL_GA, NPROJ}; pg8::gemm_phase<pg8::EpiGate<0>, pg8::StaticOrder, true, true>(lds, g, S, E, wv_s); }
            { pg8::Gemm g{P + COL_Z, (const bf16_t*)(wb + WO_S), M_TOK, 2048, 4096, NPROJ}; pg8::StaticOrder S; S.init(M_TOK, 2048, G, bx);
              pg8::EpiGate<1> E{H, 2048, P + COL_GS, NPROJ}; pg8::gemm_phase<pg8::EpiGate<1>, pg8::StaticOrder, true, true>(lds, g, S, E, wv_s); }
        }
        SEAM(pb + 5);
#if PROBE_MODE > 0
        if (IN(pb + 5) && IN(pb + 6)) { PH_IDS;
#if PROBE_MODE == 1
            phase_attn(P, LSE, a.in[2], lds, bx, G, tid);
#elif PROBE_MODE == 2
            for (int u = bx; u < 256; u += G) {
                const int xcd = u & 7, slot = u >> 3, gb = xcd * 4 + (slot >> 3), b = gb >> 3, hd = (gb & 7) * 8 + (slot & 7);
                ssd_unit<PROBE_VAR, false>(P, H, DT, a.in[8] + (size_t)l * 4 * 6144, a.in[9] + (size_t)l * 6144, a.in[10][l * 64 + hd], -expf(a.in[11][l * 64 + hd]), a.in[12][l * 64 + hd], lds, b, hd, tid, lane, wave, a, gw, NGW); }
#elif PROBE_MODE == 3
            phase_merge(P, LSE, a.in[13] + (size_t)l * 4096, lane, gw, NGW);
#elif PROBE_MODE == 4
            phase_convbc(P, P + (size_t)200000000, a.in[8] + (size_t)l * 4 * 6144, a.in[9] + (size_t)l * 6144, tid, bx, G);
#endif
            grid.sync(); }
#endif
        if (IN(pb + 6)) { PH_PTRS; pg8::Gemm g{H, (const bf16_t*)(wb + WO_O), M_TOK, 2048, 2048, 2048}; pg8::StaticOrder S; S.init(M_TOK, 2048, G, bx);
            pg8::EpiRes2 E{l == 0 ? a.in[0] : nullptr, XB, XB, mod + 4096, 12288}; pg8::gemm_phase<pg8::EpiRes2, pg8::StaticOrder, true, true>(lds, g, S, E, wv_s); }
        SEAM(pb + 6);
        if (IN(pb + 7)) { PH_PTRS; PH_IDS; phase_norm_b<false>(XB, a.in[4] + l * 2048, mod + 8192, mod + 6144, H, nullptr, lane, gw, NGW); }
        SEAM(pb + 7);
        if (IN(pb + 8)) { PH_PTRS; pg8::Gemm g{H, (const bf16_t*)(wb + WO_FI), M_TOK, 2 * D_FF, 2048, 2048}; pg8::StaticOrder S; S.init(M_TOK, 2 * D_FF, G, bx);
            pg8::EpiSwiglu E{P, D_FF}; pg8::gemm_phase<pg8::EpiSwiglu, pg8::StaticOrder, true, true>(lds, g, S, E, wv_s); }
        SEAM(pb + 8);
        if (IN(pb + 9)) { PH_PTRS; pg8::Gemm g{P, (const bf16_t*)(wb + WO_FO), M_TOK, 2048, D_FF, D_FF}; pg8::StaticOrder S; S.init(M_TOK, 2048, G, bx);
            pg8::EpiRes2 E{nullptr, XB, XB, mod + 10240, 12288}; pg8::gemm_phase<pg8::EpiRes2, pg8::StaticOrder, true, true>(lds, g, S, E, wv_s); }
        SEAM(pb + 9);
    }
#if PROBE_MODE == 7
    if (IN(20) && IN(21)) { for (int i = 0; i < 20; ++i) grid.sync(); }
#endif
    if (IN(21)) { PH_IDS; const bf16_t* XBf = (const bf16_t*)(a.ws + WS_XB); phase_norm_b<true>(XBf, a.in[19], nullptr, nullptr, nullptr, out, lane, gw, NGW); }
#undef IN
#undef SEAM
}

extern "C" void kernel_launch(void* const* d_in, const int* in_sizes, int n_in, void* d_out, int out_size, void* d_ws, size_t ws_size, hipStream_t stream) {
    static int grid = 0;
    if (grid == 0) {
        if (n_in != 20 || out_size != M_TOK * D_MODEL || ws_size < WS_END + MiB) { fprintf(stderr, "kernel_launch: unexpected shapes (n_in %d out %d ws %zu need %zu)\n", n_in, out_size, ws_size, (size_t)WS_END); grid = -1; return; }
        int dev = 0, cus = 0, per_cu = 0;
        (void)hipGetDevice(&dev); (void)hipDeviceGetAttribute(&cus, hipDeviceAttributeMultiprocessorCount, dev);
        if (hipFuncSetAttribute((const void*)fwd_kernel, hipFuncAttributeMaxDynamicSharedMemorySize, LDS_BYTES) != hipSuccess) { fprintf(stderr, "kernel_launch: hipFuncSetAttribute failed\n"); grid = -1; return; }
        if (hipOccupancyMaxActiveBlocksPerMultiprocessor(&per_cu, (const void*)fwd_kernel, 512, LDS_BYTES) != hipSuccess || per_cu < 1) { fprintf(stderr, "kernel_launch: occupancy query gave %d\n", per_cu); per_cu = 1; }
        (void)hipGetLastError();
        grid = cus * 1;
        if (grid <= 0) grid = 256;
    }
    if (grid < 0) return;
    (void)hipMemsetAsync((char*)d_ws + WS_CTL, 0, 16384, stream);
    Args a{};
    for (int i = 0; i < 20; ++i) a.in[i] = (const float*)d_in[i];
    a.out = (float*)d_out; a.ws = (unsigned char*)d_ws;
    void* args[] = {&a};
#if MK_SINGLE
    a.ph_lo = 0; a.ph_hi = NPHASE;
    hipError_t e = hipLaunchCooperativeKernel((const void*)fwd_kernel, dim3(grid), dim3(512), args, LDS_BYTES, stream);
    if (e != hipSuccess) fprintf(stderr, "cooperative launch failed: %s (grid %d)\n", hipGetErrorString(e), grid);
#else
    for (int ph = 0; ph < NPHASE; ++ph) { a.ph_lo = ph; a.ph_hi = ph + 1;
        hipError_t e = hipLaunchCooperativeKernel((const void*)fwd_kernel, dim3(grid), dim3(512), args, LDS_BYTES, stream);
        if (e != hipSuccess) { fprintf(stderr, "cooperative launch %d failed: %s (grid %d)\n", ph, hipGetErrorString(e), grid); break; } }
#endif
}
```

```cpp
#include <hip/hip_runtime.h>
#include <hip/hip_cooperative_groups.h>
#include <cstdio>
#include <cstdint>
#include <cmath>
namespace cg = cooperative_groups;
namespace pg8 {
#define PG8_LAS __attribute__((address_space(3)))
typedef unsigned short bf16_t;
typedef short bf16x8 __attribute__((ext_vector_type(8)));
typedef float f32x4 __attribute__((ext_vector_type(4)));
typedef unsigned u32x4 __attribute__((ext_vector_type(4)));
__device__ __forceinline__ int lane_id_mbcnt() { int l; asm volatile("v_mbcnt_lo_u32_b32 %0, -1, 0\n\tv_mbcnt_hi_u32_b32 %0, -1, %0" : "=v"(l)); return l; }
constexpr int BM = 256, BK = 64, HALF = 128, HTB = HALF * BK * 2  , STAGE_BYTES = 8 * HTB, NXCD = 8, WGM = 8;

__host__ __device__ __forceinline__ int lds_byte(int r, int c) { const int st = (r >> 4) * 2 + (c >> 5), rr = r & 15, cc = c & 31, ob = rr * 64 + cc * 2; return st * 1024 + (ob ^ (((ob >> 9) & 1) << 5)); }
__host__ __device__ __forceinline__ void stage_rc(int b, int& R, int& C) { const int st = b / 1024, sb = b % 1024, swz = sb ^ (((sb >> 9) & 1) << 5); R = (st >> 1) * 16 + swz / 64; C = (st & 1) * 32 + (swz % 64) / 2; }
__host__ __device__ __forceinline__ int perm32(int rho) { const int n = rho >> 4, i = rho & 15; return 8 * (i >> 2) + 4 * n + (i & 3); }

struct Unit { int pm, pn; };
struct Gemm { const bf16_t* A; const bf16_t* Bt; int M, N, K, lda; };

struct StaticOrder {
    int nM, nN, nwg, G, c;
    __host__ __device__ void init(int M, int N, int G_, int c_) { nM = M / BM; nN = N / BM; nwg = nM * nN; G = G_; c = c_; }
    __host__ __device__ bool next(int i, Unit& u) const {
        const long L = (long)i * G + c; if (L >= nwg) return false;
        int wgid = (int)L; { const int q = nwg / NXCD, r = nwg % NXCD, xcd = wgid % NXCD, off = wgid / NXCD; wgid = (xcd < r ? xcd * (q + 1) : r * (q + 1) + (xcd - r) * q) + off; }
        const int nig = WGM * nN, gid = wgid / nig, fm = gid * WGM, gsz = (nM - fm) < WGM ? (nM - fm) : WGM;
        u.pm = fm + ((wgid % nig) % gsz); u.pn = (wgid % nig) / gsz; return true;
    }
    __device__ __forceinline__ void a_ready(const Unit&) const {}
    __device__ __forceinline__ void done(const Unit&) const {}
};

__device__ __forceinline__ unsigned cvt_pk_bf16(float lo, float hi) { unsigned r; asm volatile("v_cvt_pk_bf16_f32 %0, %1, %2" : "=v"(r) : "v"(lo), "v"(hi)); return r; }
__device__ __forceinline__ float bflo(unsigned u) { return __uint_as_float(u << 16); }
__device__ __forceinline__ float bfhi(unsigned u) { return __uint_as_float(u & 0xffff0000u); }
__device__ __forceinline__ float sigmoidf_(float x) { return __builtin_amdgcn_rcpf(1.f + __expf(-x)); }
__device__ __forceinline__ float siluf_(float x) { return x * __builtin_amdgcn_rcpf(1.f + __expf(-x)); }

constexpr int NPROJ = 19200;
struct EpiProj {
    static constexpr bool PERM = true, AFTER_DRAIN = false;
    bf16_t* O; float* DT;
    __device__ __forceinline__ void operator()(const f32x4 (&acc)[2][2][4][2], const Unit& u, int wr, int wc, int fr, int fq) const {
        const int row0 = u.pm * BM + wr * 64 + fr;
        if (u.pn == 74) {
            if (wc < 2) {
#pragma unroll
                for (int ai = 0; ai < 2; ++ai)
#pragma unroll
                    for (int m = 0; m < 4; ++m) { float* p = DT + (size_t)(row0 + ai * HALF + m * 16) * 64 + wc * 32 + 8 * fq;
                        *(f32x4*)p = acc[ai][0][m][0]; *(f32x4*)(p + 4) = acc[ai][0][m][1]; }
            }
            return;
        }
        const bool sg = u.pn >= 58, zs = u.pn >= 18 && u.pn < 34;
        const int col0 = u.pn * BM + wc * 32 + 8 * fq;
#pragma unroll
        for (int ai = 0; ai < 2; ++ai)
#pragma unroll
            for (int m = 0; m < 4; ++m) { bf16_t* rowp = O + (size_t)(row0 + ai * HALF + m * 16) * NPROJ + col0;
#pragma unroll
                for (int bj = 0; bj < 2; ++bj) { f32x4 v0 = acc[ai][bj][m][0], v1 = acc[ai][bj][m][1];
                    if (sg || zs) { f32x4 t0, t1;
#pragma unroll
                        for (int j = 0; j < 4; ++j) { t0[j] = __expf(-v0[j]); t1[j] = __expf(-v1[j]); }
#pragma unroll
                        for (int j = 0; j < 4; ++j) { t0[j] = __builtin_amdgcn_rcpf(1.f + t0[j]); t1[j] = __builtin_amdgcn_rcpf(1.f + t1[j]); }
                        if (sg) { v0 = t0; v1 = t1; } else { v0 = v0 * t0; v1 = v1 * t1; } }
                    u32x4 w; w.x = cvt_pk_bf16(v0[0], v0[1]); w.y = cvt_pk_bf16(v0[2], v0[3]); w.z = cvt_pk_bf16(v1[0], v1[1]); w.w = cvt_pk_bf16(v1[2], v1[3]);
                    *(u32x4*)(rowp + bj * HALF) = w; } }
    }
};
template <int MODE> struct EpiGate {
    static constexpr bool PERM = true, AFTER_DRAIN = false;
    bf16_t* O; int ldc; const bf16_t* G; int ldg;
    __device__ __forceinline__ void operator()(const f32x4 (&acc)[2][2][4][2], const Unit& u, int wr, int wc, int fr, int fq) const {
        const int row0 = u.pm * BM + wr * 64 + fr; const int col0 = u.pn * BM + wc * 32 + 8 * fq;
#pragma unroll
        for (int ai = 0; ai < 2; ++ai)
#pragma unroll
            for (int m = 0; m < 4; ++m) { const size_t row = (size_t)(row0 + ai * HALF + m * 16);
#pragma unroll
                for (int bj = 0; bj < 2; ++bj) { const int col = col0 + bj * HALF;
                    const u32x4 gv = *(const u32x4*)(G + row * ldg + col);
                    f32x4 v0 = acc[ai][bj][m][0], v1 = acc[ai][bj][m][1];
                    v0[0] *= bflo(gv.x); v0[1] *= bfhi(gv.x); v0[2] *= bflo(gv.y); v0[3] *= bfhi(gv.y);
                    v1[0] *= bflo(gv.z); v1[1] *= bfhi(gv.z); v1[2] *= bflo(gv.w); v1[3] *= bfhi(gv.w);
                    bf16_t* op = O + row * ldc + col;
                    if (MODE == 1) { const u32x4 ov = *(const u32x4*)op;
                        v0[0] += bflo(ov.x); v0[1] += bfhi(ov.x); v0[2] += bflo(ov.y); v0[3] += bfhi(ov.y);
                        v1[0] += bflo(ov.z); v1[1] += bfhi(ov.z); v1[2] += bflo(ov.w); v1[3] += bfhi(ov.w); }
                    u32x4 w; w.x = cvt_pk_bf16(v0[0], v0[1]); w.y = cvt_pk_bf16(v0[2], v0[3]); w.z = cvt_pk_bf16(v1[0], v1[1]); w.w = cvt_pk_bf16(v1[2], v1[3]);
                    *(u32x4*)op = w; } }
    }
};
struct EpiRes {
    static constexpr bool PERM = false, AFTER_DRAIN = false;
    const float* xin; float* out; const float* gate; int gstride;
    __device__ __forceinline__ void operator()(const f32x4 (&acc)[2][2][4][2], const Unit& u, int wr, int wc, int fr, int fq) const {
        const int row0 = u.pm * BM + wr * 64 + fr; const int col0 = u.pn * BM + wc * 32 + 4 * fq;
        const float* gp = gate + (size_t)(u.pm >> 4) * gstride + col0;
        f32x4 gv[2][2];
#pragma unroll
        for (int bj = 0; bj < 2; ++bj)
#pragma unroll
            for (int n = 0; n < 2; ++n) gv[bj][n] = *(const f32x4*)(gp + bj * HALF + n * 16);
#pragma unroll
        for (int ai = 0; ai < 2; ++ai)
#pragma unroll
            for (int m = 0; m < 4; ++m) { const size_t off = (size_t)(row0 + ai * HALF + m * 16) * 2048 + col0;
#pragma unroll
                for (int bj = 0; bj < 2; ++bj)
#pragma unroll
                    for (int n = 0; n < 2; ++n) { const f32x4 xv = *(const f32x4*)(xin + off + bj * HALF + n * 16);
                        *(f32x4*)(out + off + bj * HALF + n * 16) = xv + gv[bj][n] * acc[ai][bj][m][n]; } }
    }
};
struct EpiRes2 {
    static constexpr bool PERM = true, AFTER_DRAIN = false;
    const float* xin_f; const bf16_t* xin_b; bf16_t* out; const float* gate; int gstride;
    __device__ __forceinline__ void operator()(const f32x4 (&acc)[2][2][4][2], const Unit& u, int wr, int wc, int fr, int fq) const {
        const int row0 = u.pm * BM + wr * 64 + fr; const int col0 = u.pn * BM + wc * 32 + 8 * fq;
        const float* gp = gate + (size_t)(u.pm >> 4) * gstride + col0;
        f32x4 g0[2], g1[2];
#pragma unroll
        for (int bj = 0; bj < 2; ++bj) { g0[bj] = *(const f32x4*)(gp + bj * HALF); g1[bj] = *(const f32x4*)(gp + bj * HALF + 4); }
#pragma unroll
        for (int ai = 0; ai < 2; ++ai)
#pragma unroll
            for (int m = 0; m < 4; ++m) { const size_t off = (size_t)(row0 + ai * HALF + m * 16) * 2048 + col0;
#pragma unroll
                for (int bj = 0; bj < 2; ++bj) { f32x4 x0, x1;
                    if (xin_f) { x0 = *(const f32x4*)(xin_f + off + bj * HALF); x1 = *(const f32x4*)(xin_f + off + bj * HALF + 4); }
                    else { const u32x4 xv = *(const u32x4*)(xin_b + off + bj * HALF);
                        x0 = (f32x4){bflo(xv.x), bfhi(xv.x), bflo(xv.y), bfhi(xv.y)}; x1 = (f32x4){bflo(xv.z), bfhi(xv.z), bflo(xv.w), bfhi(xv.w)}; }
                    const f32x4 v0 = x0 + g0[bj] * acc[ai][bj][m][0], v1 = x1 + g1[bj] * acc[ai][bj][m][1];
                    u32x4 w; w.x = cvt_pk_bf16(v0[0], v0[1]); w.y = cvt_pk_bf16(v0[2], v0[3]); w.z = cvt_pk_bf16(v1[0], v1[1]); w.w = cvt_pk_bf16(v1[2], v1[3]);
                    *(u32x4*)(out + off + bj * HALF) = w; } }
    }
};
struct EpiSwiglu {
    static constexpr bool PERM = true, AFTER_DRAIN = false;
    bf16_t* O; int ldc;
    __device__ __forceinline__ void operator()(const f32x4 (&acc)[2][2][4][2], const Unit& u, int wr, int wc, int fr, int fq) const {
        const int row0 = u.pm * BM + wr * 64 + fr; const int col0 = u.pn * HALF + wc * 32 + 8 * fq;
#pragma unroll
        for (int ai = 0; ai < 2; ++ai)
#pragma unroll
            for (int m = 0; m < 4; ++m) { bf16_t* op = O + (size_t)(row0 + ai * HALF + m * 16) * ldc + col0;
                f32x4 v0, v1;
#pragma unroll
                for (int j = 0; j < 4; ++j) { v0[j] = siluf_(acc[ai][0][m][0][j]) * acc[ai][1][m][0][j]; v1[j] = siluf_(acc[ai][0][m][1][j]) * acc[ai][1][m][1][j]; }
                u32x4 w; w.x = cvt_pk_bf16(v0[0], v0[1]); w.y = cvt_pk_bf16(v0[2], v0[3]); w.z = cvt_pk_bf16(v1[0], v1[1]); w.w = cvt_pk_bf16(v1[2], v1[3]);
                *(u32x4*)op = w; }
    }
};

template <class Epi, class Sched, bool ALIGN_EPI = false, bool SP2 = false>
__device__ __forceinline__ void gemm_phase(PG8_LAS unsigned char* lds, const Gemm g, const Sched& S, const Epi& E, int wave_s) {
    int tid = wave_s * 64 + lane_id_mbcnt(); asm volatile("" : "+v"(tid));        const int wid = __builtin_amdgcn_readfirstlane(tid >> 6), lane = tid & 63, wr = wid >> 2, wc = wid & 3, fr = lane & 15, fq = lane >> 4;
    const int K = g.K, nt = K / BK;
    unsigned voffA[2], voffB[2];
#pragma unroll
    for (int i = 0; i < 2; ++i) { int R, C; stage_rc(tid * 16 + i * 8192, R, C); const int Rb = Epi::PERM ? ((R & ~31) + perm32(R & 31)) : R;
        voffA[i] = (unsigned)(R * g.lda + C) * 2u; voffB[i] = (unsigned)(Rb * K + C) * 2u; }
    const size_t kstep = (size_t)(BK * 2);
    const size_t hstepA = (size_t)HALF * g.lda * 2, hstepB = (size_t)HALF * K * 2;
    const size_t tstepA = 2 * hstepA, tstepB = 2 * hstepB;
    const unsigned ldsw = (unsigned)wid * 1024u;
    const int aoff = lds_byte(wr * 64 + fr, fq * 8), boff = lds_byte(wc * 32 + fr, fq * 8);
#define PG8_SA(b, h) (((b) * 2 + (h)) * HTB)
#define PG8_SB(b, h) ((4 + (b) * 2 + (h)) * HTB)
#define PG8_STAGE(bufoff, gbase, voff) do { _Pragma("unroll") for (int _i = 0; _i < 2; ++_i) \
        __builtin_amdgcn_global_load_lds((const unsigned*)((const char*)(gbase) + (voff)[_i]), (PG8_LAS unsigned*)(lds + (bufoff) + ldsw + _i * 8192), 16, 0, 0); } while (0)
#define PG8_LDA(dst, b, h) do { _Pragma("unroll") for (int m = 0; m < 4; ++m) _Pragma("unroll") for (int k = 0; k < 2; ++k) dst[m][k] = *(const PG8_LAS bf16x8*)(lds + PG8_SA(b, h) + aoff + m * 2048 + k * 1024); } while (0)
#define PG8_LDB(dst, b, h) do { _Pragma("unroll") for (int n = 0; n < 2; ++n) _Pragma("unroll") for (int k = 0; k < 2; ++k) dst[n][k] = *(const PG8_LAS bf16x8*)(lds + PG8_SB(b, h) + boff + n * 2048 + k * 1024); } while (0)
#define PG8_MMA(ai, bj, At, Bt) do { __builtin_amdgcn_s_setprio(1); _Pragma("unroll") for (int m = 0; m < 4; ++m) _Pragma("unroll") for (int n = 0; n < 2; ++n) _Pragma("unroll") for (int k = 0; k < 2; ++k) \
        acc[ai][bj][m][n] = __builtin_amdgcn_mfma_f32_16x16x32_bf16(Bt[n][k], At[m][k], acc[ai][bj][m][n], 0, 0, 0); __builtin_amdgcn_s_setprio(0); } while (0)
#define PG8_WAIT_V(n) asm volatile("s_waitcnt vmcnt(" #n ")" ::: "memory")
#define PG8_WAIT_L(n) asm volatile("s_waitcnt lgkmcnt(" #n ")" ::: "memory")
#define PG8_BAR __builtin_amdgcn_s_barrier()
#define PG8_SCHED __builtin_amdgcn_sched_barrier(0)
    Unit cur, nxt; int ui = 0;
    if (!S.next(0, cur)) return;
    f32x4 acc[2][2][4][2];
#pragma unroll
    for (int a = 0; a < 2; ++a)
#pragma unroll
        for (int b = 0; b < 2; ++b)
#pragma unroll
            for (int m = 0; m < 4; ++m)
#pragma unroll
                for (int n = 0; n < 2; ++n) acc[a][b][m][n] = (f32x4){0.f, 0.f, 0.f, 0.f};
    bf16x8 At[4][2], B0[2][2], B1[2][2];
    const char* cA = (const char*)g.A + (size_t)cur.pm * tstepA; const char* cB = (const char*)g.Bt + (size_t)cur.pn * tstepB;
    S.a_ready(cur);
    if constexpr (SP2) {
        PG8_STAGE(PG8_SB(0, 0), cB, voffB); PG8_STAGE(PG8_SB(0, 1), cB + hstepB, voffB); PG8_STAGE(PG8_SA(0, 0), cA, voffA); PG8_STAGE(PG8_SA(0, 1), cA + hstepA, voffA);
        if (wr == 1) PG8_BAR;
        PG8_WAIT_V(2); PG8_BAR;
        PG8_STAGE(PG8_SB(1, 0), cB + kstep, voffB); PG8_STAGE(PG8_SA(1, 0), cA + kstep, voffA); PG8_STAGE(PG8_SB(1, 1), cB + hstepB + kstep, voffB);
        PG8_WAIT_V(6); PG8_BAR;
    } else {
        PG8_STAGE(PG8_SB(0, 0), cB, voffB); PG8_STAGE(PG8_SA(0, 0), cA, voffA); PG8_STAGE(PG8_SB(0, 1), cB + hstepB, voffB); PG8_STAGE(PG8_SA(0, 1), cA + hstepA, voffA);
        if (wr == 1) PG8_BAR;
        PG8_WAIT_V(4); PG8_BAR;
        PG8_STAGE(PG8_SB(1, 0), cB + kstep, voffB); PG8_STAGE(PG8_SA(1, 0), cA + kstep, voffA); PG8_STAGE(PG8_SB(1, 1), cB + hstepB + kstep, voffB);
        PG8_WAIT_V(6); PG8_BAR;
    }
    for (;;) {
        const bool has_next = S.next(ui + 1, nxt);
        const char* nA = has_next ? (const char*)g.A + (size_t)nxt.pm * tstepA : cA; const char* nB = has_next ? (const char*)g.Bt + (size_t)nxt.pn * tstepB : cB;
        for (int t = 0; t < nt; t += 2) {
            const bool last = (t == nt - 2);
            const char* a1 = cA + (size_t)(t + 1) * kstep;
            const char* a2 = last ? nA : cA + (size_t)(t + 2) * kstep; const char* b2 = last ? nB : cB + (size_t)(t + 2) * kstep;
            const char* a3 = a2 + kstep; const char* b3 = b2 + kstep;
            if (last && has_next) S.a_ready(nxt);
            if constexpr (SP2) {
            PG8_LDB(B0, 0, 0); PG8_LDB(B1, 0, 1); PG8_SCHED; PG8_LDA(At, 0, 0); PG8_STAGE(PG8_SA(1, 1), a1 + hstepA, voffA);
            PG8_WAIT_V(8); PG8_WAIT_L(0); PG8_BAR; PG8_MMA(0, 0, At, B0); PG8_MMA(0, 1, At, B1); PG8_BAR; PG8_SCHED;
            PG8_LDA(At, 0, 1); PG8_STAGE(PG8_SB(0, 0), b2, voffB); PG8_STAGE(PG8_SB(0, 1), b2 + hstepB, voffB); PG8_STAGE(PG8_SA(0, 0), a2, voffA);
            PG8_WAIT_V(8); PG8_WAIT_L(0); PG8_BAR; PG8_MMA(1, 0, At, B0); PG8_MMA(1, 1, At, B1); PG8_BAR; PG8_SCHED;
            PG8_LDB(B0, 1, 0); PG8_LDB(B1, 1, 1); PG8_SCHED; PG8_LDA(At, 1, 0); PG8_STAGE(PG8_SA(0, 1), a2 + hstepA, voffA);
            PG8_WAIT_V(8); PG8_WAIT_L(0); PG8_BAR; PG8_MMA(0, 0, At, B0); PG8_MMA(0, 1, At, B1); PG8_BAR; PG8_SCHED;
            PG8_LDA(At, 1, 1); PG8_STAGE(PG8_SB(1, 0), b3, voffB); PG8_STAGE(PG8_SB(1, 1), b3 + hstepB, voffB); PG8_STAGE(PG8_SA(1, 0), a3, voffA);
            PG8_WAIT_V(8); PG8_WAIT_L(0); PG8_BAR; PG8_MMA(1, 0, At, B0); PG8_MMA(1, 1, At, B1); PG8_BAR; PG8_SCHED;
            } else {
            PG8_LDB(B0, 0, 0); PG8_SCHED; PG8_LDA(At, 0, 0); PG8_STAGE(PG8_SA(1, 1), a1 + hstepA, voffA);
            PG8_WAIT_L(8); PG8_BAR; PG8_WAIT_L(0); PG8_MMA(0, 0, At, B0); PG8_BAR; PG8_SCHED;
            PG8_LDB(B1, 0, 1); PG8_STAGE(PG8_SB(0, 0), b2, voffB);
            PG8_BAR; PG8_WAIT_L(0); PG8_MMA(0, 1, At, B1); PG8_BAR;
            PG8_LDA(At, 0, 1); PG8_STAGE(PG8_SA(0, 0), a2, voffA);
            PG8_BAR; PG8_WAIT_L(0); PG8_MMA(1, 0, At, B0); PG8_BAR; PG8_SCHED;
            PG8_STAGE(PG8_SB(0, 1), b2 + hstepB, voffB);
            PG8_WAIT_V(6); PG8_BAR; PG8_MMA(1, 1, At, B1); PG8_BAR;
            PG8_LDB(B0, 1, 0); PG8_SCHED; PG8_LDA(At, 1, 0); PG8_STAGE(PG8_SA(0, 1), a2 + hstepA, voffA);
            PG8_WAIT_L(8); PG8_BAR; PG8_WAIT_L(0); PG8_MMA(0, 0, At, B0); PG8_BAR; PG8_SCHED;
            PG8_LDB(B1, 1, 1); PG8_STAGE(PG8_SB(1, 0), b3, voffB);
            PG8_BAR; PG8_WAIT_L(0); PG8_MMA(0, 1, At, B1); PG8_BAR;
            PG8_LDA(At, 1, 1); PG8_STAGE(PG8_SA(1, 0), a3, voffA);
            PG8_BAR; PG8_WAIT_L(0); PG8_MMA(1, 0, At, B0); PG8_BAR; PG8_SCHED;
            PG8_STAGE(PG8_SB(1, 1), b3 + hstepB, voffB);
            PG8_WAIT_V(6); PG8_BAR; PG8_MMA(1, 1, At, B1); PG8_BAR;
            }
        }
        if constexpr (ALIGN_EPI) { if (wr == 0) PG8_BAR; }
        if constexpr (!Epi::AFTER_DRAIN) { E(acc, cur, wr, wc, fr, fq); S.done(cur); }
        if (!has_next) break;
#pragma unroll
        for (int a = 0; a < 2; ++a)
#pragma unroll
            for (int b = 0; b < 2; ++b)
#pragma unroll
                for (int m = 0; m < 4; ++m)
#pragma unroll
                    for (int n = 0; n < 2; ++n) acc[a][b][m][n] = (f32x4){0.f, 0.f, 0.f, 0.f};
        cur = nxt; cA = nA; cB = nB; ++ui;
        if constexpr (ALIGN_EPI) { if (wr == 1) PG8_BAR; }
    }
    PG8_WAIT_V(0);
    if constexpr (!ALIGN_EPI) { if (wr == 0) PG8_BAR; }
    PG8_BAR;
    if constexpr (Epi::AFTER_DRAIN) { E.fused(acc, cur, wr, wc, fr, fq, lds, wid, lane); S.done(cur); }
#undef PG8_SA
#undef PG8_SB
#undef PG8_STAGE
#undef PG8_LDA
#undef PG8_LDB
#undef PG8_MMA
#undef PG8_WAIT_V
#undef PG8_WAIT_L
#undef PG8_BAR
#undef PG8_SCHED
}
}
#define LAS __attribute__((address_space(3)))
typedef unsigned short bf16_t;
typedef short bf16x8 __attribute__((ext_vector_type(8)));
typedef short s16x4 __attribute__((ext_vector_type(4)));
typedef float f32x4 __attribute__((ext_vector_type(4)));
typedef unsigned u32x4 __attribute__((ext_vector_type(4)));
typedef unsigned u32x2 __attribute__((ext_vector_type(2)));
using pg8::cvt_pk_bf16; using pg8::bflo; using pg8::bfhi; using pg8::siluf_;

constexpr int D_MODEL = 2048, SEQ = 4096, M_TOK = 16384;
constexpr int NPROJ = pg8::NPROJ;
constexpr int N_IN = 19008, D_FF = 5632;
constexpr int COL_Q = 0, COL_K = 1536, COL_V = 3072, COL_Z = 4608, COL_XBC = 8704, COL_GA = 14848, COL_GS = 16896;
constexpr int NPHASE = 22;

constexpr size_t MiB = 1u << 20;
constexpr size_t WS_CTL = 0, CTL_ZERO_BYTES = 1 * MiB;
constexpr size_t WS_MOD = 65536;
constexpr size_t WS_LSE = 1 * MiB;
constexpr size_t WS_DT = 2 * MiB;
constexpr size_t WS_W = 8 * MiB;
constexpr size_t WO_IN = 0, WO_A = 78643200, WO_S = 80740352, WO_O = 97517568, WO_FI = 105906176, WO_FO = 152043520, WL_BYTES = 175112192;
constexpr size_t WS_H = WS_W + 2 * WL_BYTES;
constexpr size_t WS_PROJ = WS_H + (size_t)M_TOK * 2048 * 2;
constexpr size_t WS_XB = WS_PROJ + (size_t)M_TOK * NPROJ * 2;
constexpr size_t WS_END = WS_XB + (size_t)M_TOK * 2048 * 2;
constexpr int LDS_BYTES = 147456;

struct Args { const float* in[20]; float* out; unsigned char* ws; int ph_lo, ph_hi; };

template <int CTRL> __device__ __forceinline__ float dpp_f(float v) { return __int_as_float(__builtin_amdgcn_update_dpp(0, __float_as_int(v), CTRL, 0xf, 0xf, false)); }
__device__ __forceinline__ float xor16_sum(float v) { const auto r = __builtin_amdgcn_permlane16_swap(__float_as_uint(v), __float_as_uint(v), false, false); return __uint_as_float(r[0]) + __uint_as_float(r[1]); }
__device__ __forceinline__ float xor32_sum(float v) { const auto r = __builtin_amdgcn_permlane32_swap(__float_as_uint(v), __float_as_uint(v), false, false); return __uint_as_float(r[0]) + __uint_as_float(r[1]); }
__device__ __forceinline__ float xor16_max(float v) { const auto r = __builtin_amdgcn_permlane16_swap(__float_as_uint(v), __float_as_uint(v), false, false); return fmaxf(__uint_as_float(r[0]), __uint_as_float(r[1])); }
__device__ __forceinline__ float xor32_max(float v) { const auto r = __builtin_amdgcn_permlane32_swap(__float_as_uint(v), __float_as_uint(v), false, false); return fmaxf(__uint_as_float(r[0]), __uint_as_float(r[1])); }
__device__ __forceinline__ float wave_sum(float v) {
    v += dpp_f<0x128>(v); v += dpp_f<0x124>(v); v += dpp_f<0x122>(v); v += dpp_f<0x121>(v);
    v = xor16_sum(v); v = xor32_sum(v);
    return v;
}
__device__ __forceinline__ float wave_incl_scan(float v, int lane) {
#pragma unroll
    for (int o = 1; o < 64; o <<= 1) { const float t = __int_as_float(__builtin_amdgcn_ds_bpermute(((lane - o) & 63) << 2, __float_as_int(v))); if (lane >= o) v += t; }
    return v;
}
__device__ __forceinline__ float lane63(float v) { return __int_as_float(__builtin_amdgcn_readlane(__float_as_int(v), 63)); }
typedef short v4i16_t __attribute__((ext_vector_type(4)));
__device__ __forceinline__ s16x4 ldtr(LAS unsigned char* p) { return __builtin_bit_cast(s16x4, __builtin_amdgcn_ds_read_tr16_b64_v4i16((LAS v4i16_t*)p)); }
__device__ __forceinline__ bf16x8 cat8(s16x4 lo, s16x4 hi) { return (bf16x8){lo[0], lo[1], lo[2], lo[3], hi[0], hi[1], hi[2], hi[3]}; }
__device__ __forceinline__ f32x4 mfma16(bf16x8 a, bf16x8 b, f32x4 c) { return __builtin_amdgcn_mfma_f32_16x16x32_bf16(a, b, c, 0, 0, 0); }
#define LDS_WAIT() asm volatile("s_waitcnt lgkmcnt(0)" ::: "memory")
#define LDS_BARRIER() asm volatile("s_waitcnt lgkmcnt(0)\n\ts_barrier" ::: "memory")

__device__ __forceinline__ void tr_item(const float* W, int Nsrc, bf16_t* WT, int K, int k0, int s0, int n0, LAS float* scr, int lane) {
    const int c = lane & 7;
    if (s0 < 0) {
#pragma unroll
        for (int j = 0; j < 4; ++j) { const int n = (lane >> 3) + 8 * j; *(u32x4*)(WT + (size_t)(n0 + n) * K + k0 + 8 * c) = (u32x4){0u, 0u, 0u, 0u}; }
        return;
    }
    { const float* wp = W + (size_t)(k0 + (lane >> 5)) * Nsrc + s0 + (lane & 31); float v[32];
#pragma unroll
        for (int i = 0; i < 32; ++i) v[i] = __builtin_nontemporal_load(wp + (size_t)(2 * i) * Nsrc);
#pragma unroll
        for (int i = 0; i < 32; ++i) scr[(2 * i + (lane >> 5)) * 33 + (lane & 31)] = v[i]; }
    LDS_WAIT();
#pragma unroll
    for (int j = 0; j < 4; ++j) { const int n = (lane >> 3) + 8 * j; const LAS float* s = scr + (8 * c) * 33 + n;
        u32x4 o; o.x = cvt_pk_bf16(s[0 * 33], s[1 * 33]); o.y = cvt_pk_bf16(s[2 * 33], s[3 * 33]); o.z = cvt_pk_bf16(s[4 * 33], s[5 * 33]); o.w = cvt_pk_bf16(s[6 * 33], s[7 * 33]);
        *(u32x4*)(WT + (size_t)(n0 + n) * K + k0 + 8 * c) = o; }
    LDS_WAIT();
}

struct SideItem { const float* src; bf16_t* dst; int nsrc; int mode; };
constexpr int IPL32 = 38400 + 1024 + 8192 + 4096 + 22528 + 11264;
__device__ __forceinline__ SideItem side_decode(const Args& a, int l, int it, int lane);
__device__ __forceinline__ void side_issue(const SideItem& s, float (&v)[16]);
__device__ __forceinline__ void side_drain(const SideItem& s, const float (&v)[16]);
__device__ __forceinline__ void phase_prep(const Args& a, LAS unsigned char* lds, int tid, int lane, int wave, int bx, int G, int nlayers) {
    float* MOD = (float*)(a.ws + WS_MOD);
    const float* cin = a.in[1]; const float* w_mod = a.in[5]; const float* b_mod = a.in[6];
    LAS f32x4* red = (LAS f32x4*)lds;
    for (int it = bx; it < 256; it += G) {
        const int l = it >> 7, c96 = it & 127;
        const int par = lane >= 24 ? 1 : 0, cl = lane - 24 * par; const bool act = lane < 48;
        const float* Wm = w_mod + (size_t)l * 2048 * 12288 + c96 * 96 + (act ? cl : 0) * 4;
        const int k0 = wave * 256 + par;
        f32x4 acc0 = {0.f, 0.f, 0.f, 0.f}, acc1 = acc0, acc2 = acc0, acc3 = acc0;
#pragma unroll 8
        for (int kk = 0; kk < 128; ++kk) { const int k = k0 + 2 * kk; const f32x4 wv = __builtin_nontemporal_load((const f32x4*)(Wm + (size_t)k * 12288));
            acc0 += siluf_(cin[k]) * wv; acc1 += siluf_(cin[2048 + k]) * wv; acc2 += siluf_(cin[4096 + k]) * wv; acc3 += siluf_(cin[6144 + k]) * wv; }
        if (act) { LAS f32x4* rp = red + ((wave * 2 + par) * 4) * 24 + cl; rp[0] = acc0; rp[24] = acc1; rp[48] = acc2; rp[72] = acc3; }
        __syncthreads();
        if (tid < 384) { const int b = tid / 96, ci = tid % 96; float s = b_mod[l * 12288 + c96 * 96 + ci];
#pragma unroll
            for (int w = 0; w < 16; ++w) s += ((const LAS float*)lds)[((w * 4 + b) * 24 + (ci >> 2)) * 4 + (ci & 3)];
            MOD[(size_t)(l * 4 + b) * 12288 + c96 * 96 + ci] = s; }
        __syncthreads();
    }
    LAS float* scr = (LAS float*)(lds + wave * 8704);
    const int gw = bx * 8 + wave, NGW = G * 8;
    constexpr int IPL = 19200 + 512 + 4096 + 2048 + 11264 + 5632;
    for (int it = gw; it < nlayers * IPL; it += NGW) {
        const int l = it / IPL; int r = it % IPL;
        unsigned char* wb = a.ws + WS_W + (size_t)l * WL_BYTES;
        if (r < 19200) { const int kb = r / 600, nb = r % 600, n0 = nb * 32;
            const int s0 = n0 < 14848 ? n0 : (n0 < 18944 ? n0 + 64 : (n0 < 19008 ? 14848 + (n0 - 18944) : -1));
            tr_item(a.in[7] + (size_t)l * 2048 * N_IN, N_IN, (bf16_t*)(wb + WO_IN), 2048, kb * 64, s0, n0, scr, lane); continue; }
        r -= 19200;
        if (r < 512) { const int kb = r >> 6, nb = r & 63; tr_item(a.in[14] + (size_t)l * 512 * 2048, 2048, (bf16_t*)(wb + WO_A), 512, kb * 64, nb * 32, nb * 32, scr, lane); continue; }
        r -= 512;
        if (r < 4096) { const int kb = r >> 6, nb = r & 63; tr_item(a.in[15] + (size_t)l * 4096 * 2048, 2048, (bf16_t*)(wb + WO_S), 4096, kb * 64, nb * 32, nb * 32, scr, lane); continue; }
        r -= 4096;
        if (r < 2048) { const int kb = r >> 6, nb = r & 63; tr_item(a.in[16] + (size_t)l * 2048 * 2048, 2048, (bf16_t*)(wb + WO_O), 2048, kb * 64, nb * 32, nb * 32, scr, lane); continue; }
        r -= 2048;
        if (r < 11264) { const int kb = r / 352, nb = r % 352, n0 = nb * 32, t = n0 >> 8, j = n0 & 255;
            const int s0 = j < 128 ? 128 * t + j : D_FF + 128 * t + (j - 128);
            tr_item(a.in[17] + (size_t)l * 2048 * 2 * D_FF, 2 * D_FF, (bf16_t*)(wb + WO_FI), 2048, kb * 64, s0, n0, scr, lane); continue; }
        r -= 11264;
        { const int kb = r >> 6, nb = r & 63; tr_item(a.in[18] + (size_t)l * D_FF * 2048, 2048, (bf16_t*)(wb + WO_FO), D_FF, kb * 64, nb * 32, nb * 32, scr, lane); }
    }
    if (nlayers == 1) {
        for (int it = 32 * NGW + gw; it < IPL32; it += NGW) { float v[16]; const SideItem sd = side_decode(a, 1, it, lane); side_issue(sd, v); side_drain(sd, v); }
    }
}

template <bool FINAL>
__device__ __forceinline__ void phase_norm(const float* x, const float* w, const float* sc, const float* sh, bf16_t* H, float* outf, int lane, int gw, int NGW) {
    for (int blk = gw; blk < M_TOK / 8; blk += NGW) {
        const int m0 = blk * 8, b = m0 >> 12;
        f32x4 A[8], B[8];
#pragma unroll
        for (int j = 0; j < 8; ++j) { const int col = 4 * (lane + 64 * j); A[j] = *(const f32x4*)(w + col);
            if (!FINAL) { const f32x4 scv = *(const f32x4*)(sc + (size_t)b * 12288 + col); A[j] = A[j] * (1.0f + scv); B[j] = *(const f32x4*)(sh + (size_t)b * 12288 + col); } }
        f32x4 v[8], nx[8];
        { const f32x4* xr = (const f32x4*)(x + (size_t)m0 * 2048) + lane;
#pragma unroll
            for (int j = 0; j < 8; ++j) nx[j] = xr[64 * j]; }
#pragma unroll 1
        for (int r = 0; r < 8; ++r) { const int m = m0 + r;
#pragma unroll
            for (int j = 0; j < 8; ++j) v[j] = nx[j];
            if (r + 1 < 8) { const f32x4* xr = (const f32x4*)(x + (size_t)(m + 1) * 2048) + lane;
#pragma unroll
                for (int j = 0; j < 8; ++j) nx[j] = xr[64 * j]; }
            float ss = 0.f;
#pragma unroll
            for (int j = 0; j < 8; ++j) ss += (v[j].x * v[j].x + v[j].y * v[j].y) + (v[j].z * v[j].z + v[j].w * v[j].w);
            ss = wave_sum(ss);
            const float rstd = 1.0f / sqrtf(ss * (1.0f / 2048.0f) + 1e-6f);
#pragma unroll
            for (int j = 0; j < 8; ++j) { const int col = 4 * (lane + 64 * j);
                if (FINAL) { *(f32x4*)(outf + (size_t)m * 2048 + col) = v[j] * rstd * A[j]; }
                else { const f32x4 o = v[j] * rstd * A[j] + B[j];
                    u32x2 pk; pk.x = cvt_pk_bf16(o.x, o.y); pk.y = cvt_pk_bf16(o.z, o.w);
                    *(u32x2*)(H + (size_t)m * 2048 + col) = pk; } }
        }
    }
}

template <bool FINAL>
__device__ __forceinline__ void phase_norm_b(const bf16_t* xb, const float* w, const float* sc, const float* sh, bf16_t* H, float* outf, int lane, int gw, int NGW) {
    for (int blk = gw; blk < M_TOK / 8; blk += NGW) {
        const int m0 = blk * 8, b = m0 >> 12;
        f32x4 A0[4], A1[4], B0[4], B1[4];
#pragma unroll
        for (int j = 0; j < 4; ++j) { const int col = 8 * (lane + 64 * j); A0[j] = *(const f32x4*)(w + col); A1[j] = *(const f32x4*)(w + col + 4);
            if (!FINAL) { const float* scp = sc + (size_t)b * 12288 + col; const float* shp = sh + (size_t)b * 12288 + col;
                A0[j] = A0[j] * (1.0f + *(const f32x4*)scp); A1[j] = A1[j] * (1.0f + *(const f32x4*)(scp + 4)); B0[j] = *(const f32x4*)shp; B1[j] = *(const f32x4*)(shp + 4); } }
        u32x4 nx[4];
        { const u32x4* xr = (const u32x4*)(xb + (size_t)m0 * 2048) + lane;
#pragma unroll
            for (int j = 0; j < 4; ++j) nx[j] = xr[64 * j]; }
#pragma unroll 1
        for (int r = 0; r < 8; ++r) { const int m = m0 + r;
            f32x4 v0[4], v1[4];
#pragma unroll
            for (int j = 0; j < 4; ++j) { const u32x4 q = nx[j]; v0[j] = (f32x4){bflo(q.x), bfhi(q.x), bflo(q.y), bfhi(q.y)}; v1[j] = (f32x4){bflo(q.z), bfhi(q.z), bflo(q.w), bfhi(q.w)}; }
            if (r + 1 < 8) { const u32x4* xr = (const u32x4*)(xb + (size_t)(m + 1) * 2048) + lane;
#pragma unroll
                for (int j = 0; j < 4; ++j) nx[j] = xr[64 * j]; }
            float ss = 0.f;
#pragma unroll
            for (int j = 0; j < 4; ++j) { const f32x4 q0 = v0[j] * v0[j], q1 = v1[j] * v1[j]; ss += ((q0.x + q0.y) + (q0.z + q0.w)) + ((q1.x + q1.y) + (q1.z + q1.w)); }
            ss = wave_sum(ss);
            const float rstd = 1.0f / sqrtf(ss * (1.0f / 2048.0f) + 1e-6f);
#pragma unroll
            for (int j = 0; j < 4; ++j) { const int col = 8 * (lane + 64 * j);
                if (FINAL) { *(f32x4*)(outf + (size_t)m * 2048 + col) = v0[j] * rstd * A0[j]; *(f32x4*)(outf + (size_t)m * 2048 + col + 4) = v1[j] * rstd * A1[j]; }
                else { const f32x4 o0 = v0[j] * rstd * A0[j] + B0[j], o1 = v1[j] * rstd * A1[j] + B1[j];
                    u32x4 pk; pk.x = cvt_pk_bf16(o0.x, o0.y); pk.y = cvt_pk_bf16(o0.z, o0.w); pk.z = cvt_pk_bf16(o1.x, o1.y); pk.w = cvt_pk_bf16(o1.z, o1.w);
                    *(u32x4*)(H + (size_t)m * 2048 + col) = pk; } }
        }
    }
}

__device__ __forceinline__ void att_decode(int u, int& g, int& b, int& hh, int& d, int& r, int& n) {
    g = u >> 9; const int rem = u & 511; b = rem >> 7; hh = (rem >> 5) & 3; const int bi = rem & 31;
    d = g == 0 ? 1 : (g == 1 ? 4 : 16); const int nb = 32 / d; r = bi / nb; n = bi % nb;
}
__device__ __forceinline__ void phase_attn(bf16_t* P, float* LSE, const float* rel_bias, LAS unsigned char* lds, int bx, int G, int tid_) {
    int tid = tid_; asm volatile("" : "+v"(tid)); const int lane = tid & 63, wave = __builtin_amdgcn_readfirstlane(tid >> 6);
    constexpr int RS = 272;
    LAS unsigned char* Ks = lds; LAS unsigned char* Vs = lds + 256 * RS; LAS float* biasT = (LAS float*)(lds + 2 * 256 * RS);
    const int l15 = lane & 15, q4 = lane >> 4, qi = 16 * wave + l15;
    int u = bx; if (u >= 1536) return;
    u32x4 kr[8], vr[8]; bf16x8 Qn[4];
#define ATT_LOAD(uu) do { int g_, b_, hh_, d_, r_, n_; att_decode((uu), g_, b_, hh_, d_, r_, n_); const int colq_ = g_ * 512 + hh_ * 128; \
        _Pragma("unroll") for (int i = 0; i < 8; ++i) { const int idx = tid + 512 * i, key = idx >> 4, ch = idx & 15; const int si = (n_ - 1) * 128 + key; \
            kr[i] = (u32x4){0u, 0u, 0u, 0u}; vr[i] = (u32x4){0u, 0u, 0u, 0u}; \
            if (n_ > 0 || i >= 4) { const bf16_t* rp = P + (size_t)(b_ * SEQ + si * d_ + r_) * NPROJ + colq_ + ch * 8; kr[i] = *(const u32x4*)(rp + COL_K); vr[i] = *(const u32x4*)(rp + COL_V); } } \
        { const bf16_t* qp_ = P + (size_t)(b_ * SEQ + (n_ * 128 + qi) * d_ + r_) * NPROJ + colq_; \
          _Pragma("unroll") for (int ks = 0; ks < 4; ++ks) Qn[ks] = *(const bf16x8*)(qp_ + 32 * ks + 8 * q4); } } while (0)
    ATT_LOAD(u);
    for (;;) {
        int g, b, hh, d, r, n; att_decode(u, g, b, hh, d, r, n);
        const int colq = g * 512 + hh * 128;
#pragma unroll
        for (int i = 0; i < 8; ++i) { const int idx = tid + 512 * i, key = idx >> 4, ch = idx & 15;
            *(LAS u32x4*)(Ks + key * RS + ch * 16) = kr[i]; *(LAS u32x4*)(Vs + key * RS + ch * 16) = vr[i]; }
        if (tid < 160) { const int steps = tid - 15; float bv = -INFINITY;
            if (steps >= 0 && steps <= 128) { const int dist = steps * d; int bk;
                if (dist < 16) bk = dist; else { const int lg = 16 + (int)(logf((float)dist / 16.0f) / 4.852030263919617f * 16.0f); bk = lg < 31 ? lg : 31; }
                bv = rel_bias[bk * 12 + g * 4 + hh]; }
            biasT[tid] = bv; }
        bf16x8 Qf[4];
#pragma unroll
        for (int ks = 0; ks < 4; ++ks) Qf[ks] = Qn[ks];
        LDS_BARRIER();
        const int un = u + G;
        if (un < 1536) ATT_LOAD(un);
        const size_t tq = (size_t)(b * SEQ + (n * 128 + qi) * d + r);
        bf16_t* qp = P + tq * NPROJ + colq;
        f32x4 S[9];
        LAS unsigned char* kbase = Ks + (16 * wave + l15) * RS + q4 * 16;
#pragma unroll
        for (int tt = 0; tt < 9; ++tt) { S[tt] = (f32x4){0.f, 0.f, 0.f, 0.f};
#pragma unroll
            for (int ks = 0; ks < 4; ++ks) { const bf16x8 Kf = *(const LAS bf16x8*)(kbase + tt * 16 * RS + ks * 64); S[tt] = mfma16(Kf, Qf[ks], S[tt]); } }
        __builtin_amdgcn_sched_barrier(0);
        const float scale = 0.08838834764831845f;
        float mx = -INFINITY;
        {
            const LAS float* bp = biasT + (143 + l15 - 4 * q4);
#pragma unroll
            for (int tt = 0; tt < 9; ++tt)
#pragma unroll
                for (int e = 0; e < 4; ++e) S[tt][e] = S[tt][e] * scale + bp[-(16 * tt + e)];
            if (n == 0) {
#pragma unroll
                for (int tt = 0; tt < 9; ++tt)
#pragma unroll
                    for (int e = 0; e < 4; ++e) { if (wave + tt < 8) S[tt][e] = -INFINITY; }
            }
#pragma unroll
            for (int tt = 0; tt < 9; ++tt)
#pragma unroll
                for (int e = 0; e < 4; ++e) mx = fmaxf(mx, S[tt][e]);
        }
        mx = xor16_max(mx); mx = xor32_max(mx);
        float sum = 0.f;
#pragma unroll
        for (int tt = 0; tt < 9; ++tt)
#pragma unroll
            for (int e = 0; e < 4; ++e) { const float p = __expf(S[tt][e] - mx); S[tt][e] = p; sum += p; }
        sum = xor16_sum(sum); sum = xor32_sum(sum);
        bf16x8 Pf[5];
#pragma unroll
        for (int kk = 0; kk < 5; ++kk) { u32x4 w; w.x = cvt_pk_bf16(S[2 * kk][0], S[2 * kk][1]); w.y = cvt_pk_bf16(S[2 * kk][2], S[2 * kk][3]);
            if (kk < 4) { w.z = cvt_pk_bf16(S[2 * kk + 1][0], S[2 * kk + 1][1]); w.w = cvt_pk_bf16(S[2 * kk + 1][2], S[2 * kk + 1][3]); } else { w.z = 0u; w.w = 0u; }
            Pf[kk] = __builtin_bit_cast(bf16x8, w); }
        const float inv = 1.0f / sum;
        LAS unsigned char* vbase = Vs + (16 * wave + 4 * q4 + (l15 >> 2)) * RS + (l15 & 3) * 8;
        bf16_t* op = qp + 4 * q4;
#pragma unroll
        for (int dt = 0; dt < 8; ++dt) { f32x4 o = {0.f, 0.f, 0.f, 0.f};
#pragma unroll
            for (int kk = 0; kk < 5; ++kk) {
                const s16x4 lo = ldtr(vbase + (32 * kk) * RS + dt * 32);
                s16x4 hi = {0, 0, 0, 0};
                if (kk < 4) hi = ldtr(vbase + (32 * kk + 16) * RS + dt * 32);
                o = mfma16(cat8(lo, hi), Pf[kk], o); }
            u32x2 pk; pk.x = cvt_pk_bf16(o[0] * inv, o[1] * inv); pk.y = cvt_pk_bf16(o[2] * inv, o[3] * inv);
            *(u32x2*)(op + 16 * dt) = pk;
            __builtin_amdgcn_sched_barrier(0); }
        if (q4 == 0) LSE[tq * 12 + g * 4 + hh] = mx + logf(sum);
        LDS_BARRIER();
        if (un >= 1536) break;
        u = un;
    }
#undef ATT_LOAD
}

__device__ __forceinline__ SideItem side_decode(const Args& a, int l, int it, int lane) {
    SideItem s; s.src = nullptr; s.dst = nullptr; s.nsrc = 0; s.mode = 0;
    if (it >= IPL32) return s;
    unsigned char* wb = a.ws + WS_W + (size_t)l * WL_BYTES;
    const float* W; bf16_t* WT; int K, Nsrc, kb, nb, s0;
    int r = it;
    if (r < 38400) { kb = r / 600; nb = r % 600; const int n0 = nb * 32; s0 = n0 < 14848 ? n0 : (n0 < 18944 ? n0 + 64 : (n0 < 19008 ? 14848 + (n0 - 18944) : -1));
        W = a.in[7] + (size_t)l * 2048 * N_IN; Nsrc = N_IN; WT = (bf16_t*)(wb + WO_IN); K = 2048; }
    else if ((r -= 38400) < 1024) { kb = r >> 6; nb = r & 63; s0 = nb * 32; W = a.in[14] + (size_t)l * 512 * 2048; Nsrc = 2048; WT = (bf16_t*)(wb + WO_A); K = 512; }
    else if ((r -= 1024) < 8192) { kb = r >> 6; nb = r & 63; s0 = nb * 32; W = a.in[15] + (size_t)l * 4096 * 2048; Nsrc = 2048; WT = (bf16_t*)(wb + WO_S); K = 4096; }
    else if ((r -= 8192) < 4096) { kb = r >> 6; nb = r & 63; s0 = nb * 32; W = a.in[16] + (size_t)l * 2048 * 2048; Nsrc = 2048; WT = (bf16_t*)(wb + WO_O); K = 2048; }
    else if ((r -= 4096) < 22528) { kb = r / 352; nb = r % 352; const int n0 = nb * 32, t = n0 >> 8, j = n0 & 255; s0 = j < 128 ? 128 * t + j : D_FF + 128 * t + (j - 128);
        W = a.in[17] + (size_t)l * 2048 * 2 * D_FF; Nsrc = 2 * D_FF; WT = (bf16_t*)(wb + WO_FI); K = 2048; }
    else { r -= 22528; kb = r >> 6; nb = r & 63; s0 = nb * 32; W = a.in[18] + (size_t)l * D_FF * 2048; Nsrc = 2048; WT = (bf16_t*)(wb + WO_FO); K = D_FF; }
    const int n = lane & 31, kh = lane >> 5, k0 = kb * 32 + 16 * kh;
    s.dst = WT + (size_t)(nb * 32 + n) * K + k0; s.nsrc = Nsrc;
    if (s0 < 0) { s.mode = 2; } else { s.mode = 1; s.src = W + (size_t)k0 * Nsrc + s0 + n; }
    return s;
}
__device__ __forceinline__ void side_issue(const SideItem& s, float (&v)[16]) {
    if (s.mode == 1) {
#pragma unroll
        for (int j = 0; j < 16; ++j) v[j] = s.src[(size_t)j * s.nsrc]; }
}
__device__ __forceinline__ void side_drain(const SideItem& s, const float (&v)[16]) {
    if (s.mode == 0) return;
    u32x4 w0 = {0u, 0u, 0u, 0u}, w1 = {0u, 0u, 0u, 0u};
    if (s.mode == 1) { w0.x = cvt_pk_bf16(v[0], v[1]); w0.y = cvt_pk_bf16(v[2], v[3]); w0.z = cvt_pk_bf16(v[4], v[5]); w0.w = cvt_pk_bf16(v[6], v[7]);
        w1.x = cvt_pk_bf16(v[8], v[9]); w1.y = cvt_pk_bf16(v[10], v[11]); w1.z = cvt_pk_bf16(v[12], v[13]); w1.w = cvt_pk_bf16(v[14], v[15]); }
    *(u32x4*)s.dst = w0; *(u32x4*)(s.dst + 8) = w1;
}

__device__ __forceinline__ void phase_convbc(const bf16_t* P, bf16_t* HBC, const float* conv_w, const float* conv_b, int tid, int bx, int G) {
    const int chunk = tid & 255, rh = tid >> 8, col = 4096 + chunk * 8;
    float cw[4][8], cbias[8];
#pragma unroll
    for (int e = 0; e < 8; ++e) { cbias[e] = conv_b[col + e];
#pragma unroll
        for (int j = 0; j < 4; ++j) cw[j][e] = conv_w[j * 6144 + col + e]; }
    for (int it = bx; it < M_TOK / 32; it += G) {
        const int r0 = it * 32 + rh * 16; const bool halo = (r0 & (SEQ - 1)) != 0;
        const bf16_t* src = P + (size_t)r0 * NPROJ + COL_XBC + col;
        u32x4 raw[19];
#pragma unroll
        for (int i = 0; i < 19; ++i) { raw[i] = (u32x4){0u, 0u, 0u, 0u}; if (i >= 3 || halo) raw[i] = *(const u32x4*)(src + (ptrdiff_t)(i - 3) * NPROJ); }
#pragma unroll
        for (int rr = 0; rr < 16; ++rr) { float o[8];
#pragma unroll
            for (int e = 0; e < 8; ++e) o[e] = cbias[e];
#pragma unroll
            for (int j = 0; j < 4; ++j) { const u32x4 rv = raw[rr + j];
                o[0] += bflo(rv.x) * cw[j][0]; o[1] += bfhi(rv.x) * cw[j][1]; o[2] += bflo(rv.y) * cw[j][2]; o[3] += bfhi(rv.y) * cw[j][3];
                o[4] += bflo(rv.z) * cw[j][4]; o[5] += bfhi(rv.z) * cw[j][5]; o[6] += bflo(rv.w) * cw[j][6]; o[7] += bfhi(rv.w) * cw[j][7]; }
#pragma unroll
            for (int e = 0; e < 8; ++e) o[e] = siluf_(o[e]);
            u32x4 w; w.x = cvt_pk_bf16(o[0], o[1]); w.y = cvt_pk_bf16(o[2], o[3]); w.z = cvt_pk_bf16(o[4], o[5]); w.w = cvt_pk_bf16(o[6], o[7]);
            *(u32x4*)(HBC + (size_t)(r0 + rr) * 2048 + chunk * 8) = w; }
    }
}

template <int VAR, bool SIDE>
__device__ __forceinline__ void ssd_unit(bf16_t* P, const bf16_t* HBC, const float* DT, const float* conv_w, const float* conv_b, float dtb, float Aneg, float Dk,
                                         LAS unsigned char* lds, int b, int hd, int tid_, int lane_, int wave_, const Args& sa, int sgw, int sngw) {
    int tid = tid_; asm volatile("" : "+v"(tid)); const int lane = tid & 63, wave = __builtin_amdgcn_readfirstlane(tid >> 6);
    constexpr int XS = 144, BS = 272;
    LAS unsigned char* Xs = lds; LAS unsigned char* Xw = lds + 18432; LAS unsigned char* Bm = lds + 36864; LAS unsigned char* Cm = lds + 71680; LAS unsigned char* Hs = lds + 106496;
    LAS float* scal = (LAS float*)(lds + 123904);
    const int g = hd >> 3, l15 = lane & 15, q4 = lane >> 4;
    const int xch = tid & 7, xr0 = (tid >> 3) * 2;
    const int xcol = hd * 64 + xch * 8;
    const int bcch = tid & 31, bcrow = tid >> 5;
    const int bccol = bcch < 16 ? g * 128 + bcch * 8 : 1024 + g * 128 + (bcch - 16) * 8;
    LAS unsigned char* bcdst = (bcch < 16 ? Bm + bcch * 16 : Cm + (bcch - 16) * 16) + bcrow * BS;
    LAS float* cwt = (LAS float*)(lds + 126976);
    if (tid < 320) { const int j = tid >> 6, cc = tid & 63; cwt[tid] = j < 4 ? conv_w[j * 6144 + hd * 64 + cc] : conv_b[hd * 64 + cc]; }
    { u32x4 zq = {0u, 0u, 0u, 0u}; asm volatile("" : "+v"(zq));
      for (int i = tid; i < 17408 / 16; i += 512) *(LAS u32x4*)(Hs + i * 16) = zq; }
    f32x4 hacc[4];
#pragma unroll
    for (int pt = 0; pt < 4; ++pt) hacc[pt] = (f32x4){0.f, 0.f, 0.f, 0.f};
    u32x4 xraw[5], bcraw[8]; float dr0 = 0.f, dr1 = 0.f;
#define SSD_LOADS(c_) do { const int tok0_ = b * SEQ + (c_) * 128; \
        _Pragma("unroll") for (int i = 0; i < 5; ++i) { xraw[i] = (u32x4){0u, 0u, 0u, 0u}; \
            if (i >= 3 || (c_) > 0 || xr0 + i >= 3) xraw[i] = *(const u32x4*)(P + (size_t)(tok0_ + xr0 - 3 + i) * NPROJ + COL_XBC + xcol); } \
        if (wave == 0) { dr0 = DT[(size_t)(tok0_ + lane) * 64 + hd]; dr1 = DT[(size_t)(tok0_ + 64 + lane) * 64 + hd]; } } while (0)
#define SSD_LOADS_BC(c_) do { const int tok0_ = b * SEQ + (c_) * 128; \
        _Pragma("unroll") for (int i = 0; i < 8; ++i) bcraw[i] = *(const u32x4*)(HBC + (size_t)(tok0_ + bcrow + 16 * i) * 2048 + bccol); } while (0)
#define SSD_SCAN(par_) do { LAS float* dtv_ = scal + (par_) * 128; LAS float* acum_ = scal + 256 + (par_) * 128; LAS float* wl_ = scal + 512 + (par_) * 128; \
        const float x0 = dr0 + dtb, x1 = dr1 + dtb; \
        const float dt0 = x0 > 20.f ? x0 : log1pf(expf(x0)), dt1 = x1 > 20.f ? x1 : log1pf(expf(x1)); \
        const float s0 = wave_incl_scan(dt0 * Aneg, lane); const float tot0 = lane63(s0); \
        const float s1 = wave_incl_scan(dt1 * Aneg, lane) + tot0; const float tot = lane63(s1); \
        dtv_[lane] = dt0; dtv_[64 + lane] = dt1; acum_[lane] = s0 * 1.4426950408889634f; acum_[64 + lane] = s1 * 1.4426950408889634f;     \
        wl_[lane] = dt0 * __expf(tot - s0); wl_[64 + lane] = dt1 * __expf(tot - s1); } while (0)
    SideItem sd0; float sv0[16]; sd0.src = nullptr; sd0.dst = nullptr; sd0.nsrc = 0; sd0.mode = 0;
#pragma unroll
    for (int j = 0; j < 16; ++j) sv0[j] = 0.f;
    SSD_LOADS(0); SSD_LOADS_BC(0);
    if (wave == 0) SSD_SCAN(0);
    __syncthreads();
    for (int c = 0; c < 32; ++c) {
        const int par = c & 1;
        LAS float* dtv = scal + par * 128; LAS float* acum = scal + 256 + par * 128; LAS float* wl = scal + 512 + par * 128;
        const int tok0 = b * SEQ + c * 128;
        f32x4 o2[2][2];
        { const f32x4 ba = *(const LAS f32x4*)(cwt + 256 + xch * 8), bb = *(const LAS f32x4*)(cwt + 256 + xch * 8 + 4); o2[0][0] = ba; o2[0][1] = bb; o2[1][0] = ba; o2[1][1] = bb; }
#pragma unroll
        for (int j = 0; j < 4; ++j) { const f32x4 wa = *(const LAS f32x4*)(cwt + j * 64 + xch * 8), wb = *(const LAS f32x4*)(cwt + j * 64 + xch * 8 + 4);
#pragma unroll
            for (int rr = 0; rr < 2; ++rr) { const u32x4 rv = xraw[rr + j];
                o2[rr][0] += (f32x4){bflo(rv.x), bfhi(rv.x), bflo(rv.y), bfhi(rv.y)} * wa; o2[rr][1] += (f32x4){bflo(rv.z), bfhi(rv.z), bflo(rv.w), bfhi(rv.w)} * wb; } }
        { f32x4 t[2][2];
#pragma unroll
            for (int rr = 0; rr < 2; ++rr)
#pragma unroll
                for (int hq = 0; hq < 2; ++hq)
                    { const f32x4 ta = o2[rr][hq] * -1.4426950408889634f;
#pragma unroll
                      for (int e = 0; e < 4; ++e) t[rr][hq][e] = __builtin_amdgcn_exp2f(ta[e]); }
#pragma unroll
            for (int rr = 0; rr < 2; ++rr)
#pragma unroll
                for (int hq = 0; hq < 2; ++hq)
                    { const f32x4 tb = t[rr][hq] + 1.0f;
#pragma unroll
                      for (int e = 0; e < 4; ++e) t[rr][hq][e] = __builtin_amdgcn_rcpf(tb[e]); }
#pragma unroll
            for (int rr = 0; rr < 2; ++rr)
#pragma unroll
                for (int hq = 0; hq < 2; ++hq) o2[rr][hq] = o2[rr][hq] * t[rr][hq]; }
#pragma unroll
        for (int rr = 0; rr < 2; ++rr) { const f32x4 oa = o2[rr][0], ob = o2[rr][1];
            u32x4 w; w.x = cvt_pk_bf16(oa[0], oa[1]); w.y = cvt_pk_bf16(oa[2], oa[3]); w.z = cvt_pk_bf16(ob[0], ob[1]); w.w = cvt_pk_bf16(ob[2], ob[3]);
            *(LAS u32x4*)(Xs + (xr0 + rr) * XS + xch * 16) = w;
            const float f = wl[xr0 + rr]; const f32x4 pa = oa * f, pb = ob * f;
            w.x = cvt_pk_bf16(pa[0], pa[1]); w.y = cvt_pk_bf16(pa[2], pa[3]); w.z = cvt_pk_bf16(pb[0], pb[1]); w.w = cvt_pk_bf16(pb[2], pb[3]);
            *(LAS u32x4*)(Xw + (xr0 + rr) * XS + xch * 16) = w; }
#pragma unroll
        for (int i = 0; i < 8; ++i) *(LAS u32x4*)(bcdst + 16 * i * BS) = bcraw[i];
        if (SIDE) { side_drain(sd0, sv0); sd0.mode = 0; }
        LDS_BARRIER();
        if (c + 1 < 32 && !(VAR & 2)) SSD_LOADS(c + 1);
        {
            const int lt = wave < 4 ? wave : 11 - wave;
            const int l = 16 * lt + l15; const float acl = acum[l];
            const size_t token = (size_t)(tok0 + l);
            bf16_t* zp = P + token * NPROJ + COL_Z + hd * 64 + 4 * q4;
            u32x2 zv[4];
#pragma unroll
            for (int pt = 0; pt < 4; ++pt) { zv[pt] = (u32x2){0x3f803f80u, 0x3f803f80u}; if (!(VAR & 1)) zv[pt] = *(const u32x2*)(zp + 16 * pt); }
            f32x4 Y[4];
#pragma unroll
            for (int pt = 0; pt < 4; ++pt) Y[pt] = (f32x4){0.f, 0.f, 0.f, 0.f};
            bf16x8 Cf[4];
            LAS unsigned char* cbase = Cm + l * BS + q4 * 16;
#pragma unroll
            for (int ks = 0; ks < 4; ++ks) Cf[ks] = *(const LAS bf16x8*)(cbase + ks * 64);
            LAS unsigned char* hbase = Hs + l15 * BS + q4 * 16;
#pragma unroll
            for (int pt = 0; pt < 4; ++pt)
#pragma unroll
                for (int ks = 0; ks < 4; ++ks) { const bf16x8 Hf = *(const LAS bf16x8*)(hbase + pt * 16 * BS + ks * 64); Y[pt] = mfma16(Hf, Cf[ks], Y[pt]); }
            const float eal = __builtin_amdgcn_exp2f(acl);
#pragma unroll
            for (int pt = 0; pt < 4; ++pt) Y[pt] *= eal;
            __builtin_amdgcn_sched_barrier(0);
            f32x4 Gt[8];
            f32x4 penv;
#pragma unroll
            for (int e = 0; e < 4; ++e) penv[e] = (4 * q4 + e <= l15) ? 0.f : 1e30f;
            LAS unsigned char* bbase = Bm + l15 * BS + q4 * 16;
#pragma unroll
            for (int st = 0; st < 8; ++st) { Gt[st] = (f32x4){0.f, 0.f, 0.f, 0.f};
                if (st <= lt) {
#pragma unroll
                    for (int ks = 0; ks < 4; ++ks) { const bf16x8 Bf = *(const LAS bf16x8*)(bbase + st * 16 * BS + ks * 64); Gt[st] = mfma16(Bf, Cf[ks], Gt[st]); }
                    const f32x4 as = *(const LAS f32x4*)(acum + 16 * st + 4 * q4), ds = *(const LAS f32x4*)(dtv + 16 * st + 4 * q4);
#pragma unroll
                    for (int e = 0; e < 1; ++e) { const float flagf = (st == lt) ? 1.0f : 0.0f;
                        const f32x4 dv = (acl - as) - penv * flagf;
                        f32x4 fv; fv[0] = __builtin_amdgcn_exp2f(dv[0]); fv[1] = __builtin_amdgcn_exp2f(dv[1]); fv[2] = __builtin_amdgcn_exp2f(dv[2]); fv[3] = __builtin_amdgcn_exp2f(dv[3]);
                        Gt[st] = Gt[st] * (fv * ds); }
                } }
            LAS unsigned char* xbase = Xs + (4 * q4 + (l15 >> 2)) * XS + (l15 & 3) * 8;
#pragma unroll
            for (int kk = 0; kk < 4; ++kk) {
                if (2 * kk <= lt) {
                    u32x4 w; w.x = cvt_pk_bf16(Gt[2 * kk][0], Gt[2 * kk][1]); w.y = cvt_pk_bf16(Gt[2 * kk][2], Gt[2 * kk][3]);
                    w.z = cvt_pk_bf16(Gt[2 * kk + 1][0], Gt[2 * kk + 1][1]); w.w = cvt_pk_bf16(Gt[2 * kk + 1][2], Gt[2 * kk + 1][3]);
                    const bf16x8 Pf = __builtin_bit_cast(bf16x8, w);
#pragma unroll
                    for (int pt = 0; pt < 4; ++pt) {
                        const s16x4 xlo = ldtr(xbase + (32 * kk) * XS + pt * 32);
                        const s16x4 xhi = ldtr(xbase + (32 * kk + 16) * XS + pt * 32);
                        Y[pt] = mfma16(cat8(xlo, xhi), Pf, Y[pt]); }
                } }
            __builtin_amdgcn_sched_barrier(0);
            if (c + 1 < 32 && !(VAR & 2)) SSD_LOADS_BC(c + 1);
            if (SIDE) { sd0 = side_decode(sa, 1, sgw + sngw * c, lane); side_issue(sd0, sv0); }
#pragma unroll
            for (int pt = 0; pt < 4; ++pt) { const int p0 = 16 * pt + 4 * q4;
                const u32x2 xv = *(const LAS u32x2*)(Xs + l * XS + p0 * 2);
                const f32x4 xf = {bflo(xv.x), bfhi(xv.x), bflo(xv.y), bfhi(xv.y)}, zf = {bflo(zv[pt].x), bfhi(zv[pt].x), bflo(zv[pt].y), bfhi(zv[pt].y)};
                const f32x4 yv = (Y[pt] + Dk * xf) * zf;
                u32x2 pk; pk.x = cvt_pk_bf16(yv[0], yv[1]); pk.y = cvt_pk_bf16(yv[2], yv[3]); if (!(VAR & 1)) *(u32x2*)(zp + 16 * pt) = pk; else asm volatile("" :: "v"(pk.x), "v"(pk.y)); }
            __builtin_amdgcn_sched_barrier(0);
            const float et = __builtin_amdgcn_exp2f(acum[127]);
#pragma unroll
            for (int pt = 0; pt < 4; ++pt) hacc[pt] *= et;
            LAS unsigned char* btbase = Bm + (4 * q4 + (l15 >> 2)) * BS + (16 * wave + 4 * (l15 & 3)) * 2;
            LAS unsigned char* xwbase = Xw + (4 * q4 + (l15 >> 2)) * XS + (l15 & 3) * 8;
#pragma unroll
            for (int kk = 0; kk < 4; ++kk) {
                const s16x4 blo = ldtr(btbase + (32 * kk) * BS);
                const s16x4 bhi = ldtr(btbase + (32 * kk + 16) * BS);
                const bf16x8 Bf = cat8(blo, bhi);
#pragma unroll
                for (int pt = 0; pt < 4; ++pt) {
                    const s16x4 xlo = ldtr(xwbase + (32 * kk) * XS + pt * 32);
                    const s16x4 xhi = ldtr(xwbase + (32 * kk + 16) * XS + pt * 32);
                    hacc[pt] = mfma16(Bf, cat8(xlo, xhi), hacc[pt]); }
            }
        }
        if (wave == 0 && c + 1 < 32) SSD_SCAN(par ^ 1);
        LDS_BARRIER();
#pragma unroll
        for (int pt = 0; pt < 4; ++pt) { u32x2 pk; pk.x = cvt_pk_bf16(hacc[pt][0], hacc[pt][1]); pk.y = cvt_pk_bf16(hacc[pt][2], hacc[pt][3]);
            *(LAS u32x2*)(Hs + (16 * pt + l15) * BS + (16 * wave + 4 * q4) * 2) = pk; }
    }
#undef SSD_LOADS
#undef SSD_LOADS_BC
#undef SSD_SCAN
    if (SIDE) { side_drain(sd0, sv0); }
    __syncthreads();
}

__device__ __forceinline__ void phase_attn_merge(bf16_t* P, const float* LSE, int lane, int gw, int NGW) {
    const int hh = lane >> 4, dd = (lane & 15) * 8;
#pragma unroll 2
    for (int m = gw; m < M_TOK; m += NGW) {
        bf16_t* op = P + (size_t)m * NPROJ + hh * 128 + dd;
        const float l0 = LSE[(size_t)m * 12 + hh], l1 = LSE[(size_t)m * 12 + 4 + hh], l2 = LSE[(size_t)m * 12 + 8 + hh];
        const u32x4 o0 = *(const u32x4*)op, o1 = *(const u32x4*)(op + 512), o2 = *(const u32x4*)(op + 1024);
        const float mx = fmaxf(l0, fmaxf(l1, l2)); float w0 = __expf(l0 - mx), w1 = __expf(l1 - mx), w2 = __expf(l2 - mx);
        const float inv = 1.0f / (w0 + w1 + w2); w0 *= inv; w1 *= inv; w2 *= inv;
        u32x4 w;
        w.x = cvt_pk_bf16(w0 * bflo(o0.x) + w1 * bflo(o1.x) + w2 * bflo(o2.x), w0 * bfhi(o0.x) + w1 * bfhi(o1.x) + w2 * bfhi(o2.x));
        w.y = cvt_pk_bf16(w0 * bflo(o0.y) + w1 * bflo(o1.y) + w2 * bflo(o2.y), w0 * bfhi(o0.y) + w1 * bfhi(o1.y) + w2 * bfhi(o2.y));
        w.z = cvt_pk_bf16(w0 * bflo(o0.z) + w1 * bflo(o1.z) + w2 * bflo(o2.z), w0 * bfhi(o0.z) + w1 * bfhi(o1.z) + w2 * bfhi(o2.z));
        w.w = cvt_pk_bf16(w0 * bflo(o0.w) + w1 * bflo(o1.w) + w2 * bflo(o2.w), w0 * bfhi(o0.w) + w1 * bfhi(o1.w) + w2 * bfhi(o2.w));
        *(u32x4*)op = w;
    }
}
__device__ __forceinline__ void phase_merge(bf16_t* P, const float* LSE, const float* nw, int lane, int gw, int NGW) {
    f32x4 wa[8], wb[8];
#pragma unroll
    for (int gg = 0; gg < 8; ++gg) { wa[gg] = *(const f32x4*)(nw + gg * 512 + lane * 8); wb[gg] = *(const f32x4*)(nw + gg * 512 + lane * 8 + 4); }
    for (int m = gw; m < M_TOK; m += NGW) {
        bf16_t* rp = P + (size_t)m * NPROJ;
        u32x4 yv[8];
#pragma unroll
        for (int gg = 0; gg < 8; ++gg) yv[gg] = *(const u32x4*)(rp + COL_Z + gg * 512 + lane * 8);
        float ss[8];
#pragma unroll
        for (int gg = 0; gg < 8; ++gg) { const u32x4 v = yv[gg];
            ss[gg] = (bflo(v.x) * bflo(v.x) + bfhi(v.x) * bfhi(v.x)) + (bflo(v.y) * bflo(v.y) + bfhi(v.y) * bfhi(v.y)) + (bflo(v.z) * bflo(v.z) + bfhi(v.z) * bfhi(v.z)) + (bflo(v.w) * bflo(v.w) + bfhi(v.w) * bfhi(v.w)); }
#pragma unroll
        for (int gg = 0; gg < 8; ++gg) ss[gg] = wave_sum(ss[gg]);
#pragma unroll
        for (int gg = 0; gg < 8; ++gg) { const u32x4 v = yv[gg];
            const float rs = 1.0f / sqrtf(ss[gg] * (1.0f / 512.0f) + 1e-6f);
            u32x4 w; w.x = cvt_pk_bf16(bflo(v.x) * rs * wa[gg].x, bfhi(v.x) * rs * wa[gg].y); w.y = cvt_pk_bf16(bflo(v.y) * rs * wa[gg].z, bfhi(v.y) * rs * wa[gg].w);
            w.z = cvt_pk_bf16(bflo(v.z) * rs * wb[gg].x, bfhi(v.z) * rs * wb[gg].y); w.w = cvt_pk_bf16(bflo(v.w) * rs * wb[gg].z, bfhi(v.w) * rs * wb[gg].w);
            *(u32x4*)(rp + COL_Z + gg * 512 + lane * 8) = w; }
    }
}

#define GAS __attribute__((address_space(1)))
#define XB_TMO      128
#define XB_XCNT(j)  (256  + 64 * (j))
#define XB_XSUB(j)  (1280 + 64 * (j))
#define XB_XGEN(j)  (2304 + 64 * (j))
#define XB_TOP      3328
#define XB_TOPGEN   3392
#define XCD_BAR_WORDS 3456
#define XB_SPIN_CAP (1u << 18)

__device__ __forceinline__ unsigned xb_ld(unsigned* p)              { return __hip_atomic_load(p, __ATOMIC_RELAXED, __HIP_MEMORY_SCOPE_AGENT); }
__device__ __forceinline__ unsigned xb_add(unsigned* p, unsigned v) { return __hip_atomic_fetch_add(p, v, __ATOMIC_RELAXED, __HIP_MEMORY_SCOPE_AGENT); }
__device__ __forceinline__ unsigned xb_xcc_id() { return (unsigned)__builtin_amdgcn_s_getreg((3 << 11) | 20) & 0xFu; }
#define XB_SPIN(cond, bar) do { unsigned _sp = 0; while (cond) { \
    if ((++_sp & 255u) == 0u) { if (xb_ld(&(bar)[XB_TMO])) break; if (_sp > XB_SPIN_CAP) { atomicAdd(&(bar)[XB_TMO], 1u); break; } } } } while (0)

struct XcdBarrier {
    unsigned* bar; unsigned x; int w0;
    volatile LAS unsigned* st;
};

__device__ __forceinline__ XcdBarrier xcd_barrier_post(unsigned* bar, volatile LAS unsigned* st, int tid0_, int wv_) {
    XcdBarrier b; b.bar = bar; b.x = xb_xcc_id(); b.st = st; b.w0 = wv_;
    if (tid0_ == 0) (void)xb_add(&bar[XB_XCNT(b.x)], 1u);
    return b;
}
__device__ __forceinline__ void xcd_barrier_complete(unsigned* bar, unsigned x, unsigned& nloc, unsigned& nx) {
    const unsigned G = gridDim.x * gridDim.y * gridDim.z;
    unsigned sum, cnt, mine, sp = 0u;
    for (;;) {
        sum = 0u; cnt = 0u; mine = 0u;
#pragma unroll
        for (unsigned j = 0; j < 16; ++j) { const unsigned c = xb_ld(&bar[XB_XCNT(j)]); sum += c; cnt += (c > 0u) ? 1u : 0u; mine = (j == x) ? c : mine; }
        if (sum == G) break;
        __builtin_amdgcn_s_sleep(1);
        if ((++sp & 255u) == 0u) { if (xb_ld(&bar[XB_TMO])) break; if (sp > XB_SPIN_CAP) { atomicAdd(&bar[XB_TMO], 1u); break; } }
    }
    nloc = mine > 0u ? mine : 1u; nx = cnt > 0u ? cnt : 1u;
}

__device__ __forceinline__ void xcd_barrier(const XcdBarrier& b) {
    asm volatile("s_waitcnt vmcnt(0)" ::: "memory");
    __syncthreads();
    if (b.w0 == 0 && pg8::lane_id_mbcnt() == 0) {
        unsigned* bar = b.bar; asm volatile("" : "+s"(bar));
        __builtin_amdgcn_s_waitcnt(0);
        unsigned nloc = b.st[0], nx = b.st[1];
        if (nloc == 0u) { xcd_barrier_complete(bar, b.x, nloc, nx); b.st[0] = nloc; b.st[1] = nx; }
        const unsigned old = xb_add(&bar[XB_XSUB(b.x)], 1u);
        const unsigned gen = old / nloc;
        if (old + 1u == (gen + 1u) * nloc) {
            __builtin_amdgcn_fence(__ATOMIC_RELEASE, "agent");
            asm volatile("s_waitcnt vmcnt(0)" ::: "memory");
            const unsigned og = xb_add(&bar[XB_TOP], 1u);
            const unsigned tg = og / nx;
            if (og + 1u == (tg + 1u) * nx) xb_add(&bar[XB_TOPGEN], 1u);
            else XB_SPIN(xb_ld(&bar[XB_TOPGEN]) == tg, bar);
            __builtin_amdgcn_fence(__ATOMIC_ACQUIRE, "agent");
            xb_add(&bar[XB_XGEN(b.x)], 1u);
            asm volatile("s_waitcnt vmcnt(0)" ::: "memory");
        } else {
            XB_SPIN(xb_ld(&bar[XB_XGEN(b.x)]) == gen, bar);
            __builtin_amdgcn_fence(__ATOMIC_ACQUIRE, "agent");
            asm volatile("s_waitcnt vmcnt(0)" ::: "memory");
        }
    }
    __syncthreads();
}

#ifndef PROBE_MODE
#define PROBE_MODE 0
#endif
#ifndef PROBE_VAR
#define PROBE_VAR 0
#endif
#ifndef MK_SINGLE
#define MK_SINGLE 1
#endif
__global__ void __launch_bounds__(512, 2) fwd_kernel(Args a) {
    extern __shared__ __attribute__((aligned(16))) unsigned char lds_raw[];
    LAS unsigned char* lds = (LAS unsigned char*)lds_raw;
    cg::grid_group grid = cg::this_grid();
    const int bx = blockIdx.x, G = gridDim.x, NGW = G * 8;
    const int tid0 = threadIdx.x;
    const int wv_s = __builtin_amdgcn_readfirstlane(tid0 >> 6);
    const int lo = a.ph_lo, hi = a.ph_hi;
    volatile LAS unsigned* MISC = (volatile LAS unsigned*)(lds + LDS_BYTES - 64);
    if (tid0 < 16) MISC[tid0] = 0u;
    __syncthreads();
    const XcdBarrier xbar = xcd_barrier_post((unsigned*)(a.ws + WS_CTL), MISC, tid0, wv_s);
#define PH_IDS int tid = wv_s * 64 + pg8::lane_id_mbcnt(); asm volatile("" : "+v"(tid)); const int lane = tid & 63, wave = __builtin_amdgcn_readfirstlane(tid >> 6), gw = bx * 8 + wave; (void)lane; (void)gw
    float* out = a.out;
#define PH_PTRS unsigned char* ws = a.ws; asm volatile("" : "+s"(ws)); float* MOD = (float*)(ws + WS_MOD); float* LSE = (float*)(ws + WS_LSE); float* DT = (float*)(ws + WS_DT); \
    bf16_t* H = (bf16_t*)(ws + WS_H); bf16_t* P = (bf16_t*)(ws + WS_PROJ); bf16_t* XB = (bf16_t*)(ws + WS_XB); (void)XB; const float* mod = MOD + (size_t)l * 4 * 12288; unsigned char* wb = ws + WS_W + (size_t)l * WL_BYTES; \
    (void)LSE; (void)DT; (void)H; (void)P; (void)mod; (void)wb
#define IN(k) (lo <= (k) && (k) < hi)
#define SEAM(k) do { if (IN(k) && IN((k) + 1)) xcd_barrier(xbar); } while (0)
    if (lo < -1000) grid.sync();
    const bool side = false;
    if (IN(0)) { PH_IDS; phase_prep(a, lds, tid, lane, wave, bx, G, side ? 1 : 2); }
    SEAM(0);
#if PROBE_MODE == 5
    if (IN(0) && IN(1)) { { PH_IDS; phase_prep(a, lds, tid, lane, wave, bx, G, 2); } xcd_barrier(xbar); }
#endif
#pragma unroll 1
    for (int l = 0; l < 2; ++l) {
        const int pb = 1 + 10 * l;
        if (IN(pb + 0)) { PH_PTRS; PH_IDS; if (l == 0) phase_norm<false>(a.in[0], a.in[3] + l * 2048, mod + 2048, mod, H, nullptr, lane, gw, NGW); else phase_norm_b<false>(XB, a.in[3] + l * 2048, mod + 2048, mod, H, nullptr, lane, gw, NGW); }
        SEAM(pb + 0);
        if (IN(pb + 1)) { PH_PTRS; pg8::Gemm g{H, (const bf16_t*)(wb + WO_IN), M_TOK, NPROJ, 2048, 2048}; pg8::StaticOrder S; S.init(M_TOK, NPROJ, G, bx);
            pg8::EpiProj E{P, DT}; pg8::gemm_phase<pg8::EpiProj, pg8::StaticOrder, true, true>(lds, g, S, E, wv_s); }
        SEAM(pb + 1);
        if (IN(pb + 2)) { PH_PTRS; PH_IDS;
            phase_attn(P, LSE, a.in[2], lds, bx, G, tid);
            phase_convbc(P, H, a.in[8] + (size_t)l * 4 * 6144, a.in[9] + (size_t)l * 6144, tid, bx, G);
        }
        SEAM(pb + 2);
        if (IN(pb + 3)) { PH_PTRS; PH_IDS;
            for (int u = bx; u < 256; u += G) {
                const int xcd = u & 7, slot = u >> 3, gb = xcd * 4 + (slot >> 3), b = gb >> 3, hd = (gb & 7) * 8 + (slot & 7);
                if (l == 0 && side) ssd_unit<0, true>(P, H, DT, a.in[8] + (size_t)l * 4 * 6144, a.in[9] + (size_t)l * 6144, a.in[10][l * 64 + hd], -expf(a.in[11][l * 64 + hd]), a.in[12][l * 64 + hd], lds, b, hd, tid, lane, wave, a, gw, NGW);
                else ssd_unit<0, false>(P, H, DT, a.in[8] + (size_t)l * 4 * 6144, a.in[9] + (size_t)l * 6144, a.in[10][l * 64 + hd], -expf(a.in[11][l * 64 + hd]), a.in[12][l * 64 + hd], lds, b, hd, tid, lane, wave, a, gw, NGW); }
            phase_attn_merge(P, LSE, lane, gw, NGW);
        }
        SEAM(pb + 3);
        if (IN(pb + 4)) { PH_PTRS; PH_IDS; phase_merge(P, LSE, a.in[13] + (size_t)l * 4096, lane, gw, NGW); }
        SEAM(pb + 4);
        if (IN(pb + 5)) { PH_PTRS;
            { pg8::Gemm g{P + COL_Q, (const bf16_t*)(wb + WO_A), M_TOK, 2048, 512, NPROJ}; pg8::StaticOrder S; S.init(M_TOK, 2048, G, bx);
              pg8::EpiGate<0> E{H, 2048, P + COL_GA, NPROJ}; pg8::gemm_phase<pg8::EpiGate<0>, pg8::StaticOrder, true, true>(lds, g, S, E, wv_s); }
            { pg8::Gemm g{P + COL_Z, (const bf16_t*)(wb + WO_S), M_TOK, 2048, 4096, NPROJ}; pg8::StaticOrder S; S.init(M_TOK, 2048, G, bx);
              pg8::EpiGate<1> E{H, 2048, P + COL_GS, NPROJ}; pg8::gemm_phase<pg8::EpiGate<1>, pg8::StaticOrder, true, true>(lds, g, S, E, wv_s); }
        }
        SEAM(pb + 5);
#if PROBE_MODE > 0
        if (IN(pb + 5) && IN(pb + 6)) { PH_IDS;
#if PROBE_MODE == 1
            phase_attn(P, LSE, a.in[2], lds, bx, G, tid);
#elif PROBE_MODE == 2
            for (int u = bx; u < 256; u += G) {
                const int xcd = u & 7, slot = u >> 3, gb = xcd * 4 + (slot >> 3), b = gb >> 3, hd = (gb & 7) * 8 + (slot & 7);
                ssd_unit<PROBE_VAR, false>(P, H, DT, a.in[8] + (size_t)l * 4 * 6144, a.in[9] + (size_t)l * 6144, a.in[10][l * 64 + hd], -expf(a.in[11][l * 64 + hd]), a.in[12][l * 64 + hd], lds, b, hd, tid, lane, wave, a, gw, NGW); }
#elif PROBE_MODE == 3
            phase_merge(P, LSE, a.in[13] + (size_t)l * 4096, lane, gw, NGW);
#elif PROBE_MODE == 4
            phase_convbc(P, P + (size_t)200000000, a.in[8] + (size_t)l * 4 * 6144, a.in[9] + (size_t)l * 6144, tid, bx, G);
#endif
            grid.sync(); }
#endif
        if (IN(pb + 6)) { PH_PTRS; pg8::Gemm g{H, (const bf16_t*)(wb + WO_O), M_TOK, 2048, 2048, 2048}; pg8::StaticOrder S; S.init(M_TOK, 2048, G, bx);
            pg8::EpiRes2 E{l == 0 ? a.in[0] : nullptr, XB, XB, mod + 4096, 12288}; pg8::gemm_phase<pg8::EpiRes2, pg8::StaticOrder, true, true>(lds, g, S, E, wv_s); }
        SEAM(pb + 6);
        if (IN(pb + 7)) { PH_PTRS; PH_IDS; phase_norm_b<false>(XB, a.in[4] + l * 2048, mod + 8192, mod + 6144, H, nullptr, lane, gw, NGW); }
        SEAM(pb + 7);
        if (IN(pb + 8)) { PH_PTRS; pg8::Gemm g{H, (const bf16_t*)(wb + WO_FI), M_TOK, 2 * D_FF, 2048, 2048}; pg8::StaticOrder S; S.init(M_TOK, 2 * D_FF, G, bx);
            pg8::EpiSwiglu E{P, D_FF}; pg8::gemm_phase<pg8::EpiSwiglu, pg8::StaticOrder, true, true>(lds, g, S, E, wv_s); }
        SEAM(pb + 8);
        if (IN(pb + 9)) { PH_PTRS; pg8::Gemm g{P, (const bf16_t*)(wb + WO_FO), M_TOK, 2048, D_FF, D_FF}; pg8::StaticOrder S; S.init(M_TOK, 2048, G, bx);
            pg8::EpiRes2 E{nullptr, XB, XB, mod + 10240, 12288}; pg8::gemm_phase<pg8::EpiRes2, pg8::StaticOrder, true, true>(lds, g, S, E, wv_s); }
        SEAM(pb + 9);
    }
#if PROBE_MODE == 7
    if (IN(20) && IN(21)) { for (int i = 0; i < 20; ++i) grid.sync(); }
#endif
    if (IN(21)) { PH_IDS; const bf16_t* XBf = (const bf16_t*)(a.ws + WS_XB); phase_norm_b<true>(XBf, a.in[19], nullptr, nullptr, nullptr, out, lane, gw, NGW); }
#undef IN
#undef SEAM
}

extern "C" void kernel_launch(void* const* d_in, const int* in_sizes, int n_in, void* d_out, int out_size, void* d_ws, size_t ws_size, hipStream_t stream) {
    static int grid = 0;
    if (grid == 0) {
        if (n_in != 20 || out_size != M_TOK * D_MODEL || ws_size < WS_END + MiB) { fprintf(stderr, "kernel_launch: unexpected shapes (n_in %d out %d ws %zu need %zu)\n", n_in, out_size, ws_size, (size_t)WS_END); grid = -1; return; }
        int dev = 0, cus = 0, per_cu = 0;
        (void)hipGetDevice(&dev); (void)hipDeviceGetAttribute(&cus, hipDeviceAttributeMultiprocessorCount, dev);
        if (hipFuncSetAttribute((const void*)fwd_kernel, hipFuncAttributeMaxDynamicSharedMemorySize, LDS_BYTES) != hipSuccess) { fprintf(stderr, "kernel_launch: hipFuncSetAttribute failed\n"); grid = -1; return; }
        if (hipOccupancyMaxActiveBlocksPerMultiprocessor(&per_cu, (const void*)fwd_kernel, 512, LDS_BYTES) != hipSuccess || per_cu < 1) { fprintf(stderr, "kernel_launch: occupancy query gave %d\n", per_cu); per_cu = 1; }
        (void)hipGetLastError();
        grid = cus * 1;
        if (grid <= 0) grid = 256;
    }
    if (grid < 0) return;
    (void)hipMemsetAsync((char*)d_ws + WS_CTL, 0, 16384, stream);
    Args a{};
    for (int i = 0; i < 20; ++i) a.in[i] = (const float*)d_in[i];
    a.out = (float*)d_out; a.ws = (unsigned char*)d_ws;
    void* args[] = {&a};
#if MK_SINGLE
    a.ph_lo = 0; a.ph_hi = NPHASE;
    hipError_t e = hipLaunchCooperativeKernel((const void*)fwd_kernel, dim3(grid), dim3(512), args, LDS_BYTES, stream);
    if (e != hipSuccess) fprintf(stderr, "cooperative launch failed: %s (grid %d)\n", hipGetErrorString(e), grid);
#else
    for (int ph = 0; ph < NPHASE; ++ph) { a.ph_lo = ph; a.ph_hi = ph + 1;
        hipError_t e = hipLaunchCooperativeKernel((const void*)fwd_kernel, dim3(grid), dim3(512), args, LDS_BYTES, stream);
        if (e != hipSuccess) { fprintf(stderr, "cooperative launch %d failed: %s (grid %d)\n", ph, hipGetErrorString(e), grid); break; } }
#endif
}
```
